# Optimizing an MI355X kernel written in HIP

```python
import math
import jax, jax.numpy as jnp
from jax import lax
import numpy as np

D_MODEL = 1024
BATCH = 8
SEQ = 4096
DEPTH = 1

GRID_W = 64
N_MEM = 256
D_HYENA = 512
HYENA_GROUPS = 8
HYENA_ORDER = 2
SHORT_CONV = 3
FILTER_BANDS = 16
FILTER_EMB = 1 + 2 * FILTER_BANDS
FILTER_FF = 64
DECAY_TARGET = 1e-2
FAST_DECAY_PCT = 0.3
SLOW_DECAY_PCT = 1.5
N_Q_HEADS = 8
N_KV_HEADS = 2
HEAD_DIM = 64
D_ATTN = N_Q_HEADS * HEAD_DIM
D_KV = N_KV_HEADS * HEAD_DIM
Q_BLOCK = 128
ROPE_THETA = 10000.0
D_MIX = D_HYENA + D_ATTN
D_IN = (HYENA_ORDER + 1) * D_HYENA + D_ATTN + 2 * D_KV
MEM_HEADS = 4
MEM_HEAD_DIM = 128
D_MEM_ATTN = MEM_HEADS * MEM_HEAD_DIM
N_GROUPS = 4
EXPERTS_PER_GROUP = 4
N_EXPERTS = N_GROUPS * EXPERTS_PER_GROUP
TOP_K = 2
D_EXPERT = 512
EPS = 1e-6

kernel_name = 'hybrid_hyena_gqa_hmoe_encoder'


def rms_norm(x, g):
    xf = x.astype(jnp.float32)
    y = xf * lax.rsqrt(jnp.mean(xf * xf, axis=-1, keepdims=True) + EPS)
    return (y * g.astype(jnp.float32)).astype(x.dtype)


def group_rms_norm(x, g, n_groups):
    shp = x.shape
    xg = x.reshape(shp[:-1] + (n_groups, shp[-1] // n_groups))
    return rms_norm(xg, g.reshape(n_groups, -1)).reshape(shp)


def rope_section(x, pos):
    m = x.shape[-1] // 2
    inv = ROPE_THETA ** (-jnp.arange(m, dtype=jnp.float32) / m)
    ang = pos.astype(jnp.float32)[:, None] * inv[None, :]
    cos = jnp.cos(ang)[None, :, None, :]
    sin = jnp.sin(ang)[None, :, None, :]
    xf = x.astype(jnp.float32)
    x1, x2 = xf[..., :m], xf[..., m:]
    return jnp.concatenate([x1 * cos - x2 * sin, x2 * cos + x1 * sin], axis=-1).astype(x.dtype)


def rope_2d(x, row, col):
    half = x.shape[-1] // 2
    return jnp.concatenate([rope_section(x[..., :half], row), rope_section(x[..., half:], col)], axis=-1)


def hyena_filter_spectra(L, w1, b1, w2, b2, w3, sin_freq):
    f32 = jnp.float32
    t = jnp.linspace(0.0, 1.0, L, dtype=f32)[:, None]
    bands = jnp.linspace(1e-4, FILTER_BANDS - 1, FILTER_BANDS, dtype=f32)[None, :]
    w = (2.0 * math.pi / L) * jnp.arange(L, dtype=f32)[:, None]
    z = jnp.concatenate([t, jnp.cos(bands * w), jnp.sin(bands * w)], axis=-1)
    a = jnp.sin(sin_freq[0].astype(f32) * (z @ w1.astype(f32) + b1.astype(f32)))
    a = jnp.sin(sin_freq[1].astype(f32) * (a @ w2.astype(f32) + b2.astype(f32)))
    filt = (a @ w3.astype(f32)).reshape(L, HYENA_ORDER, 2, D_HYENA)
    deltas = jnp.abs(jnp.linspace(math.log(DECAY_TARGET) / SLOW_DECAY_PCT,
                                  math.log(DECAY_TARGET) / FAST_DECAY_PCT, D_HYENA, dtype=f32))
    filt = filt * jnp.exp(-t * deltas)[:, None, None, :]
    fwd, bwd = filt[:, :, 0], filt[:, :, 1]
    k2 = jnp.concatenate([fwd, jnp.zeros_like(fwd[:1]), bwd[:0:-1]], axis=0)
    k2 = k2 / (jnp.sum(jnp.abs(k2), axis=0, keepdims=True) + EPS)
    return jnp.fft.rfft(k2, axis=0)


def fft_long_conv(z, k_f):
    L = z.shape[1]
    zf = jnp.fft.rfft(z.astype(jnp.float32), n=2 * L, axis=1)
    return jnp.fft.irfft(zf * k_f[None], n=2 * L, axis=1)[:, :L]


def hyena_mixer(u, short_w, short_b, skip, k_f):
    C = u.shape[-1]
    u = lax.conv_general_dilated(u, short_w[:, None, :].astype(u.dtype), window_strides=(1,),
                                 padding=((SHORT_CONV // 2, SHORT_CONV // 2),),
                                 dimension_numbers=('NWC', 'WIO', 'NWC'),
                                 feature_group_count=C) + short_b.astype(u.dtype)
    v, g1, g2 = jnp.split(u, 3, axis=-1)
    z = v
    for o, gate in enumerate((g1, g2)):
        zc = fft_long_conv(z, k_f[:, o]) + skip[o].astype(jnp.float32) * z.astype(jnp.float32)
        z = gate * zc.astype(gate.dtype)
    return z


def gqa_mixer(q, k, v, q_norm, k_norm, row, col):
    B, L, _ = q.shape
    G = N_Q_HEADS // N_KV_HEADS
    q = rope_2d(rms_norm(q.reshape(B, L, N_Q_HEADS, HEAD_DIM), q_norm), row, col)
    k = rope_2d(rms_norm(k.reshape(B, L, N_KV_HEADS, HEAD_DIM), k_norm), row, col)
    v = v.reshape(B, L, N_KV_HEADS, HEAD_DIM)
    nb = L // Q_BLOCK
    qb = q.reshape(B, nb, Q_BLOCK, N_KV_HEADS, G, HEAD_DIM).transpose(1, 0, 3, 4, 2, 5)
    kt = k.transpose(0, 2, 1, 3)
    vt = v.transpose(0, 2, 1, 3)
    scale = HEAD_DIM ** -0.5

    def attend_block(qblk):
        s = jnp.einsum('bkgqd,bksd->bkgqs', qblk, kt).astype(jnp.float32) * scale
        p = jax.nn.softmax(s, axis=-1).astype(vt.dtype)
        return jnp.einsum('bkgqs,bksd->bkgqd', p, vt)

    o = lax.map(attend_block, qb)
    return o.transpose(1, 0, 4, 2, 3, 5).reshape(B, L, D_ATTN)


def memory_cross_attn(h, m, w_q, w_k, w_v, q_norm, k_norm, w_o):
    B, L, _ = h.shape
    M = m.shape[1]
    q = rms_norm((h @ w_q).reshape(B, L, MEM_HEADS, MEM_HEAD_DIM), q_norm)
    k = rms_norm((m @ w_k).reshape(B, M, MEM_HEADS, MEM_HEAD_DIM), k_norm)
    v = (m @ w_v).reshape(B, M, MEM_HEADS, MEM_HEAD_DIM)
    s = jnp.einsum('blhd,bmhd->bhlm', q, k).astype(jnp.float32) * (MEM_HEAD_DIM ** -0.5)
    p = jax.nn.softmax(s, axis=-1).astype(v.dtype)
    o = jnp.einsum('bhlm,bmhd->blhd', p, v).reshape(B, L, D_MEM_ATTN)
    return o @ w_o


def hier_moe(h, w_rg, b_rg, w_re, b_re, w_gate, w_up, w_down):
    B, L, D = h.shape
    hf = h.reshape(B * L, D)
    grp_prob = jax.nn.softmax((hf @ w_rg).astype(jnp.float32) + b_rg.astype(jnp.float32), axis=-1)
    p_grp, g_idx = lax.top_k(grp_prob, 1)
    exp_logits = ((hf @ w_re).astype(jnp.float32) + b_re.astype(jnp.float32)).reshape(
        -1, N_GROUPS, EXPERTS_PER_GROUP)
    sel_logits = jnp.take_along_axis(exp_logits, g_idx[:, :, None], axis=1)[:, 0]
    w_top, e_loc = lax.top_k(jax.nn.softmax(sel_logits, axis=-1), TOP_K)
    w_top = p_grp * w_top / jnp.sum(w_top, axis=-1, keepdims=True)
    e_glob = g_idx * EXPERTS_PER_GROUP + e_loc
    gates = jnp.einsum('tk,tke->te', w_top,
                       jax.nn.one_hot(e_glob, N_EXPERTS, dtype=jnp.float32)).astype(h.dtype)
    y = jnp.zeros_like(hf)
    for e in range(N_EXPERTS):
        a = jax.nn.silu(hf @ w_gate[e]) * (hf @ w_up[e])
        y = y + gates[:, e:e + 1] * (a @ w_down[e])
    return y.reshape(B, L, D)


def setup_inputs(seed: int = 0) -> dict:
    key = jax.random.key(seed)
    ks = iter(jax.random.split(key, 40))
    f32 = jnp.float32

    def nrm(shape, scale):
        return jax.random.normal(next(ks), shape, f32) * scale

    def gain(shape):
        return 1.0 + 0.05 * jax.random.normal(next(ks), shape, f32)

    return {
        'x': nrm((BATCH, SEQ, D_MODEL), 1.0),
        'mem': nrm((BATCH, N_MEM, D_MODEL), 1.0),
        'norm_mix': gain((DEPTH, D_MODEL)),
        'w_in': nrm((DEPTH, D_MODEL, D_IN), D_MODEL ** -0.5),
        'hyena_short_w': nrm((DEPTH, SHORT_CONV, (HYENA_ORDER + 1) * D_HYENA), SHORT_CONV ** -0.5),
        'hyena_short_b': nrm((DEPTH, (HYENA_ORDER + 1) * D_HYENA), 0.02),
        'filt_w1': nrm((DEPTH, FILTER_EMB, FILTER_FF), FILTER_EMB ** -0.5),
        'filt_b1': nrm((DEPTH, FILTER_FF), 0.02),
        'filt_w2': nrm((DEPTH, FILTER_FF, FILTER_FF), FILTER_FF ** -0.5),
        'filt_b2': nrm((DEPTH, FILTER_FF), 0.02),
        'filt_w3': nrm((DEPTH, FILTER_FF, HYENA_ORDER * 2 * D_HYENA), FILTER_FF ** -0.5),
        'filt_sin_freq': gain((DEPTH, 2, FILTER_FF)),
        'hyena_skip': nrm((DEPTH, HYENA_ORDER, D_HYENA), 0.1),
        'attn_q_norm': gain((DEPTH, HEAD_DIM)),
        'attn_k_norm': gain((DEPTH, HEAD_DIM)),
        'out_norm_hyena': gain((DEPTH, D_HYENA)),
        'out_norm_attn': gain((DEPTH, D_ATTN)),
        'w_out': nrm((DEPTH, D_MIX, D_MODEL), D_MIX ** -0.5),
        'norm_xattn': gain((DEPTH, D_MODEL)),
        'norm_mem': gain((DEPTH, D_MODEL)),
        'w_q_mem': nrm((DEPTH, D_MODEL, D_MEM_ATTN), D_MODEL ** -0.5),
        'w_k_mem': nrm((DEPTH, D_MODEL, D_MEM_ATTN), D_MODEL ** -0.5),
        'w_v_mem': nrm((DEPTH, D_MODEL, D_MEM_ATTN), D_MODEL ** -0.5),
        'mem_q_norm': gain((DEPTH, MEM_HEAD_DIM)),
        'mem_k_norm': gain((DEPTH, MEM_HEAD_DIM)),
        'w_o_mem': nrm((DEPTH, D_MEM_ATTN, D_MODEL), D_MEM_ATTN ** -0.5),
        'norm_moe': gain((DEPTH, D_MODEL)),
        'w_router_grp': nrm((DEPTH, D_MODEL, N_GROUPS), D_MODEL ** -0.5),
        'b_router_grp': nrm((DEPTH, N_GROUPS), 0.01),
        'w_router_exp': nrm((DEPTH, D_MODEL, N_EXPERTS), D_MODEL ** -0.5),
        'b_router_exp': nrm((DEPTH, N_EXPERTS), 0.01),
        'w_gate': nrm((DEPTH, N_EXPERTS, D_MODEL, D_EXPERT), D_MODEL ** -0.5),
        'w_up': nrm((DEPTH, N_EXPERTS, D_MODEL, D_EXPERT), D_MODEL ** -0.5),
        'w_down': nrm((DEPTH, N_EXPERTS, D_EXPERT, D_MODEL), D_EXPERT ** -0.5),
    }


def reference(x, mem, norm_mix, w_in, hyena_short_w, hyena_short_b, filt_w1, filt_b1, filt_w2,
              filt_b2, filt_w3, filt_sin_freq, hyena_skip, attn_q_norm, attn_k_norm,
              out_norm_hyena, out_norm_attn, w_out, norm_xattn, norm_mem, w_q_mem, w_k_mem,
              w_v_mem, mem_q_norm, mem_k_norm, w_o_mem, norm_moe, w_router_grp, b_router_grp,
              w_router_exp, b_router_exp, w_gate, w_up, w_down):
    L = x.shape[1]
    rows = L // GRID_W
    row = jnp.broadcast_to(jnp.arange(rows, dtype=jnp.int32)[:, None], (rows, GRID_W)).reshape(-1)
    col = jnp.broadcast_to(jnp.arange(GRID_W, dtype=jnp.int32)[None, :], (rows, GRID_W)).reshape(-1)
    split_at = [(HYENA_ORDER + 1) * D_HYENA,
                (HYENA_ORDER + 1) * D_HYENA + D_ATTN,
                (HYENA_ORDER + 1) * D_HYENA + D_ATTN + D_KV]
    for i in range(DEPTH):
        h = rms_norm(x, norm_mix[i])
        u_hy, q, k, v = jnp.split(h @ w_in[i], split_at, axis=-1)
        k_f = hyena_filter_spectra(L, filt_w1[i], filt_b1[i], filt_w2[i], filt_b2[i], filt_w3[i],
                                   filt_sin_freq[i])
        y_hy = hyena_mixer(u_hy, hyena_short_w[i], hyena_short_b[i], hyena_skip[i], k_f)
        y_at = gqa_mixer(q, k, v, attn_q_norm[i], attn_k_norm[i], row, col)
        y = jnp.concatenate([group_rms_norm(y_hy, out_norm_hyena[i], HYENA_GROUPS),
                             group_rms_norm(y_at, out_norm_attn[i], N_Q_HEADS)], axis=-1)
        x = x + y @ w_out[i]
        x = x + memory_cross_attn(rms_norm(x, norm_xattn[i]), rms_norm(mem, norm_mem[i]),
                                  w_q_mem[i], w_k_mem[i], w_v_mem[i], mem_q_norm[i], mem_k_norm[i],
                                  w_o_mem[i])
        x = x + hier_moe(rms_norm(x, norm_moe[i]), w_router_grp[i], b_router_grp[i], w_router_exp[i],
                         b_router_exp[i], w_gate[i], w_up[i], w_down[i])
    return x
```

```cpp
#include <hip/hip_runtime.h>
#include <cstdio>
#include <cstdint>
#include <cmath>

namespace nv {
constexpr int B = 8, L = 4096, T = B * L, DM = 1024, DIN = 2304, DH = 512, NMEM = 256;
constexpr size_t MiB = 1u << 20;
constexpr size_t WS_XN = 0, WS_U = 128 * MiB, WS_KK = 416 * MiB, WS_A2 = 448 * MiB, WS_MEMN = 449 * MiB, WS_KMEM = 457 * MiB, WS_VMEM = 461 * MiB,
                 WS_SMALL = 465 * MiB, WS_LIST = 466 * MiB, WS_GATE = 468 * MiB;
constexpr size_t WS_H = 128 * MiB, WS_QM = 256 * MiB, WS_OM = 320 * MiB, WS_G = 256 * MiB, WS_UP = 0;

__device__ __forceinline__ float wave_sum(float v) {
#pragma unroll
    for (int o = 1; o < 64; o <<= 1) v += __shfl_xor(v, o);
    return v;
}
__device__ __forceinline__ float wave_max(float v) {
#pragma unroll
    for (int o = 1; o < 64; o <<= 1) v = fmaxf(v, __shfl_xor(v, o));
    return v;
}

__global__ __launch_bounds__(256) void rmsnorm_rows(const float* x, const float* g, float* out, int rows) {
    const int row = blockIdx.x * 4 + (threadIdx.x >> 6), lane = threadIdx.x & 63;
    if (row >= rows) return;
    const float4* xr = (const float4*)(x + (size_t)row * 1024);
    float4 v[4]; float s = 0.f;
#pragma unroll
    for (int j = 0; j < 4; ++j) { v[j] = xr[lane + 64 * j]; s += v[j].x * v[j].x + v[j].y * v[j].y + v[j].z * v[j].z + v[j].w * v[j].w; }
    const float rstd = 1.0f / sqrtf(wave_sum(s) * (1.0f / 1024.0f) + 1e-6f);
    float4* o = (float4*)(out + (size_t)row * 1024);
#pragma unroll
    for (int j = 0; j < 4; ++j) { const float4 gg = ((const float4*)g)[lane + 64 * j]; o[lane + 64 * j] = make_float4(v[j].x * rstd * gg.x, v[j].y * rstd * gg.y, v[j].z * rstd * gg.z, v[j].w * rstd * gg.w); }
}

struct GemmArgs {
    const float* A; int lda; const float* Bm; int ldb; float* C; int ldc; int M, N, K; const float* R;
    const int* cnt; const int* offs; const int* list; const float* gates; size_t bstride; int pad;
};
template <int MODE>
__global__ __launch_bounds__(256) void gemm_f32(GemmArgs g) {
    __shared__ float As[16][65];
    __shared__ float Bs[16][64];
    const int e = blockIdx.z;
    int M = g.M; const int* list = nullptr; const float* gates = nullptr; int off = 0; const float* Bm = g.Bm;
    if (MODE >= 2) { M = g.cnt[e]; list = g.list + (size_t)e * T; gates = g.gates + (size_t)e * T; off = g.offs[e]; Bm += (size_t)e * g.bstride; }
    const int m0 = blockIdx.y * 64, n0 = blockIdx.x * 64;
    if (m0 >= M) return;
    const int tid = threadIdx.x, tx = tid & 15, ty = tid >> 4;
    float acc[4][4];
#pragma unroll
    for (int i = 0; i < 4; ++i)
#pragma unroll
        for (int j = 0; j < 4; ++j) acc[i][j] = 0.f;
    const int ar = tid >> 2, ak = (tid & 3) * 4;
    const float* Arow = nullptr;
    if (m0 + ar < M) { size_t r = (MODE == 2) ? (size_t)list[m0 + ar] : (MODE == 3) ? (size_t)(off + m0 + ar) : (size_t)(m0 + ar); Arow = g.A + r * g.lda; }
    const int bk = tid >> 4, bn = (tid & 15) * 4;
    for (int k0 = 0; k0 < g.K; k0 += 16) {
        float4 a = make_float4(0.f, 0.f, 0.f, 0.f);
        if (Arow) a = *(const float4*)(Arow + k0 + ak);
        As[ak + 0][ar] = a.x; As[ak + 1][ar] = a.y; As[ak + 2][ar] = a.z; As[ak + 3][ar] = a.w;
        const float4 b = *(const float4*)(Bm + (size_t)(k0 + bk) * g.ldb + n0 + bn);
        Bs[bk][bn + 0] = b.x; Bs[bk][bn + 1] = b.y; Bs[bk][bn + 2] = b.z; Bs[bk][bn + 3] = b.w;
        __syncthreads();
#pragma unroll
        for (int kk = 0; kk < 16; ++kk) {
            float av[4], bv[4];
#pragma unroll
            for (int i = 0; i < 4; ++i) av[i] = As[kk][ty * 4 + i];
#pragma unroll
            for (int j = 0; j < 4; ++j) bv[j] = Bs[kk][tx * 4 + j];
#pragma unroll
            for (int i = 0; i < 4; ++i)
#pragma unroll
                for (int j = 0; j < 4; ++j) acc[i][j] += av[i] * bv[j];
        }
        __syncthreads();
    }
#pragma unroll
    for (int i = 0; i < 4; ++i) {
        const int m = m0 + ty * 4 + i;
        if (m >= M) continue;
        if (MODE == 0 || MODE == 1) {
            float* c = g.C + (size_t)m * g.ldc + n0 + tx * 4;
            float4 o = make_float4(acc[i][0], acc[i][1], acc[i][2], acc[i][3]);
            if (MODE == 1) { const float4 r = *(const float4*)(g.R + (size_t)m * g.ldc + n0 + tx * 4); o.x += r.x; o.y += r.y; o.z += r.z; o.w += r.w; }
            *(float4*)c = o;
        } else if (MODE == 2) {
            float* c = g.C + (size_t)(off + m) * g.ldc + n0 + tx * 4;
            *(float4*)c = make_float4(acc[i][0], acc[i][1], acc[i][2], acc[i][3]);
        } else {
            float* c = g.C + (size_t)list[m] * g.ldc + n0 + tx * 4; const float gt = gates[m];
#pragma unroll
            for (int j = 0; j < 4; ++j) atomicAdd(c + j, gt * acc[i][j]);
        }
    }
}

template <int GS>
__global__ __launch_bounds__(256) void group_rmsnorm(float* buf, int ld, int coloff, int ngroups, const float* gain, int gstride, int rows) {
    const int w = blockIdx.x * 4 + (threadIdx.x >> 6), lane = threadIdx.x & 63;
    if (w >= rows * ngroups) return;
    const int row = w / ngroups, gi = w % ngroups;
    float* p = buf + (size_t)row * ld + coloff + gi * GS;
    float v[GS / 64]; float s = 0.f;
#pragma unroll
    for (int j = 0; j < GS / 64; ++j) { v[j] = p[lane + 64 * j]; s += v[j] * v[j]; }
    const float rstd = 1.0f / sqrtf(wave_sum(s) * (1.0f / GS) + 1e-6f);
#pragma unroll
    for (int j = 0; j < GS / 64; ++j) p[lane + 64 * j] = v[j] * rstd * gain[gi * gstride + lane + 64 * j];
}

__global__ __launch_bounds__(256) void qk_norm_rope(float* U, const float* qg, const float* kg) {
    const int w = blockIdx.x * 4 + (threadIdx.x >> 6), lane = threadIdx.x & 63;
    const int row = w / 10, slot = w % 10;
    if (row >= T) return;
    float* p = U + (size_t)row * DIN + (slot < 8 ? 1536 + slot * 64 : 2048 + (slot - 8) * 64);
    const float g = (slot < 8 ? qg : kg)[lane];
    float v = p[lane];
    const float rstd = 1.0f / sqrtf(wave_sum(v * v) * (1.0f / 64.0f) + 1e-6f);
    v = v * rstd * g;
    const int t = row % L; const int pos = (lane < 32) ? (t / 64) : (t % 64);
    const int i = lane & 15;
    const float inv = powf(10000.0f, -(float)i / 16.0f);
    const float ang = (float)pos * inv;
    const float c = cosf(ang), s = sinf(ang);
    const float other = __shfl_xor(v, 16);
    const float o = ((lane & 16) == 0) ? (v * c - other * s) : (v * c + other * s);
    p[lane] = o;
}

__global__ __launch_bounds__(256) void attn_naive(const float* U, float* Y) {
    const int b = blockIdx.z, h = blockIdx.y, q = blockIdx.x * 256 + threadIdx.x;
    const float* qp = U + ((size_t)(b * L + q)) * DIN + 1536 + h * 64;
    float qr[64], o[64];
#pragma unroll
    for (int d = 0; d < 64; d += 4) { const float4 t4 = *(const float4*)(qp + d); qr[d] = t4.x * 0.125f; qr[d + 1] = t4.y * 0.125f; qr[d + 2] = t4.z * 0.125f; qr[d + 3] = t4.w * 0.125f; }
#pragma unroll
    for (int d = 0; d < 64; ++d) o[d] = 0.f;
    float m = -1e30f, l = 0.f;
    const float* kp = U + (size_t)b * L * DIN + 2048 + (h >> 2) * 64;
    for (int s = 0; s < L; ++s) {
        const float4* kr = (const float4*)(kp + (size_t)s * DIN);
        float sc = 0.f;
#pragma unroll
        for (int d = 0; d < 16; ++d) { const float4 k4 = kr[d]; sc += qr[4 * d] * k4.x + qr[4 * d + 1] * k4.y + qr[4 * d + 2] * k4.z + qr[4 * d + 3] * k4.w; }
        if (sc > m) {
            const float c = expf(m - sc); l *= c;
#pragma unroll
            for (int d = 0; d < 64; ++d) o[d] *= c;
            m = sc;
        }
        const float p = expf(sc - m); l += p;
        const float4* vr = (const float4*)(kp + (size_t)s * DIN + 128);
#pragma unroll
        for (int d = 0; d < 16; ++d) { const float4 v4 = vr[d]; o[4 * d] += p * v4.x; o[4 * d + 1] += p * v4.y; o[4 * d + 2] += p * v4.z; o[4 * d + 3] += p * v4.w; }
    }
    const float il = 1.0f / l;
    float* yp = Y + ((size_t)(b * L + q)) * DM + 512 + h * 64;
#pragma unroll
    for (int d = 0; d < 64; d += 4) *(float4*)(yp + d) = make_float4(o[d] * il, o[d + 1] * il, o[d + 2] * il, o[d + 3] * il);
}

__global__ __launch_bounds__(64) void filt_mlp(const float* w1, const float* b1, const float* w2, const float* b2, const float* freq, float* A2) {
    __shared__ float z[33]; __shared__ float a1[64];
    const int pos = blockIdx.x, f = threadIdx.x;
    if (f < 33) {
        const float tt = (float)pos / (float)(L - 1);
        const float w = (2.0f * 3.14159265358979323846f / (float)L) * (float)pos;
        float val;
        if (f == 0) val = tt;
        else { const int j = (f - 1) & 15; const float band = 1e-4f + (float)j * ((15.0f - 1e-4f) / 15.0f); val = (f <= 16) ? cosf(band * w) : sinf(band * w); }
        z[f] = val;
    }
    __syncthreads();
    float s = b1[f];
    for (int i = 0; i < 33; ++i) s += z[i] * w1[i * 64 + f];
    a1[f] = sinf(freq[f] * s);
    __syncthreads();
    float s2 = b2[f];
    for (int i = 0; i < 64; ++i) s2 += a1[i] * w2[i * 64 + f];
    A2[pos * 64 + f] = sinf(freq[64 + f] * s2);
}
__global__ __launch_bounds__(256) void filt_taps(const float* A2, const float* w3, float* KK) {
    const int pos = blockIdx.y, col = blockIdx.x * 256 + threadIdx.x;
    float s = 0.f;
    for (int f = 0; f < 64; ++f) s += A2[pos * 64 + f] * w3[f * 2048 + col];
    const int o = col >> 10, dir = (col >> 9) & 1, c = col & 511;
    const float lo = logf(1e-2f) / 1.5f, hi = logf(1e-2f) / 0.3f;
    const float delta = fabsf(lo + (float)c * ((hi - lo) / 511.0f));
    const float tt = (float)pos / (float)(L - 1);
    s *= expf(-tt * delta);
    if (dir == 0) KK[((size_t)o * 8191 + (4095 + pos)) * 512 + c] = s;
    else if (pos > 0) KK[((size_t)o * 8191 + (4095 - pos)) * 512 + c] = s;
}
__global__ __launch_bounds__(256) void filt_norm(const float* KK, float* invn) {
    const int i = blockIdx.x * 256 + threadIdx.x; if (i >= 1024) return;
    const int o = i >> 9, c = i & 511; float s = 0.f;
    for (int d = 0; d < 8191; ++d) s += fabsf(KK[((size_t)o * 8191 + d) * 512 + c]);
    invn[i] = 1.0f / (s + 1e-6f);
}
__global__ __launch_bounds__(256) void shortconv_inplace(float* U, const float* sw, const float* sb) {
    const int b = blockIdx.y, c = blockIdx.x * 256 + threadIdx.x;
    const float w0 = sw[c], w1 = sw[1536 + c], w2 = sw[3072 + c], bb = sb[c];
    float* p = U + (size_t)b * L * DIN + c;
    float prev = 0.f, cur = p[0];
    for (int t = 0; t < L; ++t) {
        const float nxt = (t + 1 < L) ? p[(size_t)(t + 1) * DIN] : 0.f;
        p[(size_t)t * DIN] = w0 * prev + w1 * cur + w2 * nxt + bb;
        prev = cur; cur = nxt;
    }
}
__global__ __launch_bounds__(256) void longconv_naive(const float* zin, int ldz, int zoff, const float* KK, const float* invn, const float* skip,
                                                      const float* gate, int ldg, int goff, float* out, int ldo, int ooff) {
    const int c = blockIdx.x * 256 + threadIdx.x, t0 = blockIdx.y * 8, b = blockIdx.z;
    float acc[8], w[8];
#pragma unroll
    for (int i = 0; i < 8; ++i) { acc[i] = 0.f; w[i] = KK[(size_t)(t0 + i + 4095) * 512 + c]; }
    const float* zp = zin + (size_t)b * L * ldz + zoff + c;
#pragma unroll 8
    for (int s = 0; s < L; ++s) {
        const float zv = zp[(size_t)s * ldz];
#pragma unroll
        for (int i = 0; i < 8; ++i) acc[i] += w[i] * zv;
        int idx = t0 - s - 1 + 4095; idx = idx < 0 ? 0 : idx;
        const float nw = KK[(size_t)idx * 512 + c];
#pragma unroll
        for (int i = 7; i > 0; --i) w[i] = w[i - 1];
        w[0] = nw;
    }
    const float in = invn[c], sk = skip[c];
#pragma unroll
    for (int i = 0; i < 8; ++i) {
        const size_t r = (size_t)b * L + t0 + i;
        out[r * ldo + ooff + c] = gate[r * ldg + goff + c] * (acc[i] * in + sk * zin[r * ldz + zoff + c]);
    }
}

__global__ __launch_bounds__(256) void memattn_naive(const float* QM, const float* KMEM, const float* VMEM, float* OM) {
    __shared__ float qs[4][128]; __shared__ float ps[4][256];
    const int wv = threadIdx.x >> 6, lane = threadIdx.x & 63;
    const int w = blockIdx.x * 4 + wv; const int row = w >> 2, h = w & 3; const int b = row / L;
    const float* qp = QM + (size_t)row * 512 + h * 128;
    qs[wv][lane] = qp[lane]; qs[wv][lane + 64] = qp[lane + 64];
    __syncthreads();
    const float scale = 0.08838834764831845f;
    float sc[4];
#pragma unroll
    for (int j = 0; j < 4; ++j) {
        const float* kp = KMEM + ((size_t)(b * NMEM + lane + 64 * j)) * 512 + h * 128;
        float s = 0.f;
        for (int d = 0; d < 128; ++d) s += qs[wv][d] * kp[d];
        sc[j] = s * scale;
    }
    const float mx = wave_max(fmaxf(fmaxf(sc[0], sc[1]), fmaxf(sc[2], sc[3])));
    float ls = 0.f;
#pragma unroll
    for (int j = 0; j < 4; ++j) { sc[j] = expf(sc[j] - mx); ls += sc[j]; ps[wv][lane + 64 * j] = sc[j]; }
    const float il = 1.0f / wave_sum(ls);
    __syncthreads();
    float o0 = 0.f, o1 = 0.f;
    for (int j = 0; j < 256; ++j) {
        const float* vp = VMEM + ((size_t)(b * NMEM + j)) * 512 + h * 128;
        const float p = ps[wv][j];
        o0 += p * vp[lane]; o1 += p * vp[lane + 64];
    }
    float* op = OM + (size_t)row * 512 + h * 128;
    op[lane] = o0 * il; op[lane + 64] = o1 * il;
}

__global__ __launch_bounds__(256) void router_naive(const float* H3, const float* wrg, const float* brg, const float* wre, const float* bre, int* cnt, int* list, float* gates) {
    const int tok = blockIdx.x * 4 + (threadIdx.x >> 6), lane = threadIdx.x & 63;
    const float* hp = H3 + (size_t)tok * 1024;
    float acc[20];
#pragma unroll
    for (int j = 0; j < 20; ++j) acc[j] = 0.f;
    for (int i = 0; i < 16; ++i) {
        const int k = lane + 64 * i; const float hv = hp[k];
#pragma unroll
        for (int j = 0; j < 4; ++j) acc[j] += hv * wrg[k * 4 + j];
#pragma unroll
        for (int j = 0; j < 16; ++j) acc[4 + j] += hv * wre[k * 16 + j];
    }
#pragma unroll
    for (int j = 0; j < 20; ++j) acc[j] = wave_sum(acc[j]);
    if (lane == 0) {
        float gl[4]; float gm = -1e30f;
#pragma unroll
        for (int j = 0; j < 4; ++j) { gl[j] = acc[j] + brg[j]; gm = fmaxf(gm, gl[j]); }
        float gs = 0.f; float gp[4];
#pragma unroll
        for (int j = 0; j < 4; ++j) { gp[j] = expf(gl[j] - gm); gs += gp[j]; }
        int gi = 0; float best = gp[0];
#pragma unroll
        for (int j = 1; j < 4; ++j) if (gp[j] > best) { best = gp[j]; gi = j; }
        const float pg = best / gs;
        float el[4]; float em = -1e30f;
#pragma unroll
        for (int j = 0; j < 4; ++j) {
            float v = 0.f;
#pragma unroll
            for (int q = 0; q < 4; ++q) if (q == gi) v = acc[4 + q * 4 + j] + bre[q * 4 + j];
            el[j] = v; em = fmaxf(em, v);
        }
        float ep[4];
#pragma unroll
        for (int j = 0; j < 4; ++j) ep[j] = expf(el[j] - em);
        int e1 = 0; float p1 = ep[0];
#pragma unroll
        for (int j = 1; j < 4; ++j) if (ep[j] > p1) { p1 = ep[j]; e1 = j; }
        int e2 = -1; float p2 = -1.f;
#pragma unroll
        for (int j = 0; j < 4; ++j) if (j != e1 && ep[j] > p2) { p2 = ep[j]; e2 = j; }
        const float w1 = pg * p1 / (p1 + p2), w2 = pg * p2 / (p1 + p2);
        const int g1 = gi * 4 + e1, g2 = gi * 4 + e2;
        int pos = atomicAdd(&cnt[g1], 1); list[(size_t)g1 * T + pos] = tok; gates[(size_t)g1 * T + pos] = w1;
        pos = atomicAdd(&cnt[g2], 1); list[(size_t)g2 * T + pos] = tok; gates[(size_t)g2 * T + pos] = w2;
    }
}
__global__ void moe_offsets(const int* cnt, int* offs) { if (threadIdx.x == 0) { int s = 0; for (int e = 0; e < 16; ++e) { offs[e] = s; s += cnt[e]; } offs[16] = s; } }
__global__ __launch_bounds__(256) void swiglu(float* G, const float* UP, size_t n) {
    size_t i = (size_t)blockIdx.x * 256 + threadIdx.x; if (i >= n) return;
    const float g = G[i]; G[i] = (g / (1.0f + expf(-g))) * UP[i];
}
}

extern "C" void kernel_launch(void* const* d_in, const int* in_sizes, int n_in, void* d_out, int out_size, void* d_ws, size_t ws_size, hipStream_t stream) {
    using namespace nv;
    const float* x = (const float*)d_in[0]; const float* mem = (const float*)d_in[1];
    auto F = [&](int i) { return (const float*)d_in[i]; };
    unsigned char* ws = (unsigned char*)d_ws; float* out = (float*)d_out;
    float* XN = (float*)(ws + WS_XN); float* U = (float*)(ws + WS_U); float* KK = (float*)(ws + WS_KK); float* A2 = (float*)(ws + WS_A2);
    float* MEMN = (float*)(ws + WS_MEMN); float* KMEM = (float*)(ws + WS_KMEM); float* VMEM = (float*)(ws + WS_VMEM);
    float* invn = (float*)(ws + WS_SMALL); int* cnt = (int*)(ws + WS_SMALL + 8192); int* offs = cnt + 32;
    int* list = (int*)(ws + WS_LIST); float* gates = (float*)(ws + WS_GATE);
    float* Y = XN; float* Z2 = out; float* H = (float*)(ws + WS_H); float* QM = (float*)(ws + WS_QM); float* OM = (float*)(ws + WS_OM);
    float* G = (float*)(ws + WS_G); float* UP = (float*)(ws + WS_UP);
    auto gemm0 = [&](const float* A, int lda, const float* Bm, int ldb, float* C, int ldc, int M, int N, int K, const float* R) {
        GemmArgs g{}; g.A = A; g.lda = lda; g.Bm = Bm; g.ldb = ldb; g.C = C; g.ldc = ldc; g.M = M; g.N = N; g.K = K; g.R = R;
        if (R) hipLaunchKernelGGL(gemm_f32<1>, dim3(N / 64, M / 64, 1), dim3(256), 0, stream, g);
        else hipLaunchKernelGGL(gemm_f32<0>, dim3(N / 64, M / 64, 1), dim3(256), 0, stream, g);
    };
    hipLaunchKernelGGL(rmsnorm_rows, dim3(T / 4), dim3(256), 0, stream, x, F(2), XN, T);
    gemm0(XN, 1024, F(3), DIN, U, DIN, T, DIN, 1024, nullptr);
    hipLaunchKernelGGL(filt_mlp, dim3(L), dim3(64), 0, stream, F(6), F(7), F(8), F(9), F(11), A2);
    hipLaunchKernelGGL(filt_taps, dim3(8, L), dim3(256), 0, stream, A2, F(10), KK);
    hipLaunchKernelGGL(filt_norm, dim3(4), dim3(256), 0, stream, KK, invn);
    hipLaunchKernelGGL(shortconv_inplace, dim3(6, B), dim3(256), 0, stream, U, F(4), F(5));
    hipLaunchKernelGGL(qk_norm_rope, dim3(T * 10 / 4), dim3(256), 0, stream, U, F(13), F(14));
    hipLaunchKernelGGL(longconv_naive, dim3(2, L / 8, B), dim3(256), 0, stream, U, DIN, 0, KK, invn, F(12), U, DIN, 512, Z2, 512, 0);
    hipLaunchKernelGGL(longconv_naive, dim3(2, L / 8, B), dim3(256), 0, stream, Z2, 512, 0, KK + (size_t)8191 * 512, invn + 512, F(12) + 512, U, DIN, 1024, Y, 1024, 0);
    hipLaunchKernelGGL(attn_naive, dim3(L / 256, 8, B), dim3(256), 0, stream, U, Y);
    hipLaunchKernelGGL(group_rmsnorm<64>, dim3(T * 8 / 4), dim3(256), 0, stream, Y, 1024, 0, 8, F(15), 64, T);
    hipLaunchKernelGGL(group_rmsnorm<64>, dim3(T * 8 / 4), dim3(256), 0, stream, Y, 1024, 512, 8, F(16), 64, T);
    gemm0(Y, 1024, F(17), 1024, out, 1024, T, 1024, 1024, x);
    hipLaunchKernelGGL(rmsnorm_rows, dim3(B * NMEM / 4), dim3(256), 0, stream, mem, F(19), MEMN, B * NMEM);
    gemm0(MEMN, 1024, F(21), 512, KMEM, 512, B * NMEM, 512, 1024, nullptr);
    gemm0(MEMN, 1024, F(22), 512, VMEM, 512, B * NMEM, 512, 1024, nullptr);
    hipLaunchKernelGGL(group_rmsnorm<128>, dim3(B * NMEM * 4 / 4), dim3(256), 0, stream, KMEM, 512, 0, 4, F(24), 0, B * NMEM);
    hipLaunchKernelGGL(rmsnorm_rows, dim3(T / 4), dim3(256), 0, stream, out, F(18), H, T);
    gemm0(H, 1024, F(20), 512, QM, 512, T, 512, 1024, nullptr);
    hipLaunchKernelGGL(group_rmsnorm<128>, dim3(T * 4 / 4), dim3(256), 0, stream, QM, 512, 0, 4, F(23), 0, T);
    hipLaunchKernelGGL(memattn_naive, dim3(T * 4 / 4), dim3(256), 0, stream, QM, KMEM, VMEM, OM);
    gemm0(OM, 512, F(25), 1024, out, 1024, T, 1024, 512, out);
    hipLaunchKernelGGL(rmsnorm_rows, dim3(T / 4), dim3(256), 0, stream, out, F(26), H, T);
    hipMemsetAsync(cnt, 0, 256, stream);
    hipLaunchKernelGGL(router_naive, dim3(T / 4), dim3(256), 0, stream, H, F(27), F(28), F(29), F(30), cnt, list, gates);
    hipLaunchKernelGGL(moe_offsets, dim3(1), dim3(64), 0, stream, cnt, offs);
    {
        GemmArgs g{}; g.A = H; g.lda = 1024; g.Bm = F(31); g.ldb = 512; g.C = G; g.ldc = 512; g.M = T; g.N = 512; g.K = 1024; g.cnt = cnt; g.offs = offs; g.list = list; g.gates = gates; g.bstride = (size_t)1024 * 512;
        hipLaunchKernelGGL(gemm_f32<2>, dim3(512 / 64, T / 64, 16), dim3(256), 0, stream, g);
        g.Bm = F(32); g.C = UP;
        hipLaunchKernelGGL(gemm_f32<2>, dim3(512 / 64, T / 64, 16), dim3(256), 0, stream, g);
        hipLaunchKernelGGL(swiglu, dim3((unsigned)(((size_t)2 * T * 512 + 255) / 256)), dim3(256), 0, stream, G, UP, (size_t)2 * T * 512);
        GemmArgs g2{}; g2.A = G; g2.lda = 512; g2.Bm = F(33); g2.ldb = 1024; g2.C = out; g2.ldc = 1024; g2.M = T; g2.N = 1024; g2.K = 512; g2.cnt = cnt; g2.offs = offs; g2.list = list; g2.gates = gates; g2.bstride = (size_t)512 * 1024;
        hipLaunchKernelGGL(gemm_f32<3>, dim3(1024 / 64, T / 64, 16), dim3(256), 0, stream, g2);
    }
}
```

```cpp
#include <hip/hip_runtime.h>
#include <cstdio>
#include <cstdint>
#include <cmath>
#ifdef MK_PATCH
#define MK_PATCHV MK_PATCH
#else
#define MK_PATCHV 0
#endif
#ifndef MK_STAGE
#define MK_STAGE 99
#endif
#define GAS __attribute__((address_space(1)))
#define LAS __attribute__((address_space(3)))
typedef unsigned short bf16_t;
typedef short bf16x8 __attribute__((ext_vector_type(8)));
typedef short s16x4 __attribute__((ext_vector_type(4)));
typedef float f32x4 __attribute__((ext_vector_type(4)));
typedef float f32x2 __attribute__((ext_vector_type(2)));
typedef float f32x16 __attribute__((ext_vector_type(16)));
typedef unsigned u32x4 __attribute__((ext_vector_type(4)));
typedef unsigned u32x2 __attribute__((ext_vector_type(2)));

constexpr int NB = 8, SEQ = 4096, T = NB * SEQ, DM = 1024, DIN = 2304, NMEMT = NB * 256;
constexpr int NWAVES = 8;
constexpr float EPSN = 1e-6f;

constexpr size_t MiBx = 1u << 20;
constexpr size_t WS_CTL = 0, CTL_ZERO_BYTES = 1 * MiBx;
constexpr size_t WS_WR = 1 * MiBx;
constexpr size_t WS_ROPE = WS_WR + 98304;
constexpr size_t WS_WIN = 2 * MiBx;
constexpr size_t WS_WOUT = 8 * MiBx;
constexpr size_t WS_WQM = 10 * MiBx;
constexpr size_t WS_WKV = 11 * MiBx;
constexpr size_t WS_WOM = 13 * MiBx;
constexpr size_t WS_WGU = 14 * MiBx;
constexpr size_t WS_WD = 46 * MiBx;
constexpr size_t WS_MEMN = 62 * MiBx;
constexpr size_t WS_KVM = 66 * MiBx;
constexpr size_t WS_KF = 70 * MiBx;
constexpr size_t WS_MOE = 86 * MiBx;
constexpr size_t WS_XN = 96 * MiBx;
constexpr size_t WS_UHT = 336 * MiBx;
constexpr size_t WS_QKV = 432 * MiBx;
constexpr size_t WS_YHT = 224 * MiBx;
constexpr size_t WS_Y = 160 * MiBx;
constexpr size_t WS_ZS = 256 * MiBx;
constexpr size_t WS_QM = 336 * MiBx, WS_OM = 368 * MiBx;
constexpr size_t WS_END = 480 * MiBx;
constexpr int CW_TMO = 0, CW_BAR = 4096;
constexpr int CW_FN = 8192;
constexpr int CW_CNT = 9472;
constexpr int CW_SS1 = 16384, CW_SS2 = CW_SS1 + T;
static_assert((CW_SS2 + T) * 4 <= (int)CTL_ZERO_BYTES, "ctl region");

constexpr int RING_BYTES = 131072;
constexpr int LDS_BYTES = 147456;
constexpr int MISC_OFF = LDS_BYTES - 512;

#define LDS_WAIT() asm volatile("s_waitcnt lgkmcnt(0)" ::: "memory")
#define VM_WAIT() asm volatile("s_waitcnt vmcnt(0)" ::: "memory")
__device__ __forceinline__ unsigned f2bf(float f) { unsigned u = __builtin_bit_cast(unsigned, f); return (u + 0x7fffu + ((u >> 16) & 1u)) >> 16; }
__device__ __forceinline__ unsigned pk2(float lo, float hi) { return f2bf(lo) | (f2bf(hi) << 16); }
__device__ __forceinline__ float bf2f(unsigned short b) { return __builtin_bit_cast(float, (unsigned)b << 16); }
__device__ __forceinline__ float bflo(unsigned w) { return __builtin_bit_cast(float, w << 16); }
__device__ __forceinline__ float bfhi(unsigned w) { return __builtin_bit_cast(float, w & 0xffff0000u); }
__device__ __forceinline__ float wsum(float v) {
#pragma unroll
    for (int o = 1; o < 64; o <<= 1) v += __shfl_xor(v, o);
    return v;
}

namespace pg8 {
constexpr int BM = 256, BK = 64, HALF = 128, HTB = HALF * BK * 2, STAGE_BYTES = 8 * HTB;
__host__ __device__ __forceinline__ int lds_byte(int r, int c) { const int st = (r >> 4) * 2 + (c >> 5), rr = r & 15, cc = c & 31, ob = rr * 64 + cc * 2; return st * 1024 + (ob ^ (((ob >> 9) & 1) << 5)); }
__host__ __device__ __forceinline__ void stage_rc(int b, int& R, int& C) { const int st = b / 1024, sb = b % 1024, swz = sb ^ (((sb >> 9) & 1) << 5); R = (st >> 1) * 16 + swz / 64; C = (st & 1) * 32 + (swz % 64) / 2; }
__host__ __device__ __forceinline__ int perm32(int rho) { const int n = rho >> 4, i = rho & 15; return 8 * (i >> 2) + 4 * n + (i & 3); }

struct Unit { const char* A; const char* B; int pm, pn, aux, flags; };
__device__ __forceinline__ unsigned cvt_pk_bf16(float lo, float hi) { unsigned r; asm volatile("v_cvt_pk_bf16_f32 %0, %1, %2" : "=v"(r) : "v"(lo), "v"(hi)); return r; }

template <class Epi, class Sched>
__device__ __forceinline__ void gemm_phase(LAS unsigned char* lds, const int lda, const int ldb, const int K, const Sched& S, const Epi& E) {
    const int tid = threadIdx.x, wid = __builtin_amdgcn_readfirstlane(tid >> 6), lane = tid & 63, wr = wid >> 2, wc = wid & 3, fr = lane & 15, fq = lane >> 4;
    const int nt = K / BK;
    unsigned voffA[2], voffB[2];
#pragma unroll
    for (int i = 0; i < 2; ++i) { int R, C; stage_rc(tid * 16 + i * 8192, R, C); const int Rb = (R & ~31) + perm32(R & 31);
        voffA[i] = (unsigned)(R * lda + C) * 2u; voffB[i] = (unsigned)(Rb * ldb + C) * 2u; }
    const size_t kstep = (size_t)(BK * 2);
    const size_t hstepA = (size_t)HALF * lda * 2, hstepB = (size_t)HALF * ldb * 2;
    const unsigned ldsw = (unsigned)wid * 1024u;
    const int aoff = lds_byte(wr * 64 + fr, fq * 8), boff = lds_byte(wc * 32 + fr, fq * 8);
#define PG8_SA(b, h) (((b) * 2 + (h)) * HTB)
#define PG8_SB(b, h) ((4 + (b) * 2 + (h)) * HTB)
#define PG8_STAGE(bufoff, gbase, voff) do { _Pragma("unroll") for (int _i = 0; _i < 2; ++_i) \
        __builtin_amdgcn_global_load_lds((const unsigned*)((const char*)(gbase) + (voff)[_i]), (LAS unsigned*)(lds + (bufoff) + ldsw + _i * 8192), 16, 0, 0); } while (0)
#define PG8_LDA(dst, b, h) do { _Pragma("unroll") for (int m = 0; m < 4; ++m) _Pragma("unroll") for (int k = 0; k < 2; ++k) dst[m][k] = *(const LAS bf16x8*)(lds + PG8_SA(b, h) + aoff + m * 2048 + k * 1024); } while (0)
#define PG8_LDB(dst, b, h) do { _Pragma("unroll") for (int n = 0; n < 2; ++n) _Pragma("unroll") for (int k = 0; k < 2; ++k) dst[n][k] = *(const LAS bf16x8*)(lds + PG8_SB(b, h) + boff + n * 2048 + k * 1024); } while (0)
#define PG8_MMA(ai, bj, At, Bt) do { __builtin_amdgcn_s_setprio(1); _Pragma("unroll") for (int m = 0; m < 4; ++m) _Pragma("unroll") for (int n = 0; n < 2; ++n) _Pragma("unroll") for (int k = 0; k < 2; ++k) \
        acc[ai][bj][m][n] = __builtin_amdgcn_mfma_f32_16x16x32_bf16(Bt[n][k], At[m][k], acc[ai][bj][m][n], 0, 0, 0); __builtin_amdgcn_s_setprio(0); } while (0)
#define PG8_WAIT_V(n) asm volatile("s_waitcnt vmcnt(" #n ")" ::: "memory")
#define PG8_WAIT_L(n) asm volatile("s_waitcnt lgkmcnt(" #n ")" ::: "memory")
#define PG8_BAR __builtin_amdgcn_s_barrier()
#define PG8_SCHED __builtin_amdgcn_sched_barrier(0)
#define PG8_ZERO() do { _Pragma("unroll") for (int a = 0; a < 2; ++a) _Pragma("unroll") for (int b = 0; b < 2; ++b) _Pragma("unroll") for (int m = 0; m < 4; ++m) _Pragma("unroll") for (int n = 0; n < 2; ++n) acc[a][b][m][n] = (f32x4){0.f, 0.f, 0.f, 0.f}; } while (0)
    Unit cur, nxt; int ui = 0;
    if (!S.next(0, cur)) return;
    f32x4 acc[2][2][4][2];
    PG8_ZERO();
    bf16x8 At[4][2], B0[2][2], B1[2][2];
    const char* cA = cur.A; const char* cB = cur.B;
    PG8_STAGE(PG8_SB(0, 0), cB, voffB); PG8_STAGE(PG8_SB(0, 1), cB + hstepB, voffB); PG8_STAGE(PG8_SA(0, 0), cA, voffA); PG8_STAGE(PG8_SA(0, 1), cA + hstepA, voffA);
    if (wr == 1) PG8_BAR;
    PG8_WAIT_V(2); PG8_BAR;
    PG8_STAGE(PG8_SB(1, 0), cB + kstep, voffB); PG8_STAGE(PG8_SA(1, 0), cA + kstep, voffA); PG8_STAGE(PG8_SB(1, 1), cB + hstepB + kstep, voffB);
    PG8_WAIT_V(6); PG8_BAR;
    for (;;) {
        const bool has_next = S.next(ui + 1, nxt);
        const char* nA = has_next ? nxt.A : cA; const char* nB = has_next ? nxt.B : cB;
        for (int t = 0; t < nt; t += 2) {
            const bool last = (t == nt - 2);
            const char* a1 = cA + (size_t)(t + 1) * kstep;
            const char* a2 = last ? nA : cA + (size_t)(t + 2) * kstep; const char* b2 = last ? nB : cB + (size_t)(t + 2) * kstep;
            const char* a3 = a2 + kstep; const char* b3 = b2 + kstep;
            PG8_LDB(B0, 0, 0); PG8_LDB(B1, 0, 1); PG8_SCHED; PG8_LDA(At, 0, 0); PG8_STAGE(PG8_SA(1, 1), a1 + hstepA, voffA);
            PG8_WAIT_V(8); PG8_WAIT_L(0); PG8_BAR; PG8_MMA(0, 0, At, B0); PG8_MMA(0, 1, At, B1); PG8_BAR; PG8_SCHED;
            PG8_LDA(At, 0, 1); PG8_STAGE(PG8_SB(0, 0), b2, voffB); PG8_STAGE(PG8_SB(0, 1), b2 + hstepB, voffB); PG8_STAGE(PG8_SA(0, 0), a2, voffA);
            PG8_WAIT_V(8); PG8_WAIT_L(0); PG8_BAR; PG8_MMA(1, 0, At, B0); PG8_MMA(1, 1, At, B1); PG8_BAR; PG8_SCHED;
            PG8_LDB(B0, 1, 0); PG8_LDB(B1, 1, 1); PG8_SCHED; PG8_LDA(At, 1, 0); PG8_STAGE(PG8_SA(0, 1), a2 + hstepA, voffA);
            PG8_WAIT_V(8); PG8_WAIT_L(0); PG8_BAR; PG8_MMA(0, 0, At, B0); PG8_MMA(0, 1, At, B1); PG8_BAR; PG8_SCHED;
            PG8_LDA(At, 1, 1); PG8_STAGE(PG8_SB(1, 0), b3, voffB); PG8_STAGE(PG8_SB(1, 1), b3 + hstepB, voffB); PG8_STAGE(PG8_SA(1, 0), a3, voffA);
            PG8_WAIT_V(8); PG8_WAIT_L(0); PG8_BAR; PG8_MMA(1, 0, At, B0); PG8_MMA(1, 1, At, B1); PG8_BAR; PG8_SCHED;
        }
        if (wr == 0) PG8_BAR;
        if (cur.flags & 2) E(acc, cur, wr, wc, fr, fq);
        if (!has_next) break;
        if (nxt.flags & 1) PG8_ZERO();
        cur = nxt; cA = nA; cB = nB; ++ui;
        if (wr == 1) PG8_BAR;
    }
    PG8_WAIT_V(0);
    PG8_BAR;
#undef PG8_SA
#undef PG8_SB
#undef PG8_STAGE
#undef PG8_LDA
#undef PG8_LDB
#undef PG8_MMA
#undef PG8_WAIT_V
#undef PG8_WAIT_L
#undef PG8_BAR
#undef PG8_SCHED
#undef PG8_ZERO
}
}

#define XB_TMO      128
#define XB_XCNT(j)  (256  + 64 * (j))
#define XB_XSUB(j)  (1280 + 64 * (j))
#define XB_XGEN(j)  (2304 + 64 * (j))
#define XB_TOP      3328
#define XB_TOPGEN   3392
#define XCD_BAR_WORDS 3456
#define XB_SPIN_CAP (1u << 18)
__device__ __forceinline__ unsigned xb_ld(unsigned* p)              { return __hip_atomic_load(p, __ATOMIC_RELAXED, __HIP_MEMORY_SCOPE_AGENT); }
__device__ __forceinline__ unsigned xb_add(unsigned* p, unsigned v) { return __hip_atomic_fetch_add(p, v, __ATOMIC_RELAXED, __HIP_MEMORY_SCOPE_AGENT); }
__device__ __forceinline__ unsigned xb_xcc_id() { return (unsigned)__builtin_amdgcn_s_getreg((3 << 11) | 20) & 0xFu; }
#define XB_SPIN(cond, bar) do { unsigned _sp = 0; while (cond) { __builtin_amdgcn_s_sleep(1); \
    if ((++_sp & 255u) == 0u) { if (xb_ld(&(bar)[XB_TMO])) break; if (_sp > XB_SPIN_CAP) { atomicAdd(&(bar)[XB_TMO], 1u); break; } } } } while (0)
struct XcdBarrier { unsigned* bar; unsigned x; volatile LAS unsigned* st; };
__device__ __forceinline__ XcdBarrier xcd_barrier_post(unsigned* bar, volatile LAS unsigned* st) {
    XcdBarrier b; b.bar = bar; b.x = xb_xcc_id(); b.st = st;
    if (threadIdx.x == 0) (void)xb_add(&bar[XB_XCNT(b.x)], 1u);
    return b;
}
__device__ __forceinline__ void xcd_barrier_complete(unsigned* bar, unsigned x, unsigned& nloc, unsigned& nx) {
    const unsigned G = gridDim.x * gridDim.y * gridDim.z;
    unsigned sum, cnt, mine, sp = 0u;
    for (;;) {
        sum = 0u; cnt = 0u; mine = 0u;
#pragma unroll
        for (unsigned j = 0; j < 16; ++j) { const unsigned c = xb_ld(&bar[XB_XCNT(j)]); sum += c; cnt += (c > 0u) ? 1u : 0u; mine = (j == x) ? c : mine; }
        if (sum == G) break;
        __builtin_amdgcn_s_sleep(1);
        if ((++sp & 255u) == 0u) { if (xb_ld(&bar[XB_TMO])) break; if (sp > XB_SPIN_CAP) { atomicAdd(&bar[XB_TMO], 1u); break; } }
    }
    nloc = mine > 0u ? mine : 1u; nx = cnt > 0u ? cnt : 1u;
}
__device__ __forceinline__ void xcd_barrier(const XcdBarrier& b) {
    asm volatile("s_waitcnt vmcnt(0)" ::: "memory");
    __syncthreads();
    if (threadIdx.x == 0) {
        unsigned* bar = b.bar;
        __builtin_amdgcn_s_waitcnt(0);
        unsigned nloc = b.st[0], nx = b.st[1];
        if (nloc == 0u) { xcd_barrier_complete(bar, b.x, nloc, nx); b.st[0] = nloc; b.st[1] = nx; }
        const unsigned old = xb_add(&bar[XB_XSUB(b.x)], 1u);
        const unsigned gen = old / nloc;
        if (old + 1u == (gen + 1u) * nloc) {
            __builtin_amdgcn_fence(__ATOMIC_RELEASE, "agent");
            asm volatile("s_waitcnt vmcnt(0)" ::: "memory");
            const unsigned og = xb_add(&bar[XB_TOP], 1u);
            const unsigned tg = og / nx;
            if (og + 1u == (tg + 1u) * nx) xb_add(&bar[XB_TOPGEN], 1u);
            else XB_SPIN(xb_ld(&bar[XB_TOPGEN]) == tg, bar);
            __builtin_amdgcn_fence(__ATOMIC_ACQUIRE, "agent");
            xb_add(&bar[XB_XGEN(b.x)], 1u);
            asm volatile("s_waitcnt vmcnt(0)" ::: "memory");
        } else {
            XB_SPIN(xb_ld(&bar[XB_XGEN(b.x)]) == gen, bar);
            __builtin_amdgcn_fence(__ATOMIC_ACQUIRE, "agent");
            asm volatile("s_waitcnt vmcnt(0)" ::: "memory");
        }
    }
    __syncthreads();
}

struct Frame {
    LAS unsigned char* lds;
    unsigned* ctl;
    unsigned char* ws;
    const float* const* in;
    float* out;
    int tid, lane, wave, vcu, G;
};

__device__ __forceinline__ void p0_transpose_item(const float* W, int N, int k0, int n0, bf16_t* dst, int ldk, const float* gain, LAS float* scr, int lane) {
#pragma unroll 8
    for (int i = 0; i < 32; ++i) { const int kk = 2 * i + (lane >> 5); float v = W[(size_t)(k0 + kk) * N + n0 + (lane & 31)]; if (gain) v *= gain[k0 + kk]; scr[kk * 33 + (lane & 31)] = v; }
    LDS_WAIT(); asm volatile("" ::: "memory");
    const int c = lane & 7;
#pragma unroll
    for (int j = 0; j < 4; ++j) { const int n = (lane >> 3) + 8 * j; const LAS float* s = scr + (8 * c) * 33 + n;
        u32x4 o; o.x = pk2(s[0 * 33], s[1 * 33]); o.y = pk2(s[2 * 33], s[3 * 33]); o.z = pk2(s[4 * 33], s[5 * 33]); o.w = pk2(s[6 * 33], s[7 * 33]);
        *(GAS u32x4*)(dst + (size_t)n * ldk + 8 * c) = o; }
    LDS_WAIT(); asm volatile("" ::: "memory");
}
__device__ __forceinline__ void rms_row_to_bf16(const float* xrow, bf16_t* orow, int lane) {
    const GAS f32x4* xr = (const GAS f32x4*)xrow + lane;
    f32x4 v[4]; float s = 0.f;
#pragma unroll
    for (int j = 0; j < 4; ++j) { v[j] = xr[64 * j]; s += (v[j].x * v[j].x + v[j].y * v[j].y) + (v[j].z * v[j].z + v[j].w * v[j].w); }
    const float rstd = 1.f / sqrtf(wsum(s) * (1.f / 1024.f) + EPSN);
    GAS unsigned long long* o8 = (GAS unsigned long long*)orow + lane;
#pragma unroll
    for (int j = 0; j < 4; ++j) o8[64 * j] = (unsigned long long)pk2(v[j].x * rstd, v[j].y * rstd) | ((unsigned long long)pk2(v[j].z * rstd, v[j].w * rstd) << 32);
}
__device__ __forceinline__ void p0_prologue(Frame& F) {
    LAS float* scr = (LAS float*)(F.lds + F.wave * 16384);
    const int gw = F.vcu * NWAVES + F.wave, NGW = F.G * NWAVES;
    const float* const* in = F.in;
    unsigned char* ws = F.ws;
    {
        LAS float* zs = (LAS float*)(F.lds + 8 * 16384);
        LAS float* a1s = zs + 16 * 34;
        LAS float* a2s = a1s + 16 * 64;
        const float* w1 = in[6]; const float* b1 = in[7]; const float* w2 = in[8]; const float* b2 = in[9]; const float* w3 = in[10]; const float* freq = in[11];
        bf16_t* KF = (bf16_t*)(ws + WS_KF); float* FN = (float*)(F.ctl + CW_FN);
        for (int pb = F.vcu; pb < SEQ / 16; pb += F.G) {
            __syncthreads();
            for (int zi = F.tid; zi < 16 * 33; zi += NWAVES * 64) {
                const int p = zi / 33, f = zi % 33, pos = pb * 16 + p;
                const float tt = (float)pos / (float)(SEQ - 1);
                const float w = (2.0f * 3.14159265358979323846f / (float)SEQ) * (float)pos;
                float val;
                if (f == 0) val = tt;
                else { const int j = (f - 1) & 15; const float band = 1e-4f + (float)j * ((15.0f - 1e-4f) / 15.0f); val = (f <= 16) ? cosf(band * w) : sinf(band * w); }
                zs[p * 34 + f] = val;
            }
            __syncthreads();
            {
#pragma unroll
                for (int pp = 0; pp < 2; ++pp) { const int p = F.wave * 2 + pp; float s = b1[F.lane];
                    for (int i = 0; i < 33; ++i) s += zs[p * 34 + i] * w1[i * 64 + F.lane];
                    a1s[p * 64 + F.lane] = sinf(freq[F.lane] * s); }
            }
            __syncthreads();
            {
#pragma unroll
                for (int pp = 0; pp < 2; ++pp) { const int p = F.wave * 2 + pp; float s = b2[F.lane];
                    for (int i = 0; i < 64; ++i) s += a1s[p * 64 + i] * w2[i * 64 + F.lane];
                    a2s[p * 64 + F.lane] = sinf(freq[64 + F.lane] * s); }
            }
            __syncthreads();
#pragma unroll 1
            for (int hh = 0; hh < 2; ++hh) {
            float acc[8][4];
#pragma unroll
            for (int p = 0; p < 8; ++p)
#pragma unroll
                for (int j = 0; j < 4; ++j) acc[p][j] = 0.f;
#pragma unroll 2
            for (int f = 0; f < 64; ++f) {
                float wv[4];
#pragma unroll
                for (int j = 0; j < 4; ++j) wv[j] = w3[f * 2048 + F.tid + 512 * j];
#pragma unroll
                for (int p = 0; p < 8; ++p) { const float a = a2s[(hh * 8 + p) * 64 + f];
#pragma unroll
                    for (int j = 0; j < 4; ++j) acc[p][j] += a * wv[j]; }
            }
            const float dlo = logf(1e-2f) / 1.5f, dhi = logf(1e-2f) / 0.3f;
#pragma unroll
            for (int j = 0; j < 4; ++j) {
                const int col = F.tid + 512 * j, o = col >> 10, dir = (col >> 9) & 1, c = col & 511;
                const float delta = fabsf(dlo + (float)c * ((dhi - dlo) / 511.0f));
                bf16_t* kf = KF + ((size_t)o * 512 + c) * 8192;
                float asum = 0.f;
#pragma unroll
                for (int p = 0; p < 8; ++p) {
                    const int pos = pb * 16 + hh * 8 + p;
                    const float v = acc[p][j] * expf(-((float)pos / (float)(SEQ - 1)) * delta);
                    if (dir == 0) { kf[4096 - pos] = (bf16_t)f2bf(v); asum += fabsf(v); }
                    else if (pos > 0) { kf[4096 + pos] = (bf16_t)f2bf(v); asum += fabsf(v); }
                }
                if (dir == 0 && pb == 0 && hh == 0) kf[0] = 0;
                atomicAdd(&FN[o * 512 + c], asum);
            }
            }
        }
        __syncthreads();
    }
    {
        constexpr int I_IN = 16 * 72, I_OUT = 16 * 32, I_Q = 16 * 16, I_OM = 8 * 32, I_G = 16 * 256, I_D = 16 * 256;
        constexpr int NITEMS = I_IN + I_OUT + 3 * I_Q + I_OM + 2 * I_G + I_D;
        for (int it = gw; it < NITEMS; it += NGW) {
            int r = it;
            if (r < I_IN) { const int kb = r / 72, nb = r % 72; p0_transpose_item(in[3], DIN, 64 * kb, 32 * nb, (bf16_t*)(ws + WS_WIN) + (size_t)(32 * nb) * 1024 + 64 * kb, 1024, in[2], scr, F.lane); continue; } r -= I_IN;
            if (r < I_OUT) { const int kb = r / 32, nb = r % 32; const float* gn = (kb < 8) ? in[15] : in[16] - 512; p0_transpose_item(in[17], 1024, 64 * kb, 32 * nb, (bf16_t*)(ws + WS_WOUT) + (size_t)(32 * nb) * 1024 + 64 * kb, 1024, gn, scr, F.lane); continue; } r -= I_OUT;
            if (r < I_Q) { const int kb = r / 16, nb = r % 16; p0_transpose_item(in[20], 512, 64 * kb, 32 * nb, (bf16_t*)(ws + WS_WQM) + (size_t)(32 * nb) * 1024 + 64 * kb, 1024, in[18], scr, F.lane); continue; } r -= I_Q;
            if (r < I_Q) { const int kb = r / 16, nb = r % 16; p0_transpose_item(in[21], 512, 64 * kb, 32 * nb, (bf16_t*)(ws + WS_WKV) + (size_t)(32 * nb) * 1024 + 64 * kb, 1024, in[19], scr, F.lane); continue; } r -= I_Q;
            if (r < I_Q) { const int kb = r / 16, nb = r % 16; p0_transpose_item(in[22], 512, 64 * kb, 32 * nb, (bf16_t*)(ws + WS_WKV) + (size_t)(512 + 32 * nb) * 1024 + 64 * kb, 1024, in[19], scr, F.lane); continue; } r -= I_Q;
            if (r < I_OM) { const int kb = r / 32, nb = r % 32; p0_transpose_item(in[25], 1024, 64 * kb, 32 * nb, (bf16_t*)(ws + WS_WOM) + (size_t)(32 * nb) * 512 + 64 * kb, 512, nullptr, scr, F.lane); continue; } r -= I_OM;
            if (r < 2 * I_G) { const int up = r / I_G; r %= I_G; const int e = r / 256, q = r % 256, kb = q / 16, nb = q % 16; const int n0 = 32 * nb;
                const int drow = (n0 >> 7) * 256 + (n0 & 127) + up * 128;
                p0_transpose_item(in[up ? 32 : 31] + (size_t)e * 1024 * 512, 512, 64 * kb, n0, (bf16_t*)(ws + WS_WGU) + ((size_t)e * 1024 + drow) * 1024 + 64 * kb, 1024, in[26], scr, F.lane); continue; } r -= 2 * I_G;
            { const int e = r / 256, q = r % 256, kb = q / 32, nb = q % 32;
                p0_transpose_item(in[33] + (size_t)e * 512 * 1024, 1024, 64 * kb, 32 * nb, (bf16_t*)(ws + WS_WD) + ((size_t)e * 1024 + 32 * nb) * 512 + 64 * kb, 512, nullptr, scr, F.lane); }
        }
    }
    {
        float* WR = (float*)(ws + WS_WR);
        for (int i = (F.vcu * NWAVES * 64) + F.tid; i < 20 * 1024; i += F.G * NWAVES * 64) { const int j = i >> 10, k = i & 1023;
            WR[i] = (j < 4 ? in[27][k * 4 + j] : in[29][k * 16 + (j - 4)]) * in[26][k]; }
    }
    {
        float* rope = (float*)(ws + WS_ROPE);
        for (int i = (F.vcu * NWAVES * 64) + F.tid; i < 1024; i += F.G * NWAVES * 64) { const float ang = (float)(i >> 4) * powf(10000.0f, -(float)(i & 15) / 16.0f); rope[i] = cosf(ang); rope[1024 + i] = sinf(ang); }
    }
    for (int m = gw; m < T; m += NGW) rms_row_to_bf16(in[0] + (size_t)m * 1024, (bf16_t*)(ws + WS_XN) + (size_t)m * 1024, F.lane);
    for (int m = gw; m < NMEMT; m += NGW) rms_row_to_bf16(in[1] + (size_t)m * 1024, (bf16_t*)(ws + WS_MEMN) + (size_t)m * 1024, F.lane);
}

struct P1Sched {
    int G, vcu; const char *win, *xn, *memn, *wkv;
    __device__ __forceinline__ bool next(int i, pg8::Unit& u) const {
        int L = i * G + vcu; constexpr size_t TILE = (size_t)256 * 1024 * 2;
        if (L < 768) { u.pm = L % 6; u.pn = L / 6; u.A = win + (size_t)u.pm * TILE; u.B = xn + (size_t)u.pn * TILE; u.aux = 0; }
        else if (L < 1152) { L -= 768; u.pn = L % 3; u.pm = L / 3; u.A = xn + (size_t)u.pm * TILE; u.B = win + (size_t)(6 + u.pn) * TILE; u.aux = 1; }
        else if (L < 1184) { L -= 1152; u.pn = L % 4; u.pm = L / 4; u.A = memn + (size_t)u.pm * TILE; u.B = wkv + (size_t)u.pn * TILE; u.aux = 2; }
        else return false;
        u.flags = 3; return true;
    }
};
__device__ __forceinline__ void store_tile_bf16(const f32x4 (&acc)[2][2][4][2], bf16_t* base, int ld, int row0, int col0) {
#pragma unroll
    for (int ai = 0; ai < 2; ++ai)
#pragma unroll
        for (int m = 0; m < 4; ++m) { bf16_t* rowp = base + (size_t)(row0 + ai * 128 + m * 16) * ld + col0;
#pragma unroll
            for (int bj = 0; bj < 2; ++bj) { const f32x4 v0 = acc[ai][bj][m][0], v1 = acc[ai][bj][m][1];
                u32x4 w; w.x = pg8::cvt_pk_bf16(v0[0], v0[1]); w.y = pg8::cvt_pk_bf16(v0[2], v0[3]); w.z = pg8::cvt_pk_bf16(v1[0], v1[1]); w.w = pg8::cvt_pk_bf16(v1[2], v1[3]);
                *(u32x4*)(rowp + bj * 128) = w; } }
}
struct EpiBf16Multi {
    unsigned char* ws;
    __device__ __forceinline__ void operator()(const f32x4 (&acc)[2][2][4][2], const pg8::Unit& u, int wr, int wc, int fr, int fq) const {
        const int row0 = u.pm * 256 + wr * 64 + fr, col0 = u.pn * 256 + wc * 32 + 8 * fq;
        if (u.aux == 0) store_tile_bf16(acc, (bf16_t*)(ws + WS_UHT), T, row0, col0);
        else if (u.aux == 1) store_tile_bf16(acc, (bf16_t*)(ws + WS_QKV), 768, row0, col0);
        else store_tile_bf16(acc, (bf16_t*)(ws + WS_KVM), 1024, row0, col0);
    }
};


__device__ __forceinline__ void p2a_kprep(Frame& F) {
    const int gw = F.vcu * NWAVES + F.wave, NGW = F.G * NWAVES, lane = F.lane;
    bf16_t* QKV = (bf16_t*)(F.ws + WS_QKV); const float* rope = (const float*)(F.ws + WS_ROPE);
    const float gk = F.in[14][lane];
    for (int row = gw; row < (MK_PATCHV == 2 ? 0 : T); row += NGW) {
        const int t = row & (SEQ - 1); const int pos = (lane < 32) ? (t >> 6) : (t & 63); const int i = lane & 15;
        const float c = rope[pos * 16 + i], sn = rope[1024 + pos * 16 + i];
#pragma unroll
        for (int kh = 0; kh < 2; ++kh) {
            bf16_t* p = QKV + (size_t)row * 768 + 512 + kh * 64 + lane;
            float v = bf2f(*p);
            const float rstd = 1.0f / sqrtf(wsum(v * v) * (1.0f / 64.0f) + EPSN);
            v = v * rstd * gk;
            const float other = __shfl_xor(v, 16);
            const float o = ((lane & 16) == 0) ? (v * c - other * sn) : (v * c + other * sn);
            *p = (bf16_t)f2bf(o);
        }
    }
    bf16_t* KVM = (bf16_t*)(F.ws + WS_KVM);
    const float g0 = F.in[24][lane], g1 = F.in[24][lane + 64];
    for (int w = gw; w < NMEMT * 4; w += NGW) {
        bf16_t* p = KVM + (size_t)(w >> 2) * 1024 + (w & 3) * 128;
        const float v0 = bf2f(p[lane]), v1 = bf2f(p[lane + 64]);
        const float rstd = 1.0f / sqrtf(wsum(v0 * v0 + v1 * v1) * (1.0f / 128.0f) + EPSN);
        p[lane] = (bf16_t)f2bf(v0 * rstd * g0); p[lane + 64] = (bf16_t)f2bf(v1 * rstd * g1);
    }
}

namespace at {
constexpr int D = 64, PQ = 768, PO = 1024;
constexpr int NW = 8, QBLK = 32, QB = QBLK * NW, KVBLK = 64;
__device__ __forceinline__ int crow(int r, int hi) { return (r & 3) + 8 * (r >> 2) + 4 * hi; }
#define SBAR() __builtin_amdgcn_sched_barrier(0)
constexpr int NSLOT = 3, SLOTB = 8192;
constexpr int LDS_K = 0, LDS_V = NSLOT * SLOTB, LDS_WS = 2 * NSLOT * SLOTB, LDS_OST = LDS_WS + NW * 64 * 4, LDS_BYTES_AT = LDS_OST + NW * 4096;
constexpr float C2 = 0.125f * 1.4426950408889634f;
__device__ __forceinline__ void glds16(const void* gsrc, unsigned lds_dst) { unsigned keep;
    asm volatile("s_mov_b32 %0, m0\n\ts_mov_b32 m0, %2\n\ts_nop 0\n\tglobal_load_lds_dwordx4 %1, off\n\ts_mov_b32 m0, %0" : "=&s"(keep) : "v"(gsrc), "s"(lds_dst) : "memory"); }
__device__ __forceinline__ float max3f(float a, float b, float c) { float r; asm("v_max3_f32 %0, %1, %2, %3" : "=v"(r) : "v"(a), "v"(b), "v"(c)); return r; }
__device__ __forceinline__ float max2f(float a, float b) { float r; asm("v_max_f32_e32 %0, %1, %2" : "=v"(r) : "v"(a), "v"(b)); return r; }
__device__ __forceinline__ float fadd_s(float a, float b) { float r; asm("v_add_f32_e32 %0, %1, %2" : "=v"(r) : "v"(a), "v"(b)); return r; }
__device__ __forceinline__ float fsub_s(float a, float b) { float r; asm("v_sub_f32_e32 %0, %1, %2" : "=v"(r) : "v"(a), "v"(b)); return r; }
typedef __bf16 bf16x2_t __attribute__((ext_vector_type(2)));
__device__ __forceinline__ unsigned cvtpk_s(float lo, float hi) { f32x2 v = {lo, hi}; bf16x2_t b = __builtin_convertvector(v, bf16x2_t); return __builtin_bit_cast(unsigned, b); }
#define WAIT_BAR(N) asm volatile("s_waitcnt vmcnt(" #N ") lgkmcnt(0)\n\ts_barrier" ::: "memory")
__device__ __forceinline__ void qkt(f32x16& p0, f32x16& p1, const char* Kslot, const bf16x8* qr, const f32x16& negm, int r32, int hi) {
    const char* kb = Kslot + hi * 1024 + r32 * 16;
#pragma unroll
    for (int d0 = 0; d0 < 4; ++d0) {
        const bf16x8 b0 = *reinterpret_cast<const bf16x8*>(kb + d0 * 2048);
        const bf16x8 b1 = *reinterpret_cast<const bf16x8*>(kb + d0 * 2048 + 512);
        if (d0 == 0) { p0 = __builtin_amdgcn_mfma_f32_32x32x16_bf16(b0, qr[0], negm, 0, 0, 0); p1 = __builtin_amdgcn_mfma_f32_32x32x16_bf16(b1, qr[0], negm, 0, 0, 0); }
        else { p0 = __builtin_amdgcn_mfma_f32_32x32x16_bf16(b0, qr[d0], p0, 0, 0, 0); p1 = __builtin_amdgcn_mfma_f32_32x32x16_bf16(b1, qr[d0], p1, 0, 0, 0); } }
}
typedef LAS const char* lds_cptr;
typedef short v4i16_t __attribute__((ext_vector_type(4)));
__device__ __forceinline__ void kload8(bf16x8* kf, lds_cptr kp) {
    kf[0] = *(const LAS bf16x8*)(kp);        kf[1] = *(const LAS bf16x8*)(kp + 512);
    kf[2] = *(const LAS bf16x8*)(kp + 2048); kf[3] = *(const LAS bf16x8*)(kp + 2560);
    kf[4] = *(const LAS bf16x8*)(kp + 4096); kf[5] = *(const LAS bf16x8*)(kp + 4608);
    kf[6] = *(const LAS bf16x8*)(kp + 6144); kf[7] = *(const LAS bf16x8*)(kp + 6656);
}
__device__ __forceinline__ void kload2(bf16x8* kf, lds_cptr kp, int j) { kf[2 * j] = *(const LAS bf16x8*)(kp + j * 2048); kf[2 * j + 1] = *(const LAS bf16x8*)(kp + j * 2048 + 512); }
__device__ __forceinline__ s16x4 vtr(lds_cptr p) { return __builtin_bit_cast(s16x4, __builtin_amdgcn_ds_read_tr16_b64_v4i16((LAS v4i16_t*)p)); }
__device__ __forceinline__ float rowmax(const f32x16& p0, const f32x16& p1) {
    float a = max3f(p0[0], p0[1], p1[0]), b = max3f(p0[2], p0[3], p1[1]); a = max3f(a, p1[2], p1[3]);
#pragma unroll
    for (int r = 4; r < 16; r += 4) { a = max3f(a, p0[r], p0[r + 1]); b = max3f(b, p0[r + 2], p0[r + 3]); a = max3f(a, p1[r], p1[r + 1]); b = max3f(b, p1[r + 2], p1[r + 3]); }
    const float m = max2f(a, b);
    auto rr = __builtin_amdgcn_permlane32_swap(__float_as_uint(m), __float_as_uint(m), false, false);
    return max2f(__uint_as_float(rr[0]), __uint_as_float(rr[1]));
}
__device__ __forceinline__ void pv(f32x16* o, int vb, bf16x8 pa0, bf16x8 pa1, bf16x8 pa2, bf16x8 pa3) {
#pragma unroll
    for (int d0 = 0; d0 < 2; ++d0) { s16x4 lo[4], hi[4];
#pragma unroll
        for (int ks = 0; ks < 4; ++ks) {
            asm volatile("ds_read_b64_tr_b16 %0,%1 offset:%c2" : "=&v"(lo[ks]) : "v"(vb), "i"(d0 * 4096 + ks * 1024) : "memory");
            asm volatile("ds_read_b64_tr_b16 %0,%1 offset:%c2" : "=&v"(hi[ks]) : "v"(vb), "i"(d0 * 4096 + ks * 1024 + 512) : "memory"); }
        asm volatile("s_waitcnt lgkmcnt(0)" ::: "memory"); SBAR();
#define PK(k) (bf16x8){lo[k][0], lo[k][1], lo[k][2], lo[k][3], hi[k][0], hi[k][1], hi[k][2], hi[k][3]}
        o[d0] = __builtin_amdgcn_mfma_f32_32x32x16_bf16(pa0, PK(0), o[d0], 0, 0, 0);
        o[d0] = __builtin_amdgcn_mfma_f32_32x32x16_bf16(pa1, PK(1), o[d0], 0, 0, 0);
        o[d0] = __builtin_amdgcn_mfma_f32_32x32x16_bf16(pa2, PK(2), o[d0], 0, 0, 0);
        o[d0] = __builtin_amdgcn_mfma_f32_32x32x16_bf16(pa3, PK(3), o[d0], 0, 0, 0);
#undef PK
    }
}
template <int THRL> __device__ __forceinline__ void attn_unit(int b, int h, int qb, const bf16_t* QKV, bf16_t* Y, const float* gq, const float* rope, char* shm) {
    const int tid = threadIdx.x, lane = tid & 63, r32 = lane & 31, hi = lane >> 5; const int wid = __builtin_amdgcn_readfirstlane(tid >> 6);
    const long rowbase = (long)b * SEQ; const int q0 = qb * QB; const int kvh = h >> 2;
    const bf16_t* Qw = QKV + (rowbase + q0 + wid * QBLK) * PQ + h * D;
    const bf16_t* Kh = QKV + rowbase * PQ + 512 + kvh * D; const bf16_t* Vh = QKV + rowbase * PQ + 640 + kvh * D;
    const unsigned lds0 = (unsigned)(uintptr_t)shm;
    float* wsf = (float*)(shm + LDS_WS) + wid * 64;
    const bf16_t* ksrc = Kh + (long)lane * PQ + wid * 8;
    const bf16_t* vsrc = Vh + (long)(16 * (wid & 3) + (lane >> 2)) * PQ + (wid >> 2) * 32 + (lane & 3) * 8;
    const unsigned kdst = lds0 + LDS_K + wid * 1024, vdst = lds0 + LDS_V + wid * 1024;
#define DMA_K(t, slot) glds16(ksrc + (long)(t) * KVBLK * PQ, (unsigned)__builtin_amdgcn_readfirstlane(kdst + (slot)))
#define DMA_V(t, slot) glds16(vsrc + (long)(t) * KVBLK * PQ, (unsigned)__builtin_amdgcn_readfirstlane(vdst + (slot)))
    const int vb0 = (int)(lds0 + LDS_V) + ((lane >> 4) & 1) * 32 + (lane & 3) * 8 + (4 * hi + ((lane & 15) >> 2)) * 64;
    const char* Kbase = shm + LDS_K; bf16x8 kf[8];
    const lds_cptr shm3 = (lds_cptr)shm; const lds_cptr kp0 = shm3 + LDS_K + hi * 1024 + r32 * 16; const lds_cptr vp0 = shm3 + LDS_V + ((lane >> 4) & 1) * 32 + (lane & 3) * 8 + (4 * hi + ((lane & 15) >> 2)) * 64;
    constexpr int NT = SEQ / KVBLK;
    DMA_K(0, 0); DMA_V(0, 0); DMA_K(1, SLOTB);
    bf16x8 qr[4];
    {
        float qf[4][8]; float ss = 0.f;
#pragma unroll
        for (int d0 = 0; d0 < 4; ++d0) { const u32x4 w = *reinterpret_cast<const u32x4*>(&Qw[(long)r32 * PQ + d0 * 16 + hi * 8]);
#pragma unroll
            for (int j = 0; j < 4; ++j) { qf[d0][2 * j] = bflo(w[j]); qf[d0][2 * j + 1] = bfhi(w[j]); }
#pragma unroll
            for (int j = 0; j < 8; ++j) ss += qf[d0][j] * qf[d0][j]; }
        ss += __shfl_xor(ss, 32);
        const float rstd = C2 / sqrtf(ss * (1.0f / 64.0f) + EPSN);
#pragma unroll
        for (int d0 = 0; d0 < 4; ++d0) { const f32x4 g0 = *(const f32x4*)(gq + d0 * 16 + hi * 8), g1 = *(const f32x4*)(gq + d0 * 16 + hi * 8 + 4);
#pragma unroll
            for (int j = 0; j < 4; ++j) { qf[d0][j] *= rstd * g0[j]; qf[d0][4 + j] *= rstd * g1[j]; } }
        const int tq = q0 + wid * QBLK + r32;
#pragma unroll
        for (int sec = 0; sec < 2; ++sec) { const int pos = sec ? (tq & 63) : (tq >> 6);
            const f32x4 c0 = *(const f32x4*)(rope + pos * 16 + hi * 8), c1 = *(const f32x4*)(rope + pos * 16 + hi * 8 + 4);
            const f32x4 s0 = *(const f32x4*)(rope + 1024 + pos * 16 + hi * 8), s1 = *(const f32x4*)(rope + 1024 + pos * 16 + hi * 8 + 4);
#pragma unroll
            for (int j = 0; j < 8; ++j) { const float c = j < 4 ? c0[j & 3] : c1[j & 3], sn = j < 4 ? s0[j & 3] : s1[j & 3];
                const float x1 = qf[2 * sec][j], x2 = qf[2 * sec + 1][j];
                qf[2 * sec][j] = x1 * c - x2 * sn; qf[2 * sec + 1][j] = x2 * c + x1 * sn; } }
#pragma unroll
        for (int d0 = 0; d0 < 4; ++d0) { u32x4 w;
#pragma unroll
            for (int j = 0; j < 4; ++j) w[j] = cvtpk_s(qf[d0][2 * j], qf[d0][2 * j + 1]);
            qr[d0] = __builtin_bit_cast(bf16x8, w); }
    }
    float mhat = 0.f, l_reg = 0.f; f32x16 o[2]; o[0] = f32x16{}; o[1] = f32x16{}; f32x16 negm = f32x16{}; asm volatile("" : "+v"(negm));
    bool resc = false;
#define START(P0, P1) do { const float rm = rowmax(P0, P1); resc = false; \
    { const float dl = rm; mhat = fadd_s(mhat, dl); \
      _Pragma("unroll") for (int r = 0; r < 16; ++r) { P0[r] = fsub_s(P0[r], dl); P1[r] = fsub_s(P1[r], dl); } \
      _Pragma("unroll") for (int r = 0; r < 16; ++r) negm[r] = -mhat; asm volatile("" : "+v"(negm)); } \
    _Pragma("unroll") for (int r = 0; r < 16; ++r) P0[r] = __builtin_amdgcn_exp2f(P0[r]); } while (0)
#define RESC() do { if (resc) { asm volatile("s_waitcnt lgkmcnt(0)" ::: "memory"); \
      _Pragma("unroll") for (int d_ = 0; d_ < 2; ++d_) _Pragma("unroll") for (int r = 0; r < 16; ++r) o[d_][r] *= wsf[crow(r, hi)]; } } while (0)
    f32x16 pA0, pA1, pB0, pB1;
    int sl_prev = 0, sl_cur = 0, sl_next = SLOTB;
#define ROT() do { sl_prev = sl_cur; sl_cur = sl_next; sl_next = (sl_next == (NSLOT - 1) * SLOTB) ? 0 : sl_next + SLOTB; } while (0)
    DMA_K(2, 2 * SLOTB);
    WAIT_BAR(3);
    qkt(pA0, pA1, Kbase, qr, negm, r32, hi); asm volatile("s_nop 15\n\ts_nop 7" : "+v"(pA0), "+v"(pA1));
    START(pA0, pA1);
    _Pragma("unroll") for (int r = 0; r < 16; ++r) pA1[r] = __builtin_amdgcn_exp2f(pA1[r]);
    WAIT_BAR(0);
    DMA_K(3, 0); DMA_V(1, SLOTB);
    ROT();
    kload8(kf, kp0 + sl_cur);
    WAIT_BAR(2);
    s16x4 vlo[8], vhi[8]; u32x4 pw0, pw1, pw2, pw3;
#define PKW(P, B) cvtpk_s(P[B], P[B + 1])
#define PAF(k) __builtin_bit_cast(bf16x8, pw##k)
#define VFR(i) (bf16x8){vlo[i][0], vlo[i][1], vlo[i][2], vlo[i][3], vhi[i][0], vhi[i][1], vhi[i][2], vhi[i][3]}
#define PIN(x) asm volatile("" : "+v"(x))
#define MX3(a, b, c) __builtin_fmaxf(__builtin_fmaxf((a), (b)), (c))
#define GAPA(MF, A0, A1, A2, A3, W0, W1, PW) do { MF; sacc += A0; sacc += A1; sacc += A2; sacc += A3; PIN(sacc); W0; W1; PIN(PW); SBAR(); } while (0)
#define EX(v) __builtin_amdgcn_exp2f(v)
#define GAPB(MF, X, B) do { MF; X[B] = EX(X[B]); X[B + 1] = EX(X[B + 1]); X[B + 2] = EX(X[B + 2]); X[B + 3] = EX(X[B + 3]); PIN(X); SBAR(); } while (0)
#define VRD(i) do { vlo[i] = vtr(vp_ + (((i) >> 2) * 4096 + ((i) & 3) * 1024)); vhi[i] = vtr(vp_ + (((i) >> 2) * 4096 + ((i) & 3) * 1024 + 512)); } while (0)
#define KRD(G, j) do { if (G) { kload2(kf, kp0 + sl_next, j); SBAR(); } } while (0)
#define STEP(C0, C1, P0, P1, t, GK, GV, GL) do { SBAR(); \
    const lds_cptr vp_ = vp0 + sl_prev; \
    VRD(0); SBAR(); float sacc = (P0[0] + P0[1]); \
    GAPA(C0 = __builtin_amdgcn_mfma_f32_32x32x16_bf16(kf[0], qr[0], negm, 0, 0, 0), P0[2], P0[3], P0[4], P0[5],     pw0[0] = PKW(P0, 0), pw0[1] = PKW(P0, 2), pw0); \
    VRD(4); SBAR(); GAPA(C1 = __builtin_amdgcn_mfma_f32_32x32x16_bf16(kf[1], qr[0], negm, 0, 0, 0), P0[6], P0[7], P0[8], P0[9],     pw0[2] = PKW(P0, 4), pw0[3] = PKW(P0, 6), pw0); \
    VRD(1); SBAR(); GAPA(C0 = __builtin_amdgcn_mfma_f32_32x32x16_bf16(kf[2], qr[1], C0, 0, 0, 0),   P0[10], P0[11], P0[12], P0[13], pw1[0] = PKW(P0, 8), pw1[1] = PKW(P0, 10), pw1); \
    VRD(5); SBAR(); GAPA(C1 = __builtin_amdgcn_mfma_f32_32x32x16_bf16(kf[3], qr[1], C1, 0, 0, 0),   P0[14], P0[15], P1[0], P1[1],   pw1[2] = PKW(P0, 12), pw1[3] = PKW(P0, 14), pw1); \
    VRD(2); SBAR(); GAPA(C0 = __builtin_amdgcn_mfma_f32_32x32x16_bf16(kf[4], qr[2], C0, 0, 0, 0),   P1[2], P1[3], P1[4], P1[5],     pw2[0] = PKW(P1, 0), pw2[1] = PKW(P1, 2), pw2); \
    VRD(6); SBAR(); GAPA(C1 = __builtin_amdgcn_mfma_f32_32x32x16_bf16(kf[5], qr[2], C1, 0, 0, 0),   P1[6], P1[7], P1[8], P1[9],     pw2[2] = PKW(P1, 4), pw2[3] = PKW(P1, 6), pw2); \
    VRD(3); SBAR(); GAPA(C0 = __builtin_amdgcn_mfma_f32_32x32x16_bf16(kf[6], qr[3], C0, 0, 0, 0),   P1[10], P1[11], P1[12], P1[13], pw3[0] = PKW(P1, 8), pw3[1] = PKW(P1, 10), pw3); \
    VRD(7); SBAR(); GAPA(C1 = __builtin_amdgcn_mfma_f32_32x32x16_bf16(kf[7], qr[3], C1, 0, 0, 0),   P1[14], P1[15], 0.f, 0.f,       pw3[2] = PKW(P1, 12), pw3[3] = PKW(P1, 14), pw3); \
    l_reg += sacc; \
    if (GK) { DMA_K((t) + 3, sl_cur); } if (GV) { DMA_V((t) + 1, sl_next); } \
    { float a = MX3(C0[0], C0[1], C1[0]), b = MX3(C0[2], C0[3], C1[1]); a = MX3(a, C1[2], C1[3]); \
      _Pragma("unroll") for (int r = 4; r < 16; r += 4) { a = MX3(a, C0[r], C0[r + 1]); b = MX3(b, C0[r + 2], C0[r + 3]); a = MX3(a, C1[r], C1[r + 1]); b = MX3(b, C1[r + 2], C1[r + 3]); } \
      float rm = __builtin_fmaxf(a, b); { auto rr = __builtin_amdgcn_permlane32_swap(__float_as_uint(rm), __float_as_uint(rm), false, false); rm = __builtin_fmaxf(__uint_as_float(rr[0]), __uint_as_float(rr[1])); } \
      resc = false; \
      if (__builtin_expect(__any(rm > (float)THRL), 0)) { const float dl = __builtin_fmaxf(rm, 0.f); mhat += dl; \
        _Pragma("unroll") for (int r = 0; r < 16; ++r) { C0[r] -= dl; C1[r] -= dl; } \
        _Pragma("unroll") for (int r = 0; r < 16; ++r) negm[r] = -mhat; asm volatile("" : "+v"(negm)); \
        const float f = __builtin_amdgcn_exp2f(-dl); l_reg *= f; if (hi == 0) wsf[r32] = f; resc = true; } } \
    SBAR(); \
    GAPB(o[0] = __builtin_amdgcn_mfma_f32_32x32x16_bf16(PAF(0), VFR(0), o[0], 0, 0, 0), C0, 0); \
    GAPB(o[1] = __builtin_amdgcn_mfma_f32_32x32x16_bf16(PAF(0), VFR(4), o[1], 0, 0, 0), C0, 4); \
    KRD(GL, 0); GAPB(o[0] = __builtin_amdgcn_mfma_f32_32x32x16_bf16(PAF(1), VFR(1), o[0], 0, 0, 0), C0, 8); \
    KRD(GL, 1); GAPB(o[1] = __builtin_amdgcn_mfma_f32_32x32x16_bf16(PAF(1), VFR(5), o[1], 0, 0, 0), C0, 12); \
    KRD(GL, 2); GAPB(o[0] = __builtin_amdgcn_mfma_f32_32x32x16_bf16(PAF(2), VFR(2), o[0], 0, 0, 0), C1, 0); \
    KRD(GL, 3); GAPB(o[1] = __builtin_amdgcn_mfma_f32_32x32x16_bf16(PAF(2), VFR(6), o[1], 0, 0, 0), C1, 4); \
    GAPB(o[0] = __builtin_amdgcn_mfma_f32_32x32x16_bf16(PAF(3), VFR(3), o[0], 0, 0, 0), C1, 8); \
    GAPB(o[1] = __builtin_amdgcn_mfma_f32_32x32x16_bf16(PAF(3), VFR(7), o[1], 0, 0, 0), C1, 12); \
    } while (0)
    int t = 1;
    for (; t + 5 < NT; t += 2) {
        STEP(pB0, pB1, pA0, pA1, t, true, true, true);     WAIT_BAR(2); RESC(); ROT();
        STEP(pA0, pA1, pB0, pB1, t + 1, true, true, true); WAIT_BAR(2); RESC(); ROT();
    }
#define ENDW(tt) do { if ((tt) + 3 < NT) { WAIT_BAR(2); } else if ((tt) + 2 < NT) { WAIT_BAR(1); } else { WAIT_BAR(0); } } while (0)
    for (; t + 1 < NT; t += 2) {
        STEP(pB0, pB1, pA0, pA1, t, (t + 3 < NT), (t + 1 < NT), (t + 1 < NT));         ENDW(t);     RESC(); ROT();
        STEP(pA0, pA1, pB0, pB1, t + 1, (t + 4 < NT), (t + 2 < NT), (t + 2 < NT));     ENDW(t + 1); RESC(); ROT();
    }
    STEP(pB0, pB1, pA0, pA1, NT - 1, false, false, false); RESC();
    { float sacc = pB0[0] + pB0[1]; _Pragma("unroll") for (int r = 2; r < 16; ++r) sacc += pB0[r]; _Pragma("unroll") for (int r = 0; r < 16; ++r) sacc += pB1[r]; l_reg += sacc;
      pw0 = (u32x4){PKW(pB0, 0), PKW(pB0, 2), PKW(pB0, 4), PKW(pB0, 6)}; pw1 = (u32x4){PKW(pB0, 8), PKW(pB0, 10), PKW(pB0, 12), PKW(pB0, 14)}; pw2 = (u32x4){PKW(pB1, 0), PKW(pB1, 2), PKW(pB1, 4), PKW(pB1, 6)}; pw3 = (u32x4){PKW(pB1, 8), PKW(pB1, 10), PKW(pB1, 12), PKW(pB1, 14)};
      SBAR(); pv(o, vb0 + sl_cur, PAF(0), PAF(1), PAF(2), PAF(3)); }
#undef PKW
#undef PAF
#undef VFR
#undef PIN
#undef MX3
#undef GAPA
#undef GAPB
#undef EX
#undef VRD
#undef KRD
#undef STEP
#undef ENDW
    { auto rr = __builtin_amdgcn_permlane32_swap(__float_as_uint(l_reg), __float_as_uint(l_reg), false, false); l_reg = __uint_as_float(rr[0]) + __uint_as_float(rr[1]); }
    if (hi == 0) wsf[32 + r32] = l_reg; asm volatile("s_waitcnt lgkmcnt(0)" ::: "memory");
    float rli[16];
#pragma unroll
    for (int r = 0; r < 16; ++r) rli[r] = __builtin_amdgcn_rcpf(wsf[32 + crow(r, hi)]);
    bf16_t* Ow = Y + (rowbase + q0 + wid * QBLK) * PO + 512 + h * D;
    { bf16_t* stg = (bf16_t*)(shm + LDS_OST) + wid * 2048;
#pragma unroll
      for (int r = 0; r < 16; ++r) { const int orow = crow(r, hi);
#pragma unroll
        for (int d0 = 0; d0 < 2; ++d0) stg[orow * 64 + d0 * 32 + r32] = (bf16_t)f2bf(o[d0][r] * rli[r]); }
      asm volatile("s_waitcnt lgkmcnt(0)" ::: "memory");
#pragma unroll
      for (int i = 0; i < 4; ++i) { const int row = i * 8 + (lane >> 3), ch = lane & 7; const u32x4 v = *(const u32x4*)(stg + row * 64 + ch * 8);
        float f[8]; float ss = 0.f;
#pragma unroll
        for (int j = 0; j < 4; ++j) { f[2 * j] = bflo(v[j]); f[2 * j + 1] = bfhi(v[j]); ss += f[2 * j] * f[2 * j] + f[2 * j + 1] * f[2 * j + 1]; }
        ss += __shfl_xor(ss, 1); ss += __shfl_xor(ss, 2); ss += __shfl_xor(ss, 4);
        const float rs = 1.0f / sqrtf(ss * (1.0f / 64.0f) + EPSN);
        u32x4 w;
#pragma unroll
        for (int j = 0; j < 4; ++j) w[j] = pk2(f[2 * j] * rs, f[2 * j + 1] * rs);
        *(u32x4*)(Ow + (long)row * PO + ch * 8) = w; } }
    asm volatile("s_waitcnt lgkmcnt(0)\n\ts_barrier" ::: "memory");
#undef DMA_K
#undef DMA_V
#undef START
#undef RESC
#undef ROT
}
#undef SBAR
#undef WAIT_BAR
}

namespace hy {
constexpr int PADT = 512, ZT = SEQ + 2 * PADT, SB = ZT * 2 + 16;
constexpr int LZ = 0, LF0 = 8 * SB, LF1 = LF0 + 16384 + 68, LRED = LF1 + 16384 + 12, LEND = LRED + 64;
static_assert(LF0 % 16 == 0 && LEND <= RING_BYTES, "hyena LDS map");
__device__ __forceinline__ int crow(int r, int hi) { return (r & 3) + 8 * (r >> 2) + 4 * hi; }
__device__ __forceinline__ void hyena_unit(int c, const bf16_t* UHT, bf16_t* ZS, bf16_t* YHT, const bf16_t* KF, const float* FN, const float* sw, const float* sbias, const float* skip, LAS unsigned char* lds) {
    const int tid = threadIdx.x, lane = tid & 63, wid = __builtin_amdgcn_readfirstlane(tid >> 6);
    const int r32 = lane & 31, hi = lane >> 5;
    __syncthreads();
    for (int i = tid; i < 8 * 2 * (PADT / 8); i += 512) { const int b = i / (2 * (PADT / 8)), rem = i % (2 * (PADT / 8)); const int side = rem / (PADT / 8), k = rem % (PADT / 8);
        *(LAS u32x4*)(lds + LZ + b * SB + 2 * (side * (PADT + SEQ) + 8 * k)) = (u32x4){0u, 0u, 0u, 0u}; }
#pragma unroll 1
    for (int ord = 0; ord < 2; ++ord) {
        { const u32x4* src = (const u32x4*)(KF + ((size_t)ord * 512 + c) * 8192); float as = 0.f;
#pragma unroll
          for (int k = 0; k < 2; ++k) { const u32x4 w = src[tid + 512 * k]; *(LAS u32x4*)(lds + LF0 + 16 * (tid + 512 * k)) = w;
#pragma unroll
              for (int j = 0; j < 4; ++j) as += fabsf(bflo(w[j])) + fabsf(bfhi(w[j])); }
          as = wsum(as); if (lane == 0) *(LAS float*)(lds + LRED + 4 * wid) = as; }
        { const int cc = ord * 512 + c; const float w0 = sw[cc], w1 = sw[1536 + cc], w2 = sw[3072 + cc], bb = sbias[cc];
          const bf16_t* u = UHT + (size_t)cc * T; const bf16_t* zs = ZS + (size_t)c * T;
#pragma unroll 1
          for (int k = 0; k < 8; ++k) { const int id = tid + 512 * k, b = id >> 9, t8 = (id & 511) * 8; const size_t g = (size_t)b * SEQ + t8;
            const u32x4 w = *(const u32x4*)(u + g);
            const float prev = t8 > 0 ? bf2f(u[g - 1]) : 0.f, next = t8 + 8 < SEQ ? bf2f(u[g + 8]) : 0.f;
            float x[10]; x[0] = prev; x[9] = next;
#pragma unroll
            for (int j = 0; j < 4; ++j) { x[1 + 2 * j] = bflo(w[j]); x[2 + 2 * j] = bfhi(w[j]); }
            float y[8];
#pragma unroll
            for (int j = 0; j < 8; ++j) y[j] = w0 * x[j] + w1 * x[j + 1] + w2 * x[j + 2] + bb;
            if (ord == 1) { const u32x4 zw = *(const u32x4*)(zs + g);
#pragma unroll
                for (int j = 0; j < 4; ++j) { y[2 * j] *= bflo(zw[j]); y[2 * j + 1] *= bfhi(zw[j]); } }
            u32x4 ow;
#pragma unroll
            for (int j = 0; j < 4; ++j) ow[j] = pk2(y[2 * j], y[2 * j + 1]);
            *(LAS u32x4*)(lds + LZ + b * SB + 2 * (PADT + t8)) = ow; } }
        __syncthreads();
#pragma unroll 2
        for (int k = 0; k < 8; ++k) { const int i = tid + 512 * k; const unsigned lo = *(const LAS unsigned*)(lds + LF0 + 4 * i), hi2 = (i < 4095) ? *(const LAS unsigned*)(lds + LF0 + 4 * i + 4) : 0u;
            *(LAS unsigned*)(lds + LF1 + 4 * i) = (lo >> 16) | (hi2 << 16); }
        __syncthreads();
#ifdef HY_DIRECT
        {
            float l1d = 0.f;
            for (int k = 0; k < 8; ++k) l1d += *(const LAS float*)(lds + LRED + 4 * k);
            const float invd = 1.0f / (l1d + 1e-6f), skd = skip[ord * 512 + c];
            bf16_t* dstd = (ord == 0 ? ZS : YHT) + (size_t)c * T;
#pragma unroll 1
            for (int o8 = 0; o8 < 64; ++o8) { const int idx = tid + 512 * o8, b = idx >> 12, t = idx & 4095;
                const LAS bf16_t* zrow = (const LAS bf16_t*)(lds + LZ + b * SB) + PADT;
                const LAS bf16_t* Rp = (const LAS bf16_t*)(lds + LF0) + (4096 - t);
                float a = 0.f;
#pragma unroll 4
                for (int sidx = 0; sidx < 4096; ++sidx) a += bf2f(Rp[sidx]) * bf2f(zrow[sidx]);
                dstd[(size_t)b * SEQ + t] = (bf16_t)f2bf(a * invd + skd * bf2f(zrow[t])); }
            VM_WAIT();
            __syncthreads();
            continue;
        }
#endif
        const int q0 = 4 * wid; const int Dlo = 4 * q0 - 127;
        f32x16 acc[4];
#pragma unroll
        for (int i = 0; i < 4; ++i) acc[i] = f32x16{};
        const int m0 = 4096 - 32 * Dlo - r32 + 8 * hi;
        unsigned aaddr = (r32 & 1) ? (unsigned)(LF1 + 2 * (m0 - 1)) : (unsigned)(LF0 + 2 * m0);
        const int bn = r32 >> 2, pn = r32 & 3;
        unsigned baddr = (unsigned)(LZ + bn * SB + 2 * (PADT + 32 * (4 * q0 + pn - Dlo) + 8 * hi));
        int nD = 143; asm volatile("" : "+s"(nD));
#pragma unroll 2
        for (int d = 0; d < nD; ++d) {
            u32x4 a0, a1;
#pragma unroll
            for (int j = 0; j < 4; ++j) { a0[j] = *(const LAS unsigned*)(lds + aaddr + 4 * j); a1[j] = *(const LAS unsigned*)(lds + aaddr + 32 + 4 * j); }
            const bf16x8 A0 = __builtin_bit_cast(bf16x8, a0), A1 = __builtin_bit_cast(bf16x8, a1);
#pragma unroll
            for (int i = 0; i < 4; ++i) {
                const bf16x8 b0 = *(const LAS bf16x8*)(lds + baddr + i * 256), b1 = *(const LAS bf16x8*)(lds + baddr + i * 256 + 32);
                acc[i] = __builtin_amdgcn_mfma_f32_32x32x16_bf16(A0, b0, acc[i], 0, 0, 0);
                acc[i] = __builtin_amdgcn_mfma_f32_32x32x16_bf16(A1, b1, acc[i], 0, 0, 0);
            }
            aaddr -= 64; baddr -= 64;
        }
        float l1 = 0.f;
#pragma unroll
        for (int k = 0; k < 8; ++k) l1 += *(const LAS float*)(lds + LRED + 4 * k);
        const float inv = 1.0f / (l1 + 1e-6f), sk = skip[ord * 512 + c];
        bf16_t* dst = (ord == 0 ? ZS : YHT) + (size_t)c * T + (size_t)bn * SEQ;
#pragma unroll
        for (int i = 0; i < 4; ++i)
#pragma unroll
            for (int g4 = 0; g4 < 4; ++g4) { const int t4 = 32 * (4 * (q0 + i) + pn) + 8 * g4 + 4 * hi;
                const u32x2 zw = *(const LAS u32x2*)(lds + LZ + bn * SB + 2 * (PADT + t4));
                const float z0 = bflo(zw[0]), z1 = bfhi(zw[0]), z2 = bflo(zw[1]), z3 = bfhi(zw[1]);
                u32x2 ow; ow[0] = pk2(acc[i][4 * g4] * inv + sk * z0, acc[i][4 * g4 + 1] * inv + sk * z1); ow[1] = pk2(acc[i][4 * g4 + 2] * inv + sk * z2, acc[i][4 * g4 + 3] * inv + sk * z3);
                *(u32x2*)(dst + t4) = ow; }
        VM_WAIT();
        __syncthreads();
    }
}
}

__device__ __forceinline__ void p2c_transpose(Frame& F, bf16_t* Y) {
    const int gw = F.vcu * NWAVES + F.wave, NGW = F.G * NWAVES, lane = F.lane;
    const bf16_t* UHT = (const bf16_t*)(F.ws + WS_UHT); const bf16_t* YHT = (const bf16_t*)(F.ws + WS_YHT);
    const float* sw = F.in[4]; const float* sbias = F.in[5];
    for (int it = gw; it < 8 * (T / 64); it += NGW) {
        const int g = it & 7, tb = it >> 3; const int t = tb * 64 + lane, ts = t & (SEQ - 1);
        float ss = 0.f;
#pragma unroll 4
        for (int ch = 0; ch < 64; ++ch) { const int c = 64 * g + ch, cc = 1024 + c;
            const bf16_t* u = UHT + (size_t)cc * T + t;
            const float um = ts > 0 ? bf2f(u[-1]) : 0.f, u0 = bf2f(u[0]), up = ts < SEQ - 1 ? bf2f(u[1]) : 0.f;
            const float gate = sw[cc] * um + sw[1536 + cc] * u0 + sw[3072 + cc] * up + sbias[cc];
            const float yv = gate * bf2f(YHT[(size_t)c * T + t]); ss += yv * yv; }
        const float rs = 1.0f / sqrtf(ss * (1.0f / 64.0f) + EPSN);
        bf16_t* o = Y + (size_t)t * 1024 + 64 * g;
#pragma unroll 1
        for (int k = 0; k < 8; ++k) { float y[8];
#pragma unroll
            for (int j = 0; j < 8; ++j) { const int c = 64 * g + 8 * k + j, cc = 1024 + c;
                const bf16_t* u = UHT + (size_t)cc * T + t;
                const float um = ts > 0 ? bf2f(u[-1]) : 0.f, u0 = bf2f(u[0]), up = ts < SEQ - 1 ? bf2f(u[1]) : 0.f;
                const float gate = sw[cc] * um + sw[1536 + cc] * u0 + sw[3072 + cc] * up + sbias[cc];
                y[j] = gate * bf2f(YHT[(size_t)c * T + t]) * rs; }
            u32x4 w;
#pragma unroll
            for (int j = 0; j < 4; ++j) w[j] = pk2(y[2 * j], y[2 * j + 1]);
            *(u32x4*)(o + 8 * k) = w; }
    }
}


struct TileSched {
    int G, vcu, nM, lgN; const char *A, *B; size_t tA, tB;
    __device__ __forceinline__ bool next(int i, pg8::Unit& u) const {
        const int L = i * G + vcu; if (L >= (nM << lgN)) return false;
        u.pm = L >> lgN; u.pn = L & ((1 << lgN) - 1); u.A = A + (size_t)u.pm * tA; u.B = B + (size_t)u.pn * tB; u.aux = 0; u.flags = 3; return true;
    }
};
struct EpiResid {
    const float* base; float* out; bf16_t* xb; float* ss;
    __device__ __forceinline__ void operator()(const f32x4 (&acc)[2][2][4][2], const pg8::Unit& u, int wr, int wc, int fr, int fq) const {
        const int row0 = u.pm * 256 + wr * 64 + fr, col0 = u.pn * 256 + wc * 32 + 8 * fq;
#pragma unroll
        for (int ai = 0; ai < 2; ++ai)
#pragma unroll
            for (int m = 0; m < 4; ++m) { const int r = row0 + ai * 128 + m * 16; float part = 0.f;
#pragma unroll
                for (int bj = 0; bj < 2; ++bj) { const size_t off = (size_t)r * 1024 + col0 + bj * 128;
                    const f32x4 v0 = acc[ai][bj][m][0] + *(const f32x4*)(base + off), v1 = acc[ai][bj][m][1] + *(const f32x4*)(base + off + 4);
                    *(f32x4*)(out + off) = v0; *(f32x4*)(out + off + 4) = v1;
                    u32x4 w; w.x = pg8::cvt_pk_bf16(v0[0], v0[1]); w.y = pg8::cvt_pk_bf16(v0[2], v0[3]); w.z = pg8::cvt_pk_bf16(v1[0], v1[1]); w.w = pg8::cvt_pk_bf16(v1[2], v1[3]);
                    *(u32x4*)(xb + off) = w;
                    part += (v0[0] * v0[0] + v0[1] * v0[1]) + (v0[2] * v0[2] + v0[3] * v0[3]) + (v1[0] * v1[0] + v1[1] * v1[1]) + (v1[2] * v1[2] + v1[3] * v1[3]); }
                part += __shfl_xor(part, 16); part += __shfl_xor(part, 32);
                if (fq == 0) atomicAdd(ss + r, part);
                asm volatile("" ::: "memory"); }
    }
};
struct EpiRowScale {
    bf16_t* O; const float* ss;
    __device__ __forceinline__ void operator()(const f32x4 (&acc)[2][2][4][2], const pg8::Unit& u, int wr, int wc, int fr, int fq) const {
        const int row0 = u.pm * 256 + wr * 64 + fr, col0 = u.pn * 256 + wc * 32 + 8 * fq;
#pragma unroll
        for (int ai = 0; ai < 2; ++ai)
#pragma unroll
            for (int m = 0; m < 4; ++m) { const int r = row0 + ai * 128 + m * 16; const float rs = 1.0f / sqrtf(ss[r] * (1.0f / 1024.0f) + EPSN);
#pragma unroll
                for (int bj = 0; bj < 2; ++bj) { const f32x4 v0 = acc[ai][bj][m][0] * rs, v1 = acc[ai][bj][m][1] * rs;
                    u32x4 w; w.x = pg8::cvt_pk_bf16(v0[0], v0[1]); w.y = pg8::cvt_pk_bf16(v0[2], v0[3]); w.z = pg8::cvt_pk_bf16(v1[0], v1[1]); w.w = pg8::cvt_pk_bf16(v1[2], v1[3]);
                    *(u32x4*)(O + (size_t)r * 512 + col0 + bj * 128) = w; } }
    }
};

namespace ma {
constexpr int KP = 272, VP = 520;
constexpr int LK = 0, LV = 256 * KP, LEND = LV + 128 * VP;
static_assert(LEND <= MISC_OFF, "mem-attn LDS map");
__device__ __forceinline__ void memattn_unit(int b, int h, int rb, const bf16_t* QM, const bf16_t* KVM, bf16_t* OM, const float* gq, LAS unsigned char* lds) {
    const int tid = threadIdx.x, lane = tid & 63, wid = __builtin_amdgcn_readfirstlane(tid >> 6), r32 = lane & 31, hi = lane >> 5;
    __syncthreads();
#pragma unroll 2
    for (int k = 0; k < 8; ++k) { const int p = tid + 512 * k, key = p >> 4, ch = p & 15;
        const u32x4 w = *(const u32x4*)(KVM + (size_t)(b * 256 + key) * 1024 + h * 128 + ch * 8);
        *(LAS u32x4*)(lds + LK + key * KP + ch * 16) = w; }
#pragma unroll 2
    for (int k = 0; k < 8; ++k) { const int p = tid + 512 * k, key = p & 255, ch = p >> 8;
        const u32x4 w = *(const u32x4*)(KVM + (size_t)(b * 256 + key) * 1024 + 512 + h * 128 + ch * 8);
#pragma unroll
        for (int j = 0; j < 4; ++j) { *(LAS bf16_t*)(lds + LV + (ch * 8 + 2 * j) * VP + key * 2) = (bf16_t)(w[j] & 0xffffu); *(LAS bf16_t*)(lds + LV + (ch * 8 + 2 * j + 1) * VP + key * 2) = (bf16_t)(w[j] >> 16); } }
    const size_t qrow = (size_t)b * SEQ + rb * 256 + wid * 32 + r32;
    bf16x8 qf[8];
    {
        float qv[8][8]; float ssq = 0.f;
#pragma unroll
        for (int ks = 0; ks < 8; ++ks) { const u32x4 w = *(const u32x4*)(QM + qrow * 512 + h * 128 + ks * 16 + hi * 8);
#pragma unroll
            for (int j = 0; j < 4; ++j) { qv[ks][2 * j] = bflo(w[j]); qv[ks][2 * j + 1] = bfhi(w[j]); ssq += qv[ks][2 * j] * qv[ks][2 * j] + qv[ks][2 * j + 1] * qv[ks][2 * j + 1]; } }
        ssq += __shfl_xor(ssq, 32);
        const float rs = (0.08838834764831845f * 1.4426950408889634f) / sqrtf(ssq * (1.0f / 128.0f) + EPSN);
#pragma unroll
        for (int ks = 0; ks < 8; ++ks) { const f32x4 g0 = *(const f32x4*)(gq + ks * 16 + hi * 8), g1 = *(const f32x4*)(gq + ks * 16 + hi * 8 + 4); u32x4 w;
#pragma unroll
            for (int j = 0; j < 2; ++j) { w[j] = pk2(qv[ks][2 * j] * rs * g0[2 * j], qv[ks][2 * j + 1] * rs * g0[2 * j + 1]); w[2 + j] = pk2(qv[ks][4 + 2 * j] * rs * g1[2 * j], qv[ks][5 + 2 * j] * rs * g1[2 * j + 1]); }
            qf[ks] = __builtin_bit_cast(bf16x8, w); }
    }
    __syncthreads();
    f32x16 st[8];
#pragma unroll
    for (int kb = 0; kb < 8; ++kb) { f32x16 a = f32x16{};
#pragma unroll
        for (int ks = 0; ks < 8; ++ks) { const bf16x8 kf = *(const LAS bf16x8*)(lds + LK + (kb * 32 + r32) * KP + ks * 32 + hi * 16);
            a = __builtin_amdgcn_mfma_f32_32x32x16_bf16(kf, qf[ks], a, 0, 0, 0); }
        st[kb] = a; }
    float mx = -1e30f;
#pragma unroll
    for (int kb = 0; kb < 8; ++kb)
#pragma unroll
        for (int r = 0; r < 16; ++r) mx = fmaxf(mx, st[kb][r]);
    mx = fmaxf(mx, __shfl_xor(mx, 32));
    float l = 0.f; u32x4 pb[8][2];
#pragma unroll
    for (int kb = 0; kb < 8; ++kb) {
#pragma unroll
        for (int r = 0; r < 16; ++r) { st[kb][r] = __builtin_amdgcn_exp2f(st[kb][r] - mx); l += st[kb][r]; }
#pragma unroll
        for (int s2 = 0; s2 < 2; ++s2)
#pragma unroll
            for (int j = 0; j < 4; ++j) pb[kb][s2][j] = pk2(st[kb][8 * s2 + 2 * j], st[kb][8 * s2 + 2 * j + 1]); }
    l += __shfl_xor(l, 32);
    const float il = 1.0f / l;
    bf16_t* orow = OM + qrow * 512 + h * 128;
#pragma unroll
    for (int db = 0; db < 4; ++db) { f32x16 o = f32x16{};
#pragma unroll
        for (int kb = 0; kb < 8; ++kb)
#pragma unroll
            for (int s2 = 0; s2 < 2; ++s2) { const LAS unsigned char* vp = lds + LV + (db * 32 + r32) * VP + 2 * (kb * 32 + 16 * s2 + 4 * hi);
                const u32x2 v0 = *(const LAS u32x2*)vp, v1 = *(const LAS u32x2*)(vp + 16);
                const u32x4 vv = (u32x4){v0[0], v0[1], v1[0], v1[1]};
                o = __builtin_amdgcn_mfma_f32_32x32x16_bf16(__builtin_bit_cast(bf16x8, vv), __builtin_bit_cast(bf16x8, pb[kb][s2]), o, 0, 0, 0); }
#pragma unroll
        for (int g4 = 0; g4 < 4; ++g4) { u32x2 w; w[0] = pk2(o[4 * g4] * il, o[4 * g4 + 1] * il); w[1] = pk2(o[4 * g4 + 2] * il, o[4 * g4 + 3] * il);
            *(u32x2*)(orow + db * 32 + 8 * g4 + 4 * hi) = w; } }
}
}

constexpr size_t WS_TOKI = WS_MOE, WS_TOKW = WS_MOE + 1 * MiBx, WS_TOKS = WS_MOE + 2 * MiBx, WS_GWS = WS_MOE + 3 * MiBx, WS_RS = WS_MOE + 4 * MiBx;
constexpr size_t WS_XS = WS_Y;
constexpr size_t WS_HB = WS_UHT;
constexpr int XS_ROWS = T + 24 * 256;
__device__ __forceinline__ void p6a_route(Frame& F) {
    const int gw = F.vcu * NWAVES + F.wave, NGW = F.G * NWAVES, lane = F.lane;
    const float* WR = (const float*)(F.ws + WS_WR); const float* brg = F.in[28]; const float* bre = F.in[30];
    int* cnt = (int*)(F.ctl + CW_CNT); int* toki = (int*)(F.ws + WS_TOKI); float* tokw = (float*)(F.ws + WS_TOKW);
    for (int tok = gw; tok < T; tok += NGW) {
        const GAS f32x4* xr = (const GAS f32x4*)(F.out + (size_t)tok * 1024) + lane;
        f32x4 v[4]; float ssq = 0.f;
#pragma unroll
        for (int j = 0; j < 4; ++j) { v[j] = xr[64 * j]; ssq += (v[j].x * v[j].x + v[j].y * v[j].y) + (v[j].z * v[j].z + v[j].w * v[j].w); }
        const float rstd = 1.0f / sqrtf(wsum(ssq) * (1.0f / 1024.0f) + EPSN);
        float lg[20];
#pragma unroll
        for (int e = 0; e < 20; ++e) { float a = 0.f;
#pragma unroll
            for (int j = 0; j < 4; ++j) { const f32x4 w = *((const f32x4*)(WR + e * 1024) + lane + 64 * j); a += (v[j].x * w.x + v[j].y * w.y) + (v[j].z * w.z + v[j].w * w.w); }
            lg[e] = wsum(a) * rstd; }
        float gl[4], gm = -1e30f;
#pragma unroll
        for (int j = 0; j < 4; ++j) { gl[j] = lg[j] + brg[j]; gm = fmaxf(gm, gl[j]); }
        float gs = 0.f, gp[4];
#pragma unroll
        for (int j = 0; j < 4; ++j) { gp[j] = expf(gl[j] - gm); gs += gp[j]; }
        int gi = 0; float best = gp[0];
#pragma unroll
        for (int j = 1; j < 4; ++j) if (gp[j] > best) { best = gp[j]; gi = j; }
        const float pg = best / gs;
        float el[4], em = -1e30f;
#pragma unroll
        for (int j = 0; j < 4; ++j) { float vv = 0.f;
#pragma unroll
            for (int q = 0; q < 4; ++q) if (q == gi) vv = lg[4 + q * 4 + j] + bre[q * 4 + j];
            el[j] = vv; em = fmaxf(em, vv); }
        float ep[4];
#pragma unroll
        for (int j = 0; j < 4; ++j) ep[j] = expf(el[j] - em);
        int e1 = 0; float p1 = ep[0];
#pragma unroll
        for (int j = 1; j < 4; ++j) if (ep[j] > p1) { p1 = ep[j]; e1 = j; }
        int e2 = -1; float p2 = -1.f;
#pragma unroll
        for (int j = 0; j < 4; ++j) if (j != e1 && ep[j] > p2) { p2 = ep[j]; e2 = j; }
        const float w1 = pg * p1 / (p1 + p2), w2 = pg * p2 / (p1 + p2);
        const int lo = e1 < e2 ? e1 : e2, hi2 = e1 < e2 ? e2 : e1; const float wlo = e1 < e2 ? w1 : w2, whi = e1 < e2 ? w2 : w1;
        const int pidx = (lo == 0) ? (hi2 - 1) : (lo == 1 ? hi2 + 1 : 5);
        const int bucket = gi * 6 + pidx;
        if (lane == 0) { const int pos = atomicAdd(&cnt[bucket], 1); toki[tok] = (bucket << 16) | pos; tokw[2 * tok] = wlo; tokw[2 * tok + 1] = whi; }
    }
}
__device__ __forceinline__ void moe_prefix(Frame& F, volatile LAS int* tp) {
    if (F.tid == 0) { const int* cnt = (const int*)(F.ctl + CW_CNT); int s = 0; for (int b = 0; b < 24; ++b) { tp[b] = s; s += (cnt[b] + 255) >> 8; } tp[24] = s; }
    __syncthreads();
}
__device__ __forceinline__ void p6b_scatter(Frame& F, volatile LAS int* tp) {
    const int gw = F.vcu * NWAVES + F.wave, NGW = F.G * NWAVES, lane = F.lane;
    const int* cnt = (const int*)(F.ctl + CW_CNT); const int* toki = (const int*)(F.ws + WS_TOKI); const float* tokw = (const float*)(F.ws + WS_TOKW);
    int* toks = (int*)(F.ws + WS_TOKS); float* gws = (float*)(F.ws + WS_GWS); float* rsb = (float*)(F.ws + WS_RS);
    const bf16_t* xb = (const bf16_t*)(F.ws + WS_XN); bf16_t* xs = (bf16_t*)(F.ws + WS_XS); const float* ss2 = (const float*)(F.ctl + CW_SS2);
    for (int tok = gw; tok < T; tok += NGW) {
        const int ti = toki[tok]; const int bucket = ti >> 16, pos = ti & 0xffff; const int gpos = tp[bucket] * 256 + pos;
        const u32x4* src = (const u32x4*)(xb + (size_t)tok * 1024); u32x4* dst = (u32x4*)(xs + (size_t)gpos * 1024);
        dst[lane] = src[lane]; dst[lane + 64] = src[lane + 64];
        if (lane == 0) { toks[gpos] = tok; gws[2 * gpos] = tokw[2 * tok]; gws[2 * gpos + 1] = tokw[2 * tok + 1]; rsb[gpos] = 1.0f / sqrtf(ss2[tok] * (1.0f / 1024.0f) + EPSN); }
    }
    for (int i = (F.vcu * NWAVES * 64) + F.tid; i < 24 * 256; i += F.G * NWAVES * 64) { const int b = i >> 8, k = i & 255; const int c = cnt[b], p = c + k;
        if (p < ((c + 255) & ~255)) { toks[tp[b] * 256 + p] = -1; gws[2 * (tp[b] * 256 + p)] = 0.f; gws[2 * (tp[b] * 256 + p) + 1] = 0.f; rsb[tp[b] * 256 + p] = 0.f; } }
}
__device__ __forceinline__ int moe_bucket_of_tile(volatile LAS int* tp, int tau) { int b = 0;
#pragma unroll
    for (int k = 1; k < 24; ++k) b += (tau >= tp[k]) ? 1 : 0;
    return b; }
__device__ __forceinline__ int moe_expert(int bucket, int slot) { const int g = bucket / 6, p = bucket % 6; const int lo = p < 3 ? 0 : (p < 5 ? 1 : 2), hi2 = p < 3 ? p + 1 : (p < 5 ? p - 1 : 3); return g * 4 + (slot ? hi2 : lo); }
struct MoeUpSched {
    int G, vcu; volatile LAS int* tp; const char *xs, *wgu;
    __device__ __forceinline__ bool next(int i, pg8::Unit& u) const {
        const int L = i * G + vcu; const int ntile = tp[24]; if (L >= ntile * 8) return false;
        const int tau = L >> 3, slot = (L >> 2) & 1, pn = L & 3; const int e = moe_expert(moe_bucket_of_tile(tp, tau), slot);
        u.pm = tau; u.pn = pn; u.aux = slot; u.flags = 3; u.A = xs + (size_t)tau * 256 * 2048; u.B = wgu + ((size_t)e * 1024 + pn * 256) * 2048; return true;
    }
};
struct EpiMoeUp {
    bf16_t* H; const float* rsb; const float* gws;
    __device__ __forceinline__ void operator()(const f32x4 (&acc)[2][2][4][2], const pg8::Unit& u, int wr, int wc, int fr, int fq) const {
        const int row0 = u.pm * 256 + wr * 64 + fr, col0 = u.aux * 512 + u.pn * 128 + wc * 32 + 8 * fq;
#pragma unroll
        for (int ai = 0; ai < 2; ++ai)
#pragma unroll
            for (int m = 0; m < 4; ++m) { const int r = row0 + ai * 128 + m * 16; const float rs = rsb[r], gwt = gws[2 * r + u.aux];
                float hv[8];
#pragma unroll
                for (int n = 0; n < 2; ++n)
#pragma unroll
                    for (int k = 0; k < 4; ++k) { const float g = acc[ai][0][m][n][k] * rs, uu = acc[ai][1][m][n][k] * rs; hv[4 * n + k] = g / (1.0f + __expf(-g)) * uu * gwt; }
                u32x4 w; w.x = pg8::cvt_pk_bf16(hv[0], hv[1]); w.y = pg8::cvt_pk_bf16(hv[2], hv[3]); w.z = pg8::cvt_pk_bf16(hv[4], hv[5]); w.w = pg8::cvt_pk_bf16(hv[6], hv[7]);
                *(u32x4*)(H + (size_t)r * 1024 + col0) = w; }
    }
};
struct MoeDownSched {
    int G, vcu; volatile LAS int* tp; const char *hb, *wd;
    __device__ __forceinline__ bool next(int i, pg8::Unit& u) const {
        const int L = (i >> 1) * G + vcu, slot = i & 1; const int ntile = tp[24]; if (L >= ntile * 4) return false;
        const int tau = L >> 2, pn = L & 3; const int e = moe_expert(moe_bucket_of_tile(tp, tau), slot);
        u.pm = tau; u.pn = pn; u.aux = slot; u.flags = slot ? 2 : 1; u.A = hb + (size_t)tau * 256 * 2048 + slot * 1024; u.B = wd + ((size_t)e * 1024 + pn * 256) * 1024; return true;
    }
};
struct EpiMoeDown {
    float* out; const int* toks;
    __device__ __forceinline__ void operator()(const f32x4 (&acc)[2][2][4][2], const pg8::Unit& u, int wr, int wc, int fr, int fq) const {
        const int row0 = u.pm * 256 + wr * 64 + fr, col0 = u.pn * 256 + wc * 32 + 8 * fq;
#pragma unroll
        for (int ai = 0; ai < 2; ++ai)
#pragma unroll
            for (int m = 0; m < 4; ++m) { const int tok = toks[row0 + ai * 128 + m * 16];
                if (tok >= 0) {
#pragma unroll
                    for (int bj = 0; bj < 2; ++bj) { float* p = out + (size_t)tok * 1024 + col0 + bj * 128;
                        *(f32x4*)p = *(const f32x4*)p + acc[ai][bj][m][0]; *(f32x4*)(p + 4) = *(const f32x4*)(p + 4) + acc[ai][bj][m][1]; } }
                asm volatile("" ::: "memory"); }
    }
};

struct Args { const float* in[34]; float* out; unsigned char* ws; unsigned char* ybuf; int ph_lo, ph_hi; };
__global__ void __launch_bounds__(NWAVES * 64, 2) mk_fwd(Args args) {
    extern __shared__ __attribute__((aligned(16))) unsigned char lds[];
    Frame F;
    F.lds = (LAS unsigned char*)lds;
    F.tid = threadIdx.x; F.lane = F.tid & 63; F.wave = __builtin_amdgcn_readfirstlane(F.tid >> 6);
    F.G = gridDim.x; { const int bx = blockIdx.x; F.vcu = (F.G % 8 == 0) ? (bx % 8) * (F.G / 8) + bx / 8 : bx; }
    F.ws = args.ws; F.ctl = (unsigned*)(args.ws + WS_CTL); F.in = args.in; F.out = args.out;
    volatile LAS unsigned* MISC = (volatile LAS unsigned*)(F.lds + MISC_OFF);
    for (int u = F.tid; u < 128; u += NWAVES * 64) MISC[u] = 0u;
    __syncthreads();
    XcdBarrier bar = xcd_barrier_post(F.ctl + CW_BAR, MISC + 8);
    const int lo = args.ph_lo, hi = args.ph_hi;
#define IN(k) (lo <= (k) && (k) < hi)
#define SEAM(k) do { if (IN(k) && IN((k) + 1)) xcd_barrier(bar); } while (0)
    unsigned char* ws = args.ws;
    if (IN(0)) { p0_prologue(F); }
    SEAM(0);
    if (IN(1)) {
        P1Sched S{F.G, F.vcu, (const char*)(ws + WS_WIN), (const char*)(ws + WS_XN), (const char*)(ws + WS_MEMN), (const char*)(ws + WS_WKV)};
        EpiBf16Multi E{ws};
        pg8::gemm_phase(F.lds, 1024, 1024, 1024, S, E);
    }
    SEAM(1);
    if (IN(2)) { p2a_kprep(F); }
    SEAM(2);
    if (IN(3)) {
        const bf16_t* QKV = (const bf16_t*)(ws + WS_QKV); bf16_t* Yb = (bf16_t*)args.ybuf;
#ifndef NO_HY
        for (int j = 0; j < 2; ++j) { const int c = j * F.G + F.vcu; if (c < 512)
            hy::hyena_unit(c, (const bf16_t*)(ws + WS_UHT), (bf16_t*)(ws + WS_ZS), (bf16_t*)(ws + WS_YHT), (const bf16_t*)(ws + WS_KF), (const float*)(F.ctl + CW_FN), args.in[4], args.in[5], args.in[12], F.lds); }
        __syncthreads();
#endif
#ifndef NO_AT
        for (int i = 0; i < 4; ++i) { const int uid = i * F.G + F.vcu; if (uid < 1024) { const int pair = uid >> 6, rem = uid & 63;
            at::attn_unit<8>(pair >> 1, (pair & 1) * 4 + (rem >> 4), rem & 15, QKV, Yb, args.in[13], (const float*)(ws + WS_ROPE), (char*)lds); } }
#endif
    }
    SEAM(3);
#ifndef NO_P2C
    if (IN(4)) { p2c_transpose(F, (bf16_t*)args.ybuf); }
#endif
    SEAM(4);
    if (IN(5)) {
        TileSched S{F.G, F.vcu, T / 256, 2, (const char*)args.ybuf, (const char*)(ws + WS_WOUT), (size_t)256 * 2048, (size_t)256 * 2048};
        EpiResid E{args.in[0], args.out, (bf16_t*)(ws + WS_XN), (float*)(F.ctl + CW_SS1)};
        pg8::gemm_phase(F.lds, 1024, 1024, 1024, S, E);
    }
    SEAM(5);
    if (IN(6)) {
        TileSched S{F.G, F.vcu, T / 256, 1, (const char*)(ws + WS_XN), (const char*)(ws + WS_WQM), (size_t)256 * 2048, (size_t)256 * 2048};
        EpiRowScale E{(bf16_t*)(ws + WS_QM), (const float*)(F.ctl + CW_SS1)};
        pg8::gemm_phase(F.lds, 1024, 1024, 1024, S, E);
    }
    SEAM(6);
    if (IN(7)) {
        for (int i = 0; i < 2; ++i) { const int uid = i * F.G + F.vcu; if (uid < 512)
            ma::memattn_unit(uid >> 6, (uid >> 4) & 3, uid & 15, (const bf16_t*)(ws + WS_QM), (const bf16_t*)(ws + WS_KVM), (bf16_t*)(ws + WS_OM), args.in[23], F.lds); }
        __syncthreads();
    }
    SEAM(7);
    if (IN(8)) {
        TileSched S{F.G, F.vcu, T / 256, 2, (const char*)(ws + WS_OM), (const char*)(ws + WS_WOM), (size_t)256 * 1024, (size_t)256 * 1024};
        EpiResid E{args.out, args.out, (bf16_t*)(ws + WS_XN), (float*)(F.ctl + CW_SS2)};
        pg8::gemm_phase(F.lds, 512, 512, 512, S, E);
    }
    SEAM(8);
    if (IN(9)) { p6a_route(F); }
    SEAM(9);
    volatile LAS int* tp = (volatile LAS int*)(MISC + 32);
    if (IN(10)) { moe_prefix(F, tp); p6b_scatter(F, tp); }
    SEAM(10);
    if (IN(11)) {
        moe_prefix(F, tp);
        MoeUpSched S{F.G, F.vcu, tp, (const char*)(ws + WS_XS), (const char*)(ws + WS_WGU)};
        EpiMoeUp E{(bf16_t*)(ws + WS_HB), (const float*)(ws + WS_RS), (const float*)(ws + WS_GWS)};
        pg8::gemm_phase(F.lds, 1024, 1024, 1024, S, E);
    }
    SEAM(11);
    if (IN(12)) {
        moe_prefix(F, tp);
        MoeDownSched S{F.G, F.vcu, tp, (const char*)(ws + WS_HB), (const char*)(ws + WS_WD)};
        EpiMoeDown E{args.out, (const int*)(ws + WS_TOKS)};
        pg8::gemm_phase(F.lds, 1024, 512, 512, S, E);
    }
#undef IN
#undef SEAM
}

#ifdef MK_HYBRID
__global__ __launch_bounds__(256) void cv_u(const bf16_t* UHT, const bf16_t* QKV, float* U) {
    const int t = blockIdx.x;
    for (int c = threadIdx.x; c < 1536; c += 256) U[(size_t)t * 2304 + c] = bf2f(UHT[(size_t)c * T + t]);
    for (int c = threadIdx.x; c < 768; c += 256) U[(size_t)t * 2304 + 1536 + c] = bf2f(QKV[(size_t)t * 768 + c]);
}
__global__ __launch_bounds__(256) void cv_y(const bf16_t* Yb, float* Yf) {
    const int t = blockIdx.x;
    for (int c = threadIdx.x; c < 1024; c += 256) Yf[(size_t)t * 1024 + c] = bf2f(Yb[(size_t)t * 1024 + c]);
}
#ifndef MK_PMODE
#define MK_PMODE 0
#endif
__global__ __launch_bounds__(256) void cv_ypatch(const bf16_t* Yb, float* Yf, int coff) {
    const int t = blockIdx.x; const int ts = t & (SEQ - 1);
    if (MK_PMODE == 1 && !(ts < 64)) return;
    if (MK_PMODE == 2 && !(ts >= SEQ - 64)) return;
    if (MK_PMODE == 3 && !(ts >= 64 && ts < SEQ - 64)) return;
    if (MK_PMODE == 4 && !((t >> 12) < 4)) return;
    for (int c = threadIdx.x; c < 512; c += 256) { if (MK_PMODE == 5 && c >= 64) continue; if (MK_PMODE == 6 && c < 448) continue; Yf[(size_t)t * 1024 + coff + c] = bf2f(Yb[(size_t)t * 1024 + coff + c]); }
}
__global__ __launch_bounds__(256) void cv_yht(const bf16_t* YHTc, const float* U, float* Yf) {
    const int t = blockIdx.x;
    for (int c = threadIdx.x; c < 512; c += 256) Yf[(size_t)t * 1024 + c] = U[(size_t)t * 2304 + 1024 + c] * bf2f(YHTc[(size_t)c * T + t]);
}
__global__ __launch_bounds__(256) void cv_taps(const bf16_t* KF, const float* FN, float* KK, float* invn) {
    const int o = blockIdx.y, di = blockIdx.x;
    for (int c = threadIdx.x; c < 512; c += 256) KK[((size_t)o * 8191 + di) * 512 + c] = bf2f(KF[((size_t)o * 512 + c) * 8192 + (4096 - (di - 4095))]);
    if (di == 0) for (int c = threadIdx.x; c < 512; c += 256) invn[o * 512 + c] = 1.0f / (FN[o * 512 + c] + 1e-6f);
}
__global__ __launch_bounds__(256) void cv_kvm(const bf16_t* KVM, float* KMEM, float* VMEM) {
    const int r = blockIdx.x;
    for (int c = threadIdx.x; c < 512; c += 256) { KMEM[(size_t)r * 512 + c] = bf2f(KVM[(size_t)r * 1024 + c]); VMEM[(size_t)r * 512 + c] = bf2f(KVM[(size_t)r * 1024 + 512 + c]); }
}

#endif
extern "C" void kernel_launch(void* const* d_in, const int* in_sizes, int n_in, void* d_out, int out_size, void* d_ws, size_t ws_size, hipStream_t stream) {
#ifdef MK_HYBRID
    using nv::GemmArgs; using nv::gemm_f32; using nv::filt_mlp; using nv::filt_taps; using nv::filt_norm; using nv::shortconv_inplace; using nv::qk_norm_rope; using nv::longconv_naive;
    using nv::attn_naive; using nv::group_rmsnorm; using nv::rmsnorm_rows; using nv::memattn_naive; using nv::router_naive; using nv::moe_offsets; using nv::swiglu;
#endif
    static int grid = 0;
    if (grid == 0) {
        int dev = 0, cus = 0;
        if (hipGetDevice(&dev) != hipSuccess || hipDeviceGetAttribute(&cus, hipDeviceAttributeMultiprocessorCount, dev) != hipSuccess) { grid = -1; return; }
        if (hipFuncSetAttribute((const void*)mk_fwd, hipFuncAttributeMaxDynamicSharedMemorySize, LDS_BYTES) != hipSuccess) { fprintf(stderr, "hipFuncSetAttribute failed\n"); grid = -1; return; }
        (void)hipGetLastError();
        grid = cus;
    }
    if (grid < 0) return;
    (void)hipMemsetAsync((char*)d_ws + WS_CTL, 0, CTL_ZERO_BYTES, stream);
    Args a{};
    for (int i = 0; i < 34; ++i) a.in[i] = (const float*)d_in[i];
    a.out = (float*)d_out; a.ws = (unsigned char*)d_ws;
#ifdef MK_PATCH
    a.ybuf = (unsigned char*)d_out + 64 * MiBx;
#else
    a.ybuf = (unsigned char*)d_ws + WS_Y;
#endif
    a.ph_lo = 0; a.ph_hi = MK_STAGE;
    hipLaunchKernelGGL(mk_fwd, dim3(grid), dim3(NWAVES * 64), LDS_BYTES, stream, a);

#ifdef MK_HYBRID
    const float* x = (const float*)d_in[0];
    auto Fi = [&](int i) { return (const float*)d_in[i]; };
    unsigned char* ws = (unsigned char*)d_ws; float* out = (float*)d_out;
    constexpr size_t N_U = 0, N_KK = 288 * MiBx, N_A2 = 320 * MiBx, N_KMEM = 321 * MiBx, N_VMEM = 325 * MiBx, N_SMALL = 329 * MiBx, N_LIST = 330 * MiBx, N_GATE = 332 * MiBx,
                     N_Y = 336 * MiBx, N_H = 0, N_QM = 128 * MiBx, N_OM = 192 * MiBx, N_G = 128 * MiBx, N_UP = 336 * MiBx;
    float* U = (float*)(ws + N_U); float* KK = (float*)(ws + N_KK); float* A2 = (float*)(ws + N_A2);
    float* KMEM = (float*)(ws + N_KMEM); float* VMEM = (float*)(ws + N_VMEM);
    float* invn = (float*)(ws + N_SMALL); int* cnt = (int*)(ws + N_SMALL + 8192); int* offs = cnt + 32;
    int* list = (int*)(ws + N_LIST); float* gates = (float*)(ws + N_GATE);
    float* Y = (float*)(ws + N_Y); float* Z2 = out; float* H = (float*)(ws + N_H); float* QM = (float*)(ws + N_QM); float* OM = (float*)(ws + N_OM);
    float* G = (float*)(ws + N_G); float* UP = (float*)(ws + N_UP);
    auto gemm0 = [&](const float* A, int lda, const float* Bm, int ldb, float* C, int ldc, int M, int N, int K, const float* R) {
        GemmArgs g{}; g.A = A; g.lda = lda; g.Bm = Bm; g.ldb = ldb; g.C = C; g.ldc = ldc; g.M = M; g.N = N; g.K = K; g.R = R;
        if (R) hipLaunchKernelGGL(gemm_f32<1>, dim3(N / 64, M / 64, 1), dim3(256), 0, stream, g);
        else hipLaunchKernelGGL(gemm_f32<0>, dim3(N / 64, M / 64, 1), dim3(256), 0, stream, g);
    };
    hipLaunchKernelGGL(cv_kvm, dim3(NMEMT), dim3(256), 0, stream, (const bf16_t*)(ws + WS_KVM), KMEM, VMEM);
    if (MK_STAGE < 6) {
    if (MK_PATCHV && MK_PMODE == 7) (void)hipMemcpyAsync((unsigned char*)d_out + 64 * MiBx, ws + WS_YHT, 32 * MiBx, hipMemcpyDeviceToDevice, stream);
    if (MK_STAGE <= 2 || MK_PATCHV) {
#ifdef MK_TAPS
    hipLaunchKernelGGL(cv_taps, dim3(8191, 2), dim3(256), 0, stream, (const bf16_t*)(ws + WS_KF), (const float*)((unsigned*)(ws + WS_CTL) + CW_FN), KK, invn);
#endif
    hipLaunchKernelGGL(cv_u, dim3(T), dim3(256), 0, stream, (const bf16_t*)(ws + WS_UHT), (const bf16_t*)(ws + WS_QKV), U);
#ifndef MK_TAPS
    hipLaunchKernelGGL(filt_mlp, dim3(nv::L), dim3(64), 0, stream, Fi(6), Fi(7), Fi(8), Fi(9), Fi(11), A2);
    hipLaunchKernelGGL(filt_taps, dim3(8, nv::L), dim3(256), 0, stream, A2, Fi(10), KK);
    hipLaunchKernelGGL(filt_norm, dim3(4), dim3(256), 0, stream, KK, invn);
#endif
    hipLaunchKernelGGL(shortconv_inplace, dim3(6, nv::B), dim3(256), 0, stream, U, Fi(4), Fi(5));
    hipLaunchKernelGGL(qk_norm_rope, dim3(T * 10 / 4), dim3(256), 0, stream, U, Fi(13), Fi(14));
    hipLaunchKernelGGL(longconv_naive, dim3(2, nv::L / 8, nv::B), dim3(256), 0, stream, U, nv::DIN, 0, KK, invn, Fi(12), U, nv::DIN, 512, Z2, 512, 0);
    hipLaunchKernelGGL(longconv_naive, dim3(2, nv::L / 8, nv::B), dim3(256), 0, stream, Z2, 512, 0, KK + (size_t)8191 * 512, invn + 512, Fi(12) + 512, U, nv::DIN, 1024, Y, 1024, 0);
    hipLaunchKernelGGL(attn_naive, dim3(nv::L / 256, 8, nv::B), dim3(256), 0, stream, U, Y);
    if (MK_PATCHV && MK_PMODE == 7) hipLaunchKernelGGL(cv_yht, dim3(T), dim3(256), 0, stream, (const bf16_t*)((unsigned char*)d_out + 64 * MiBx), U, Y);
    else if (MK_PATCHV) hipLaunchKernelGGL(cv_ypatch, dim3(T), dim3(256), 0, stream, (const bf16_t*)a.ybuf, Y, MK_PATCHV == 1 ? 512 : 0);
    } else {
    hipLaunchKernelGGL(cv_y, dim3(T), dim3(256), 0, stream, (const bf16_t*)(ws + WS_Y), Y);
    }
    hipLaunchKernelGGL(group_rmsnorm<64>, dim3(T * 8 / 4), dim3(256), 0, stream, Y, 1024, 0, 8, Fi(15), 64, T);
    hipLaunchKernelGGL(group_rmsnorm<64>, dim3(T * 8 / 4), dim3(256), 0, stream, Y, 1024, 512, 8, Fi(16), 64, T);
    gemm0(Y, 1024, Fi(17), 1024, out, 1024, T, 1024, 1024, x);
    }
    if (MK_STAGE < 9) {
    if (MK_STAGE <= 2) hipLaunchKernelGGL(group_rmsnorm<128>, dim3(NMEMT * 4 / 4), dim3(256), 0, stream, KMEM, 512, 0, 4, Fi(24), 0, NMEMT);
    hipLaunchKernelGGL(rmsnorm_rows, dim3(T / 4), dim3(256), 0, stream, out, Fi(18), H, T);
    gemm0(H, 1024, Fi(20), 512, QM, 512, T, 512, 1024, nullptr);
    hipLaunchKernelGGL(group_rmsnorm<128>, dim3(T * 4 / 4), dim3(256), 0, stream, QM, 512, 0, 4, Fi(23), 0, T);
    hipLaunchKernelGGL(memattn_naive, dim3(T * 4 / 4), dim3(256), 0, stream, QM, KMEM, VMEM, OM);
    gemm0(OM, 512, Fi(25), 1024, out, 1024, T, 1024, 512, out);
    }
    if (MK_STAGE < 13) {
    hipLaunchKernelGGL(rmsnorm_rows, dim3(T / 4), dim3(256), 0, stream, out, Fi(26), H, T);
    (void)hipMemsetAsync(cnt, 0, 256, stream);
    hipLaunchKernelGGL(router_naive, dim3(T / 4), dim3(256), 0, stream, H, Fi(27), Fi(28), Fi(29), Fi(30), cnt, list, gates);
    hipLaunchKernelGGL(moe_offsets, dim3(1), dim3(64), 0, stream, cnt, offs);
    {
        GemmArgs g{}; g.A = H; g.lda = 1024; g.Bm = Fi(31); g.ldb = 512; g.C = G; g.ldc = 512; g.M = T; g.N = 512; g.K = 1024; g.cnt = cnt; g.offs = offs; g.list = list; g.gates = gates; g.bstride = (size_t)1024 * 512;
        hipLaunchKernelGGL(gemm_f32<2>, dim3(512 / 64, T / 64, 16), dim3(256), 0, stream, g);
        g.Bm = Fi(32); g.C = UP;
        hipLaunchKernelGGL(gemm_f32<2>, dim3(512 / 64, T / 64, 16), dim3(256), 0, stream, g);
        hipLaunchKernelGGL(swiglu, dim3((unsigned)(((size_t)2 * T * 512 + 255) / 256)), dim3(256), 0, stream, G, UP, (size_t)2 * T * 512);
        GemmArgs g2{}; g2.A = G; g2.lda = 512; g2.Bm = Fi(33); g2.ldb = 1024; g2.C = out; g2.ldc = 1024; g2.M = T; g2.N = 1024; g2.K = 512; g2.cnt = cnt; g2.offs = offs; g2.list = list; g2.gates = gates; g2.bstride = (size_t)512 * 1024;
        hipLaunchKernelGGL(gemm_f32<3>, dim3(1024 / 64, T / 64, 16), dim3(256), 0, stream, g2);
    }
    }
#endif
}
```

```cpp
#include <hip/hip_runtime.h>
#include <cstdio>
#include <cstdint>
#include <cmath>
#define MK_STAGE 99
#define GAS __attribute__((address_space(1)))
#define LAS __attribute__((address_space(3)))
typedef unsigned short bf16_t;
typedef short bf16x8 __attribute__((ext_vector_type(8)));
typedef short s16x4 __attribute__((ext_vector_type(4)));
typedef float f32x4 __attribute__((ext_vector_type(4)));
typedef float f32x2 __attribute__((ext_vector_type(2)));
typedef float f32x16 __attribute__((ext_vector_type(16)));
typedef unsigned u32x4 __attribute__((ext_vector_type(4)));
typedef unsigned u32x2 __attribute__((ext_vector_type(2)));

constexpr int NB = 8, SEQ = 4096, T = NB * SEQ, DM = 1024, DIN = 2304, NMEMT = NB * 256;
constexpr int NWAVES = 8;
constexpr float EPSN = 1e-6f;

constexpr size_t MiBx = 1u << 20;
constexpr size_t WS_CTL = 0, CTL_ZERO_BYTES = 65536;
constexpr size_t WS_WR = 1 * MiBx;
constexpr size_t WS_ROPE = WS_WR + 98304;
constexpr size_t WS_WIN = 2 * MiBx;
constexpr size_t WS_WOUT = 8 * MiBx;
constexpr size_t WS_WQM = 10 * MiBx;
constexpr size_t WS_WKV = 11 * MiBx;
constexpr size_t WS_WOM = 13 * MiBx;
constexpr size_t WS_WGU = 14 * MiBx;
constexpr size_t WS_WD = 288 * MiBx;
constexpr size_t WS_MEMN = 62 * MiBx;
constexpr size_t WS_KVM = 66 * MiBx;
constexpr size_t WS_KF = 70 * MiBx;
constexpr size_t WS_MOE = 86 * MiBx;
constexpr size_t WS_RMS0 = WS_MOE + 2 * MiBx + 512 * 1024;
constexpr size_t WS_XN = 96 * MiBx;
constexpr size_t WS_UHT = 336 * MiBx;
constexpr size_t WS_QKV = 432 * MiBx;
constexpr size_t WS_YHT = 224 * MiBx;
constexpr size_t WS_Y = 160 * MiBx;
constexpr size_t WS_ZS = 256 * MiBx;
constexpr size_t WS_QM = 336 * MiBx, WS_OM = 368 * MiBx;
constexpr size_t WS_END = 480 * MiBx;
constexpr int CW_TMO = 0, CW_BAR = 4096;
constexpr int CW_FN = 8192;
constexpr int CW_CNT = 9472;
static_assert((CW_CNT + 24 * 64) * 4 <= (int)CTL_ZERO_BYTES, "ctl region");

constexpr int RING_BYTES = 131072;
constexpr int LDS_BYTES = 147456;
constexpr int MISC_OFF = LDS_BYTES - 512;

#define LDS_WAIT() asm volatile("s_waitcnt lgkmcnt(0)" ::: "memory")
#define VM_WAIT() asm volatile("s_waitcnt vmcnt(0)" ::: "memory")
__device__ __forceinline__ unsigned f2bf(float f) { unsigned u = __builtin_bit_cast(unsigned, f); return (u + 0x7fffu + ((u >> 16) & 1u)) >> 16; }
__device__ __forceinline__ unsigned pk2(float lo, float hi) { return f2bf(lo) | (f2bf(hi) << 16); }
__device__ __forceinline__ float bf2f(unsigned short b) { return __builtin_bit_cast(float, (unsigned)b << 16); }
__device__ __forceinline__ float bflo(unsigned w) { return __builtin_bit_cast(float, w << 16); }
__device__ __forceinline__ float bfhi(unsigned w) { return __builtin_bit_cast(float, w & 0xffff0000u); }
__device__ __forceinline__ float wsum_sw(float v) {
#define SWZ_(m) v += __int_as_float(__builtin_amdgcn_ds_swizzle(__float_as_int(v), 0x1F | ((m) << 10)))
    SWZ_(1); SWZ_(2); SWZ_(4); SWZ_(8); SWZ_(16);
#undef SWZ_
    return __int_as_float(__builtin_amdgcn_readlane(__float_as_int(v), 0)) + __int_as_float(__builtin_amdgcn_readlane(__float_as_int(v), 32));
}
__device__ __forceinline__ float wsum(float v) {
#pragma unroll
    for (int o = 1; o < 64; o <<= 1) v += __shfl_xor(v, o);
    return v;
}

namespace pg8 {
constexpr int BM = 256, BK = 64, HALF = 128, HTB = HALF * BK * 2, STAGE_BYTES = 8 * HTB;
__host__ __device__ __forceinline__ int lds_byte(int r, int c) { const int st = (r >> 4) * 2 + (c >> 5), rr = r & 15, cc = c & 31, ob = rr * 64 + cc * 2; return st * 1024 + (ob ^ (((ob >> 9) & 1) << 5)); }
__host__ __device__ __forceinline__ void stage_rc(int b, int& R, int& C) { const int st = b / 1024, sb = b % 1024, swz = sb ^ (((sb >> 9) & 1) << 5); R = (st >> 1) * 16 + swz / 64; C = (st & 1) * 32 + (swz % 64) / 2; }
__host__ __device__ __forceinline__ int perm32(int rho) { const int n = rho >> 4, i = rho & 15; return 8 * (i >> 2) + 4 * n + (i & 3); }

struct Unit { const char* A; const char* B; const int* rows; int pm, pn, aux, flags, kt, nvalid; };
__device__ __forceinline__ unsigned cvt_pk_bf16(float lo, float hi) { unsigned r; asm volatile("v_cvt_pk_bf16_f32 %0, %1, %2" : "=v"(r) : "v"(lo), "v"(hi)); return r; }

template <class Epi, class Sched, bool GATHER = false>
__device__ __forceinline__ void gemm_phase(LAS unsigned char* lds, const int lda, const int ldb, const int K, const Sched& S, const Epi& E) {
    const int tid = threadIdx.x, wid = __builtin_amdgcn_readfirstlane(tid >> 6), lane = tid & 63, wr = wid >> 2, wc = wid & 3, fr = lane & 15, fq = lane >> 4;
    (void)K;
    unsigned voffA[2], voffB[2]; int rowA[2]; unsigned colA[2];
#pragma unroll
    for (int i = 0; i < 2; ++i) { int R, C; stage_rc(tid * 16 + i * 8192, R, C); const int Rb = (R & ~31) + perm32(R & 31);
        voffA[i] = (unsigned)(R * lda + C) * 2u; voffB[i] = (unsigned)(Rb * ldb + C) * 2u; rowA[i] = R; colA[i] = (unsigned)C * 2u; }
    unsigned gA[2][2], gN[2][2];
    const size_t kstep = (size_t)(BK * 2);
    const size_t hstepA = (size_t)HALF * lda * 2, hstepB = (size_t)HALF * ldb * 2;
    const unsigned ldsw = (unsigned)wid * 1024u;
    const int aoff = lds_byte(wr * 64 + fr, fq * 8), boff = lds_byte(wc * 32 + fr, fq * 8);
#define PG8_SA(b, h) (((b) * 2 + (h)) * HTB)
#define PG8_SB(b, h) ((4 + (b) * 2 + (h)) * HTB)
#define PG8_STAGE(bufoff, gbase, voff) do { _Pragma("unroll") for (int _i = 0; _i < 2; ++_i) \
        __builtin_amdgcn_global_load_lds((const unsigned*)((const char*)(gbase) + (voff)[_i]), (LAS unsigned*)(lds + (bufoff) + ldsw + _i * 8192), 16, 0, 0); } while (0)
#define PG8_STAGE_A(bufoff, gbase, H, G_) do { _Pragma("unroll") for (int _i = 0; _i < 2; ++_i) \
        __builtin_amdgcn_global_load_lds((const unsigned*)((const char*)(gbase) + (GATHER ? G_[H][_i] : ((H) ? (unsigned)hstepA : 0u) + voffA[_i])), (LAS unsigned*)(lds + (bufoff) + ldsw + _i * 8192), 16, 0, 0); } while (0)
#define PG8_ROWOFF(G_, U_) do { if constexpr (GATHER) { _Pragma("unroll") for (int _h = 0; _h < 2; ++_h) _Pragma("unroll") for (int _i = 0; _i < 2; ++_i) G_[_h][_i] = S.rowoff(U_, rowA[_i] + 128 * _h) + colA[_i]; } } while (0)
#define PG8_LDA(dst, b, h) do { _Pragma("unroll") for (int m = 0; m < 4; ++m) _Pragma("unroll") for (int k = 0; k < 2; ++k) dst[m][k] = *(const LAS bf16x8*)(lds + PG8_SA(b, h) + aoff + m * 2048 + k * 1024); } while (0)
#define PG8_LDB(dst, b, h) do { _Pragma("unroll") for (int n = 0; n < 2; ++n) _Pragma("unroll") for (int k = 0; k < 2; ++k) dst[n][k] = *(const LAS bf16x8*)(lds + PG8_SB(b, h) + boff + n * 2048 + k * 1024); } while (0)
#define PG8_MMA(ai, bj, At, Bt) do { __builtin_amdgcn_s_setprio(1); _Pragma("unroll") for (int m = 0; m < 4; ++m) _Pragma("unroll") for (int n = 0; n < 2; ++n) _Pragma("unroll") for (int k = 0; k < 2; ++k) \
        acc[ai][bj][m][n] = __builtin_amdgcn_mfma_f32_16x16x32_bf16(Bt[n][k], At[m][k], acc[ai][bj][m][n], 0, 0, 0); __builtin_amdgcn_s_setprio(0); } while (0)
#define PG8_WAIT_V(n) asm volatile("s_waitcnt vmcnt(" #n ")" ::: "memory")
#define PG8_WAIT_L(n) asm volatile("s_waitcnt lgkmcnt(" #n ")" ::: "memory")
#define PG8_BAR __builtin_amdgcn_s_barrier()
#define PG8_SCHED __builtin_amdgcn_sched_barrier(0)
#define PG8_ZERO() do { _Pragma("unroll") for (int a = 0; a < 2; ++a) _Pragma("unroll") for (int b = 0; b < 2; ++b) _Pragma("unroll") for (int m = 0; m < 4; ++m) _Pragma("unroll") for (int n = 0; n < 2; ++n) acc[a][b][m][n] = (f32x4){0.f, 0.f, 0.f, 0.f}; } while (0)
    Unit cur, nxt; int ui = 0;
    if (!S.next(0, cur)) return;
    f32x4 acc[2][2][4][2];
    PG8_ZERO();
    bf16x8 At[4][2], B0[2][2], B1[2][2];
    const char* cA = cur.A; const char* cB = cur.B;
    PG8_ROWOFF(gA, cur);
    PG8_STAGE(PG8_SB(0, 0), cB, voffB); PG8_STAGE(PG8_SB(0, 1), cB + hstepB, voffB); PG8_STAGE_A(PG8_SA(0, 0), cA, 0, gA); PG8_STAGE_A(PG8_SA(0, 1), cA, 1, gA);
    if (wr == 1) PG8_BAR;
    PG8_WAIT_V(2); PG8_BAR;
    PG8_STAGE(PG8_SB(1, 0), cB + kstep, voffB); PG8_STAGE_A(PG8_SA(1, 0), cA + kstep, 0, gA); PG8_STAGE(PG8_SB(1, 1), cB + hstepB + kstep, voffB);
    PG8_WAIT_V(6); PG8_BAR;
    for (;;) {
        const bool has_next = S.next(ui + 1, nxt);
        const char* nA = has_next ? nxt.A : cA; const char* nB = has_next ? nxt.B : cB;
        if (has_next) PG8_ROWOFF(gN, nxt); else if constexpr (GATHER) { _Pragma("unroll") for (int _h = 0; _h < 2; ++_h) _Pragma("unroll") for (int _i = 0; _i < 2; ++_i) gN[_h][_i] = gA[_h][_i]; }
        const int nt = cur.kt;
        for (int t = 0; t < nt; t += 2) {
            const bool last = (t == nt - 2);
            const char* a1 = cA + (size_t)(t + 1) * kstep;
            const char* a2 = last ? nA : cA + (size_t)(t + 2) * kstep; const char* b2 = last ? nB : cB + (size_t)(t + 2) * kstep;
            const char* a3 = a2 + kstep; const char* b3 = b2 + kstep;
            unsigned g2[2][2];
            if constexpr (GATHER) { _Pragma("unroll") for (int _h = 0; _h < 2; ++_h) _Pragma("unroll") for (int _i = 0; _i < 2; ++_i) g2[_h][_i] = last ? gN[_h][_i] : gA[_h][_i]; }
            PG8_LDB(B0, 0, 0); PG8_LDB(B1, 0, 1); PG8_SCHED; PG8_LDA(At, 0, 0); PG8_STAGE_A(PG8_SA(1, 1), a1, 1, gA);
            PG8_WAIT_V(8); PG8_WAIT_L(0); PG8_BAR; PG8_MMA(0, 0, At, B0); PG8_MMA(0, 1, At, B1); PG8_BAR; PG8_SCHED;
            PG8_LDA(At, 0, 1); PG8_STAGE(PG8_SB(0, 0), b2, voffB); PG8_STAGE(PG8_SB(0, 1), b2 + hstepB, voffB); PG8_STAGE_A(PG8_SA(0, 0), a2, 0, g2);
            PG8_WAIT_V(8); PG8_WAIT_L(0); PG8_BAR; PG8_MMA(1, 0, At, B0); PG8_MMA(1, 1, At, B1); PG8_BAR; PG8_SCHED;
            PG8_LDB(B0, 1, 0); PG8_LDB(B1, 1, 1); PG8_SCHED; PG8_LDA(At, 1, 0); PG8_STAGE_A(PG8_SA(0, 1), a2, 1, g2);
            PG8_WAIT_V(8); PG8_WAIT_L(0); PG8_BAR; PG8_MMA(0, 0, At, B0); PG8_MMA(0, 1, At, B1); PG8_BAR; PG8_SCHED;
            PG8_LDA(At, 1, 1); PG8_STAGE(PG8_SB(1, 0), b3, voffB); PG8_STAGE(PG8_SB(1, 1), b3 + hstepB, voffB); PG8_STAGE_A(PG8_SA(1, 0), a3, 0, g2);
            PG8_WAIT_V(8); PG8_WAIT_L(0); PG8_BAR; PG8_MMA(1, 0, At, B0); PG8_MMA(1, 1, At, B1); PG8_BAR; PG8_SCHED;
        }
        if (wr == 0) PG8_BAR;
        if (cur.flags & 2) E(acc, cur, wr, wc, fr, fq);
        if (!has_next) break;
        if (nxt.flags & 1) PG8_ZERO();
        cur = nxt; cA = nA; cB = nB; ++ui;
        if constexpr (GATHER) { _Pragma("unroll") for (int _h = 0; _h < 2; ++_h) _Pragma("unroll") for (int _i = 0; _i < 2; ++_i) gA[_h][_i] = gN[_h][_i]; }
        if (wr == 1) PG8_BAR;
    }
    PG8_WAIT_V(0);
    PG8_BAR;
#undef PG8_SA
#undef PG8_SB
#undef PG8_STAGE
#undef PG8_STAGE_A
#undef PG8_ROWOFF
#undef PG8_LDA
#undef PG8_LDB
#undef PG8_MMA
#undef PG8_WAIT_V
#undef PG8_WAIT_L
#undef PG8_BAR
#undef PG8_SCHED
#undef PG8_ZERO
}
}

#define XB_TMO      128
#define XB_XCNT(j)  (256  + 64 * (j))
#define XB_XSUB(j)  (1280 + 64 * (j))
#define XB_XGEN(j)  (2304 + 64 * (j))
#define XB_TOP      3328
#define XB_TOPGEN   3392
#define XCD_BAR_WORDS 3456
#define XB_SPIN_CAP (1u << 18)
__device__ __forceinline__ unsigned xb_ld(unsigned* p)              { return __hip_atomic_load(p, __ATOMIC_RELAXED, __HIP_MEMORY_SCOPE_AGENT); }
__device__ __forceinline__ unsigned xb_add(unsigned* p, unsigned v) { return __hip_atomic_fetch_add(p, v, __ATOMIC_RELAXED, __HIP_MEMORY_SCOPE_AGENT); }
__device__ __forceinline__ unsigned xb_xcc_id() { return (unsigned)__builtin_amdgcn_s_getreg((3 << 11) | 20) & 0xFu; }
#define XB_SPIN(cond, bar) do { unsigned _sp = 0; while (cond) { __builtin_amdgcn_s_sleep(1); \
    if ((++_sp & 255u) == 0u) { if (xb_ld(&(bar)[XB_TMO])) break; if (_sp > XB_SPIN_CAP) { atomicAdd(&(bar)[XB_TMO], 1u); break; } } } } while (0)
struct XcdBarrier { unsigned* bar; unsigned x; volatile LAS unsigned* st; };
__device__ __forceinline__ XcdBarrier xcd_barrier_post(unsigned* bar, volatile LAS unsigned* st) {
    XcdBarrier b; b.bar = bar; b.x = xb_xcc_id(); b.st = st;
    if (threadIdx.x == 0) (void)xb_add(&bar[XB_XCNT(b.x)], 1u);
    return b;
}
__device__ __forceinline__ void xcd_barrier_complete(unsigned* bar, unsigned x, unsigned& nloc, unsigned& nx) {
    const unsigned G = gridDim.x * gridDim.y * gridDim.z;
    unsigned sum, cnt, mine, sp = 0u;
    for (;;) {
        sum = 0u; cnt = 0u; mine = 0u;
#pragma unroll
        for (unsigned j = 0; j < 16; ++j) { const unsigned c = xb_ld(&bar[XB_XCNT(j)]); sum += c; cnt += (c > 0u) ? 1u : 0u; mine = (j == x) ? c : mine; }
        if (sum == G) break;
        __builtin_amdgcn_s_sleep(1);
        if ((++sp & 255u) == 0u) { if (xb_ld(&bar[XB_TMO])) break; if (sp > XB_SPIN_CAP) { atomicAdd(&bar[XB_TMO], 1u); break; } }
    }
    nloc = mine > 0u ? mine : 1u; nx = cnt > 0u ? cnt : 1u;
}
__device__ __forceinline__ void xcd_barrier(const XcdBarrier& b) {
    asm volatile("s_waitcnt vmcnt(0)" ::: "memory");
    __syncthreads();
    if (threadIdx.x == 0) {
        unsigned* bar = b.bar;
        __builtin_amdgcn_s_waitcnt(0);
        unsigned nloc = b.st[0], nx = b.st[1];
        if (nloc == 0u) { xcd_barrier_complete(bar, b.x, nloc, nx); b.st[0] = nloc; b.st[1] = nx; }
        const unsigned old = xb_add(&bar[XB_XSUB(b.x)], 1u);
        const unsigned gen = old / nloc;
        if (old + 1u == (gen + 1u) * nloc) {
            __builtin_amdgcn_fence(__ATOMIC_RELEASE, "agent");
            asm volatile("s_waitcnt vmcnt(0)" ::: "memory");
            const unsigned og = xb_add(&bar[XB_TOP], 1u);
            const unsigned tg = og / nx;
            if (og + 1u == (tg + 1u) * nx) xb_add(&bar[XB_TOPGEN], 1u);
            else XB_SPIN(xb_ld(&bar[XB_TOPGEN]) == tg, bar);
            __builtin_amdgcn_fence(__ATOMIC_ACQUIRE, "agent");
            xb_add(&bar[XB_XGEN(b.x)], 1u);
            asm volatile("s_waitcnt vmcnt(0)" ::: "memory");
        } else {
            XB_SPIN(xb_ld(&bar[XB_XGEN(b.x)]) == gen, bar);
            __builtin_amdgcn_fence(__ATOMIC_ACQUIRE, "agent");
            asm volatile("s_waitcnt vmcnt(0)" ::: "memory");
        }
    }
    __syncthreads();
}

struct Frame {
    LAS unsigned char* lds;
    unsigned* ctl;
    unsigned char* ws;
    const float* const* in;
    float* out;
    int tid, lane, wave, vcu, G;
};

#ifndef MK_TSB
#define MK_TSB 0
#endif
#ifdef MK_TS
#define TSI(k) do { if ((k) == MK_TS && blockIdx.x == MK_TSB && threadIdx.x == 0) { const unsigned long long t_ = __builtin_amdgcn_s_memrealtime(); ((volatile LAS unsigned*)(F.lds + MISC_OFF))[60] = (unsigned)t_; ((volatile LAS unsigned*)(F.lds + MISC_OFF))[61] = (unsigned)(t_ >> 32); } } while (0)
#else
#define TSI(k) do {} while (0)
#endif
template <bool GU> __device__ __forceinline__ void p0_transpose_item(const float* W, int N, int k0, int n0, bf16_t* dst, int ldk, const float* gain, LAS unsigned char* scr, int lane) {
    constexpr int TP = 264;
#pragma unroll 4
    for (int i = 0; i < 16; ++i) { const int kk = 2 * i + (lane >> 5); f32x4 v = *(const f32x4*)(W + (size_t)(k0 + kk) * N + n0 + 4 * (lane & 31)); if (gain) v = v * gain[k0 + kk];
        u32x2 w; w[0] = pk2(v[0], v[1]); w[1] = pk2(v[2], v[3]); *(LAS u32x2*)(scr + kk * TP + 8 * (lane & 31)) = w; }
    LDS_WAIT(); asm volatile("" ::: "memory");
#pragma unroll 2
    for (int sI = 0; sI < 8; ++sI) { const int n = 16 * sI + (lane >> 2), kc = lane & 3; unsigned short e[8];
#pragma unroll
        for (int q = 0; q < 8; ++q) e[q] = *(const LAS unsigned short*)(scr + (8 * kc + q) * TP + 2 * n);
        u32x4 o; o.x = e[0] | ((unsigned)e[1] << 16); o.y = e[2] | ((unsigned)e[3] << 16); o.z = e[4] | ((unsigned)e[5] << 16); o.w = e[6] | ((unsigned)e[7] << 16);
        const int drow = GU ? ((n >> 7) * 256 + (n & 127)) : n;
        *(GAS u32x4*)(dst + (size_t)drow * ldk + 8 * kc) = o; }
    LDS_WAIT(); asm volatile("" ::: "memory");
}
template <int NR> __device__ __forceinline__ void rms_rows_to_bf16(const float* x, bf16_t* o, float* rms, int row0, int lane) {
    f32x4 v[NR][4];
#pragma unroll
    for (int r = 0; r < NR; ++r) { const GAS f32x4* xr = (const GAS f32x4*)(x + (size_t)(row0 + r) * 1024) + lane;
#pragma unroll
        for (int j = 0; j < 4; ++j) v[r][j] = xr[64 * j]; }
#pragma unroll
    for (int r = 0; r < NR; ++r) { float s = 0.f;
#pragma unroll
        for (int j = 0; j < 4; ++j) s += (v[r][j].x * v[r][j].x + v[r][j].y * v[r][j].y) + (v[r][j].z * v[r][j].z + v[r][j].w * v[r][j].w);
        const float ms = wsum(s) * (1.f / 1024.f) + EPSN; const float rstd = 1.f / sqrtf(ms);
        if (rms && lane == 0) rms[row0 + r] = sqrtf(ms);
        GAS unsigned long long* o8 = (GAS unsigned long long*)(o + (size_t)(row0 + r) * 1024) + lane;
#pragma unroll
        for (int j = 0; j < 4; ++j) o8[64 * j] = (unsigned long long)pk2(v[r][j].x * rstd, v[r][j].y * rstd) | ((unsigned long long)pk2(v[r][j].z * rstd, v[r][j].w * rstd) << 32); }
}
__device__ __forceinline__ void rms2_load(f32x4 (&v)[2][4], const float* x, int row0, int lane) {
#pragma unroll
    for (int r = 0; r < 2; ++r) { const GAS f32x4* xr = (const GAS f32x4*)(x + (size_t)(row0 + r) * 1024) + lane;
#pragma unroll
        for (int j = 0; j < 4; ++j) v[r][j] = xr[64 * j]; }
}
__device__ __forceinline__ void rms2_finish(const f32x4 (&v)[2][4], bf16_t* o, float* rms, int row0, int lane) {
#pragma unroll
    for (int r = 0; r < 2; ++r) { float s = 0.f;
#pragma unroll
        for (int j = 0; j < 4; ++j) s += (v[r][j].x * v[r][j].x + v[r][j].y * v[r][j].y) + (v[r][j].z * v[r][j].z + v[r][j].w * v[r][j].w);
        const float ms = wsum(s) * (1.f / 1024.f) + EPSN; const float rstd = 1.f / sqrtf(ms);
        if (lane == 0) rms[row0 + r] = sqrtf(ms);
        GAS unsigned long long* o8 = (GAS unsigned long long*)(o + (size_t)(row0 + r) * 1024) + lane;
#pragma unroll
        for (int j = 0; j < 4; ++j) o8[64 * j] = (unsigned long long)pk2(v[r][j].x * rstd, v[r][j].y * rstd) | ((unsigned long long)pk2(v[r][j].z * rstd, v[r][j].w * rstd) << 32); }
}
__device__ __forceinline__ void p0_prologue(Frame& F) {
    const int gw = F.vcu * NWAVES + F.wave, NGW = F.G * NWAVES;
    const float* const* in = F.in;
    unsigned char* ws = F.ws;
    int xn_m = 2 * gw;
    {
        LAS float* zs = (LAS float*)(F.lds + 8 * 16384);
        LAS float* a1s = zs + 16 * 34;
        LAS float* a2s = a1s + 16 * 64;
        const float* w1 = in[6]; const float* b1 = in[7]; const float* w2 = in[8]; const float* b2 = in[9]; const float* w3 = in[10]; const float* freq = in[11];
        bf16_t* KF = (bf16_t*)(ws + WS_KF);
        for (int pb = F.vcu; pb < SEQ / 16; pb += F.G) {
            __syncthreads();
            for (int zi = F.tid; zi < 16 * 33; zi += NWAVES * 64) {
                const int p = zi / 33, f = zi % 33, pos = pb * 16 + p;
                const float tt = (float)pos / (float)(SEQ - 1);
                const float w = (2.0f * 3.14159265358979323846f / (float)SEQ) * (float)pos;
                float val;
                if (f == 0) val = tt;
                else { const int j = (f - 1) & 15; const float band = 1e-4f + (float)j * ((15.0f - 1e-4f) / 15.0f); val = (f <= 16) ? cosf(band * w) : sinf(band * w); }
                zs[p * 34 + f] = val;
            }
            __syncthreads();
            {
                LAS float* w1s = (LAS float*)(F.lds); LAS float* w2s = w1s + 33 * 64;
                for (int i = F.tid; i < 33 * 64; i += NWAVES * 64) w1s[i] = w1[i];
                for (int i = F.tid; i < 64 * 64; i += NWAVES * 64) w2s[i] = w2[i];
                __syncthreads();
#pragma unroll
                for (int pp = 0; pp < 2; ++pp) { const int p = F.wave * 2 + pp; float s = b1[F.lane];
#pragma unroll 11
                    for (int i = 0; i < 33; ++i) s += zs[p * 34 + i] * w1s[i * 64 + F.lane];
                    a1s[p * 64 + F.lane] = sinf(freq[F.lane] * s); }
                __syncthreads();
#pragma unroll
                for (int pp = 0; pp < 2; ++pp) { const int p = F.wave * 2 + pp; float s = b2[F.lane];
#pragma unroll 8
                    for (int i = 0; i < 64; ++i) s += a1s[p * 64 + i] * w2s[i * 64 + F.lane];
                    a2s[p * 64 + F.lane] = sinf(freq[64 + F.lane] * s); }
            }
            __syncthreads();
            float acc[16][4];
#pragma unroll
            for (int p = 0; p < 16; ++p)
#pragma unroll
                for (int j = 0; j < 4; ++j) acc[p][j] = 0.f;
            f32x4 nxtw[8];
#pragma unroll
            for (int k = 0; k < 8; ++k) nxtw[k] = *(const f32x4*)(w3 + 4 * (F.tid + 512 * k));
#pragma unroll 1
            for (int fc = 0; fc < 8; ++fc) {
                __syncthreads();
#pragma unroll
                for (int k = 0; k < 8; ++k) *(LAS f32x4*)(F.lds + 16 * (F.tid + 512 * k)) = nxtw[k];
                if (fc < 7) {
#pragma unroll
                    for (int k = 0; k < 8; ++k) nxtw[k] = *(const f32x4*)(w3 + (size_t)(8 * (fc + 1)) * 2048 + 4 * (F.tid + 512 * k)); }
                f32x4 xv[2][4]; const int xm = xn_m; const bool xdo = xm < T;
                if (xdo) { rms2_load(xv, in[0], xm, F.lane); xn_m += 2 * NGW; }
                __syncthreads();
#pragma unroll 2
                for (int f = 0; f < 8; ++f) {
                    float wv[4];
#pragma unroll
                    for (int j = 0; j < 4; ++j) wv[j] = *(const LAS float*)(F.lds + 4 * (f * 2048 + F.tid + 512 * j));
#pragma unroll
                    for (int p = 0; p < 16; ++p) { const float a = a2s[p * 64 + 8 * fc + f];
#pragma unroll
                        for (int j = 0; j < 4; ++j) acc[p][j] += a * wv[j]; }
                }
                if (xdo) rms2_finish(xv, (bf16_t*)(ws + WS_XN), (float*)(ws + WS_RMS0), xm, F.lane);
            }
            const float dlo = logf(1e-2f) / 1.5f, dhi = logf(1e-2f) / 0.3f;
#pragma unroll
            for (int j = 0; j < 4; ++j) {
                const int col = F.tid + 512 * j, o = col >> 10, dir = (col >> 9) & 1, c = col & 511;
                const float delta = fabsf(dlo + (float)c * ((dhi - dlo) / 511.0f));
                bf16_t* kf = KF + ((size_t)o * 512 + c) * 8192 + dir * 4096 + pb * 16;
#pragma unroll
                for (int hh = 0; hh < 2; ++hh) {
                    float v[8];
#pragma unroll
                    for (int p = 0; p < 8; ++p) { const int pos = pb * 16 + hh * 8 + p; v[p] = acc[hh * 8 + p][j] * expf(-((float)pos / (float)(SEQ - 1)) * delta); }
                    if (dir == 1 && pb == 0 && hh == 0) v[0] = acc[0][j - 1];
                    u32x4 w;
#pragma unroll
                    for (int p = 0; p < 4; ++p) w[p] = pk2(v[2 * p], v[2 * p + 1]);
                    *(u32x4*)(kf + hh * 8) = w;
                }
            }
        }
        __syncthreads();
    }
    TSI(20);
    {
        constexpr int I_IN = 32 * 18, I_Q = 32 * 4;
        constexpr int NITEMS_P0 = I_IN + 2 * I_Q;
        LAS unsigned char* scrb = F.lds + F.wave * 16384;
        for (int it = gw; it < NITEMS_P0; it += NGW) {
            int r = it;
            if (r < I_IN) { const int kb = r / 18, nb = r % 18; p0_transpose_item<false>(in[3], DIN, 32 * kb, 128 * nb, (bf16_t*)(ws + WS_WIN) + (size_t)(128 * nb) * 1024 + 32 * kb, 1024, in[2], scrb, F.lane); continue; } r -= I_IN;
            if (r < I_Q) { const int kb = r / 4, nb = r % 4; p0_transpose_item<false>(in[21], 512, 32 * kb, 128 * nb, (bf16_t*)(ws + WS_WKV) + (size_t)(128 * nb) * 1024 + 32 * kb, 1024, in[19], scrb, F.lane); continue; } r -= I_Q;
            if (r < I_Q) { const int kb = r / 4, nb = r % 4; p0_transpose_item<false>(in[22], 512, 32 * kb, 128 * nb, (bf16_t*)(ws + WS_WKV) + (size_t)(512 + 128 * nb) * 1024 + 32 * kb, 1024, in[19], scrb, F.lane); continue; } r -= I_Q;
        }
    }
    TSI(21);
    {
        float* WR = (float*)(ws + WS_WR);
        for (int i = (F.vcu * NWAVES * 64) + F.tid; i < 20 * 1024; i += F.G * NWAVES * 64) { const int j = i >> 10, k = i & 1023;
            WR[i] = (j < 4 ? in[27][k * 4 + j] : in[29][k * 16 + (j - 4)]) * in[26][k]; }
    }
    {
        float* rope = (float*)(ws + WS_ROPE);
        for (int i = (F.vcu * NWAVES * 64) + F.tid; i < 1024; i += F.G * NWAVES * 64) { const float ang = (float)(i >> 4) * powf(10000.0f, -(float)(i & 15) / 16.0f); rope[i] = cosf(ang); rope[1024 + i] = sinf(ang); }
    }
    for (int m = xn_m; m < T; m += 2 * NGW) rms_rows_to_bf16<2>(in[0], (bf16_t*)(ws + WS_XN), (float*)(ws + WS_RMS0), m, F.lane);
    for (int m = gw; m < NMEMT; m += NGW) rms_rows_to_bf16<1>(in[1], (bf16_t*)(ws + WS_MEMN), nullptr, m, F.lane);
}

struct P1Sched {
    int G, vcu; const char *win, *xn, *memn, *wkv;
    __device__ __forceinline__ bool next(int i, pg8::Unit& u) const {
        int L = i * G + vcu; constexpr size_t TILE = (size_t)256 * 1024 * 2;
        if (L < 768) { u.pm = L % 6; u.pn = L / 6; u.A = win + (size_t)u.pm * TILE; u.B = xn + (size_t)u.pn * TILE; u.aux = 0; }
        else if (L < 1152) { L -= 768; u.pn = L % 3; u.pm = L / 3; u.A = xn + (size_t)u.pm * TILE; u.B = win + (size_t)(6 + u.pn) * TILE; u.aux = 1; }
        else if (L < 1184) { L -= 1152; u.pn = L % 4; u.pm = L / 4; u.A = memn + (size_t)u.pm * TILE; u.B = wkv + (size_t)u.pn * TILE; u.aux = 2; }
        else return false;
        u.flags = 3; u.kt = 16; return true;
    }
};
__device__ __forceinline__ void store_tile_bf16(const f32x4 (&acc)[2][2][4][2], bf16_t* base, int ld, int row0, int col0) {
#pragma unroll
    for (int ai = 0; ai < 2; ++ai)
#pragma unroll
        for (int m = 0; m < 4; ++m) { bf16_t* rowp = base + (size_t)(row0 + ai * 128 + m * 16) * ld + col0;
#pragma unroll
            for (int bj = 0; bj < 2; ++bj) { const f32x4 v0 = acc[ai][bj][m][0], v1 = acc[ai][bj][m][1];
                u32x4 w; w.x = pg8::cvt_pk_bf16(v0[0], v0[1]); w.y = pg8::cvt_pk_bf16(v0[2], v0[3]); w.z = pg8::cvt_pk_bf16(v1[0], v1[1]); w.w = pg8::cvt_pk_bf16(v1[2], v1[3]);
                *(u32x4*)(rowp + bj * 128) = w; } }
}
struct EpiBf16Multi {
    unsigned char* ws;
    __device__ __forceinline__ void operator()(const f32x4 (&acc)[2][2][4][2], const pg8::Unit& u, int wr, int wc, int fr, int fq) const {
        const int row0 = u.pm * 256 + wr * 64 + fr, col0 = u.pn * 256 + wc * 32 + 8 * fq;
        if (u.aux == 0) store_tile_bf16(acc, (bf16_t*)(ws + WS_UHT), T, row0, col0);
        else if (u.aux == 1) store_tile_bf16(acc, (bf16_t*)(ws + WS_QKV), 768, row0, col0);
        else store_tile_bf16(acc, (bf16_t*)(ws + WS_KVM), 1024, row0, col0);
    }
};


__device__ __forceinline__ void kprep_tile(Frame& F, int pm) {
    bf16_t* QKV = (bf16_t*)(F.ws + WS_QKV); const float* rope = (const float*)(F.ws + WS_ROPE); const float* gk = F.in[14];
    const int row = pm * 256 + (F.tid >> 1), kh = F.tid & 1; const int t = row & (SEQ - 1);
    bf16_t* p = QKV + (size_t)row * 768 + 512 + kh * 64;
    u32x4 w[8]; float v[64]; float ss = 0.f;
#pragma unroll
    for (int k = 0; k < 8; ++k) w[k] = *(const u32x4*)(p + 8 * k);
#pragma unroll
    for (int k = 0; k < 8; ++k)
#pragma unroll
        for (int j = 0; j < 4; ++j) { v[8 * k + 2 * j] = bflo(w[k][j]); v[8 * k + 2 * j + 1] = bfhi(w[k][j]); ss += v[8 * k + 2 * j] * v[8 * k + 2 * j] + v[8 * k + 2 * j + 1] * v[8 * k + 2 * j + 1]; }
    const float rstd = 1.0f / sqrtf(ss * (1.0f / 64.0f) + EPSN);
#pragma unroll
    for (int d = 0; d < 64; ++d) v[d] *= rstd * gk[d];
#pragma unroll
    for (int sec = 0; sec < 2; ++sec) { const int pos = sec ? (t & 63) : (t >> 6);
#pragma unroll
        for (int i = 0; i < 16; ++i) { const float c = rope[pos * 16 + i], sn = rope[1024 + pos * 16 + i]; const float x1 = v[32 * sec + i], x2 = v[32 * sec + 16 + i];
            v[32 * sec + i] = x1 * c - x2 * sn; v[32 * sec + 16 + i] = x2 * c + x1 * sn; } }
#pragma unroll
    for (int k = 0; k < 8; ++k) { u32x4 o;
#pragma unroll
        for (int j = 0; j < 4; ++j) o[j] = pk2(v[8 * k + 2 * j], v[8 * k + 2 * j + 1]);
        *(u32x4*)(p + 8 * k) = o; }
}
__device__ __forceinline__ void kmem_norm_tile(Frame& F, int pm, int pn) {
    bf16_t* KVM = (bf16_t*)(F.ws + WS_KVM); const float* g = F.in[24];
    const int row = pm * 256 + (F.tid >> 1), hh = F.tid & 1;
    bf16_t* p = KVM + (size_t)row * 1024 + pn * 256 + hh * 128;
    u32x4 w[16]; float ss = 0.f;
#pragma unroll
    for (int k = 0; k < 16; ++k) w[k] = *(const u32x4*)(p + 8 * k);
#pragma unroll
    for (int k = 0; k < 16; ++k)
#pragma unroll
        for (int j = 0; j < 4; ++j) { const float a = bflo(w[k][j]), b2 = bfhi(w[k][j]); ss += a * a + b2 * b2; }
    const float rstd = 1.0f / sqrtf(ss * (1.0f / 128.0f) + EPSN);
#pragma unroll
    for (int k = 0; k < 16; ++k) { u32x4 o;
#pragma unroll
        for (int j = 0; j < 4; ++j) o[j] = pk2(bflo(w[k][j]) * rstd * g[8 * k + 2 * j], bfhi(w[k][j]) * rstd * g[8 * k + 2 * j + 1]);
        *(u32x4*)(p + 8 * k) = o; }
}

namespace at {
constexpr int D = 64, PQ = 768, PO = 1024;
constexpr int NW = 8, QBLK = 32, QB = QBLK * NW, KVBLK = 64;
__device__ __forceinline__ int crow(int r, int hi) { return (r & 3) + 8 * (r >> 2) + 4 * hi; }
#define SBAR() __builtin_amdgcn_sched_barrier(0)
constexpr int NSLOT = 3, SLOTB = 8192;
constexpr int LDS_K = 0, LDS_V = NSLOT * SLOTB, LDS_WS = 2 * NSLOT * SLOTB, LDS_OST = LDS_WS + NW * 64 * 4, LDS_BYTES_AT = LDS_OST + NW * 4096;
constexpr float C2 = 0.125f * 1.4426950408889634f;
__device__ __forceinline__ void glds16(const void* gsrc, unsigned lds_dst) { unsigned keep;
    asm volatile("s_mov_b32 %0, m0\n\ts_mov_b32 m0, %2\n\ts_nop 0\n\tglobal_load_lds_dwordx4 %1, off\n\ts_mov_b32 m0, %0" : "=&s"(keep) : "v"(gsrc), "s"(lds_dst) : "memory"); }
__device__ __forceinline__ float max3f(float a, float b, float c) { float r; asm("v_max3_f32 %0, %1, %2, %3" : "=v"(r) : "v"(a), "v"(b), "v"(c)); return r; }
__device__ __forceinline__ float max2f(float a, float b) { float r; asm("v_max_f32_e32 %0, %1, %2" : "=v"(r) : "v"(a), "v"(b)); return r; }
__device__ __forceinline__ float fadd_s(float a, float b) { float r; asm("v_add_f32_e32 %0, %1, %2" : "=v"(r) : "v"(a), "v"(b)); return r; }
__device__ __forceinline__ float fsub_s(float a, float b) { float r; asm("v_sub_f32_e32 %0, %1, %2" : "=v"(r) : "v"(a), "v"(b)); return r; }
typedef __bf16 bf16x2_t __attribute__((ext_vector_type(2)));
__device__ __forceinline__ unsigned cvtpk_s(float lo, float hi) { f32x2 v = {lo, hi}; bf16x2_t b = __builtin_convertvector(v, bf16x2_t); return __builtin_bit_cast(unsigned, b); }
#define WAIT_BAR(N) asm volatile("s_waitcnt vmcnt(" #N ") lgkmcnt(0)\n\ts_barrier" ::: "memory")
__device__ __forceinline__ void qkt(f32x16& p0, f32x16& p1, const char* Kslot, const bf16x8* qr, const f32x16& negm, int r32, int hi) {
    const char* kb = Kslot + hi * 1024 + r32 * 16;
#pragma unroll
    for (int d0 = 0; d0 < 4; ++d0) {
        const bf16x8 b0 = *reinterpret_cast<const bf16x8*>(kb + d0 * 2048);
        const bf16x8 b1 = *reinterpret_cast<const bf16x8*>(kb + d0 * 2048 + 512);
        if (d0 == 0) { p0 = __builtin_amdgcn_mfma_f32_32x32x16_bf16(b0, qr[0], negm, 0, 0, 0); p1 = __builtin_amdgcn_mfma_f32_32x32x16_bf16(b1, qr[0], negm, 0, 0, 0); }
        else { p0 = __builtin_amdgcn_mfma_f32_32x32x16_bf16(b0, qr[d0], p0, 0, 0, 0); p1 = __builtin_amdgcn_mfma_f32_32x32x16_bf16(b1, qr[d0], p1, 0, 0, 0); } }
}
typedef LAS const char* lds_cptr;
typedef short v4i16_t __attribute__((ext_vector_type(4)));
__device__ __forceinline__ void kload8(bf16x8* kf, lds_cptr kp) {
    kf[0] = *(const LAS bf16x8*)(kp);        kf[1] = *(const LAS bf16x8*)(kp + 512);
    kf[2] = *(const LAS bf16x8*)(kp + 2048); kf[3] = *(const LAS bf16x8*)(kp + 2560);
    kf[4] = *(const LAS bf16x8*)(kp + 4096); kf[5] = *(const LAS bf16x8*)(kp + 4608);
    kf[6] = *(const LAS bf16x8*)(kp + 6144); kf[7] = *(const LAS bf16x8*)(kp + 6656);
}
__device__ __forceinline__ void kload2(bf16x8* kf, lds_cptr kp, int j) { kf[2 * j] = *(const LAS bf16x8*)(kp + j * 2048); kf[2 * j + 1] = *(const LAS bf16x8*)(kp + j * 2048 + 512); }
__device__ __forceinline__ s16x4 vtr(lds_cptr p) { return __builtin_bit_cast(s16x4, __builtin_amdgcn_ds_read_tr16_b64_v4i16((LAS v4i16_t*)p)); }
__device__ __forceinline__ float rowmax(const f32x16& p0, const f32x16& p1) {
    float a = max3f(p0[0], p0[1], p1[0]), b = max3f(p0[2], p0[3], p1[1]); a = max3f(a, p1[2], p1[3]);
#pragma unroll
    for (int r = 4; r < 16; r += 4) { a = max3f(a, p0[r], p0[r + 1]); b = max3f(b, p0[r + 2], p0[r + 3]); a = max3f(a, p1[r], p1[r + 1]); b = max3f(b, p1[r + 2], p1[r + 3]); }
    const float m = max2f(a, b);
    auto rr = __builtin_amdgcn_permlane32_swap(__float_as_uint(m), __float_as_uint(m), false, false);
    return max2f(__uint_as_float(rr[0]), __uint_as_float(rr[1]));
}
__device__ __forceinline__ void pv(f32x16* o, int vb, bf16x8 pa0, bf16x8 pa1, bf16x8 pa2, bf16x8 pa3) {
#pragma unroll
    for (int d0 = 0; d0 < 2; ++d0) { s16x4 lo[4], hi[4];
#pragma unroll
        for (int ks = 0; ks < 4; ++ks) {
            asm volatile("ds_read_b64_tr_b16 %0,%1 offset:%c2" : "=&v"(lo[ks]) : "v"(vb), "i"(d0 * 4096 + ks * 1024) : "memory");
            asm volatile("ds_read_b64_tr_b16 %0,%1 offset:%c2" : "=&v"(hi[ks]) : "v"(vb), "i"(d0 * 4096 + ks * 1024 + 512) : "memory"); }
        asm volatile("s_waitcnt lgkmcnt(0)" ::: "memory"); SBAR();
#define PK(k) (bf16x8){lo[k][0], lo[k][1], lo[k][2], lo[k][3], hi[k][0], hi[k][1], hi[k][2], hi[k][3]}
        o[d0] = __builtin_amdgcn_mfma_f32_32x32x16_bf16(pa0, PK(0), o[d0], 0, 0, 0);
        o[d0] = __builtin_amdgcn_mfma_f32_32x32x16_bf16(pa1, PK(1), o[d0], 0, 0, 0);
        o[d0] = __builtin_amdgcn_mfma_f32_32x32x16_bf16(pa2, PK(2), o[d0], 0, 0, 0);
        o[d0] = __builtin_amdgcn_mfma_f32_32x32x16_bf16(pa3, PK(3), o[d0], 0, 0, 0);
#undef PK
    }
}
template <int THRL> __device__ __forceinline__ void attn_unit(int b, int h, int qb, const bf16_t* QKV, bf16_t* Y, const float* gq, const float* gk, const float* rope, char* shm) {
    const int tid = threadIdx.x, lane = tid & 63, r32 = lane & 31, hi = lane >> 5; const int wid = __builtin_amdgcn_readfirstlane(tid >> 6);
    const long rowbase = (long)b * SEQ; const int q0 = qb * QB; const int kvh = h >> 2;
    const bf16_t* Qw = QKV + (rowbase + q0 + wid * QBLK) * PQ + h * D;
    const bf16_t* Kh = QKV + rowbase * PQ + 512 + kvh * D; const bf16_t* Vh = QKV + rowbase * PQ + 640 + kvh * D;
    const unsigned lds0 = (unsigned)(uintptr_t)shm;
    float* wsf = (float*)(shm + LDS_WS) + wid * 64;
    const bf16_t* ksrc = Kh + (long)lane * PQ + wid * 8;
    const bf16_t* vsrc = Vh + (long)(16 * (wid & 3) + (lane >> 2)) * PQ + (wid >> 2) * 32 + (lane & 3) * 8;
    const unsigned kdst = lds0 + LDS_K + wid * 1024, vdst = lds0 + LDS_V + wid * 1024;
#define DMA_K(t, slot) glds16(ksrc + (long)(t) * KVBLK * PQ, (unsigned)__builtin_amdgcn_readfirstlane(kdst + (slot)))
#define DMA_V(t, slot) glds16(vsrc + (long)(t) * KVBLK * PQ, (unsigned)__builtin_amdgcn_readfirstlane(vdst + (slot)))
    const int vb0 = (int)(lds0 + LDS_V) + ((lane >> 4) & 1) * 32 + (lane & 3) * 8 + (4 * hi + ((lane & 15) >> 2)) * 64;
    const char* Kbase = shm + LDS_K; bf16x8 kf[8];
    const lds_cptr shm3 = (lds_cptr)shm; const lds_cptr kp0 = shm3 + LDS_K + hi * 1024 + r32 * 16; const lds_cptr vp0 = shm3 + LDS_V + ((lane >> 4) & 1) * 32 + (lane & 3) * 8 + (4 * hi + ((lane & 15) >> 2)) * 64;
    constexpr int NT = SEQ / KVBLK;
    DMA_K(0, 0); DMA_V(0, 0); DMA_K(1, SLOTB);
    bf16x8 qr[4];
    {
        float qf[4][8]; float ss = 0.f;
#pragma unroll
        for (int d0 = 0; d0 < 4; ++d0) { const u32x4 w = *reinterpret_cast<const u32x4*>(&Qw[(long)r32 * PQ + d0 * 16 + hi * 8]);
#pragma unroll
            for (int j = 0; j < 4; ++j) { qf[d0][2 * j] = bflo(w[j]); qf[d0][2 * j + 1] = bfhi(w[j]); }
#pragma unroll
            for (int j = 0; j < 8; ++j) ss += qf[d0][j] * qf[d0][j]; }
        ss += __shfl_xor(ss, 32);
        const float rstd = C2 / sqrtf(ss * (1.0f / 64.0f) + EPSN);
#pragma unroll
        for (int d0 = 0; d0 < 4; ++d0) { const f32x4 g0 = *(const f32x4*)(gq + d0 * 16 + hi * 8), g1 = *(const f32x4*)(gq + d0 * 16 + hi * 8 + 4);
#pragma unroll
            for (int j = 0; j < 4; ++j) { qf[d0][j] *= rstd * g0[j]; qf[d0][4 + j] *= rstd * g1[j]; } }
        const int tq = q0 + wid * QBLK + r32;
#pragma unroll
        for (int sec = 0; sec < 2; ++sec) { const int pos = sec ? (tq & 63) : (tq >> 6);
            const f32x4 c0 = *(const f32x4*)(rope + pos * 16 + hi * 8), c1 = *(const f32x4*)(rope + pos * 16 + hi * 8 + 4);
            const f32x4 s0 = *(const f32x4*)(rope + 1024 + pos * 16 + hi * 8), s1 = *(const f32x4*)(rope + 1024 + pos * 16 + hi * 8 + 4);
#pragma unroll
            for (int j = 0; j < 8; ++j) { const float c = j < 4 ? c0[j & 3] : c1[j & 3], sn = j < 4 ? s0[j & 3] : s1[j & 3];
                const float x1 = qf[2 * sec][j], x2 = qf[2 * sec + 1][j];
                qf[2 * sec][j] = x1 * c - x2 * sn; qf[2 * sec + 1][j] = x2 * c + x1 * sn; } }
#pragma unroll
        for (int d0 = 0; d0 < 4; ++d0) { u32x4 w;
#pragma unroll
            for (int j = 0; j < 4; ++j) w[j] = cvtpk_s(qf[d0][2 * j], qf[d0][2 * j + 1]);
            qr[d0] = __builtin_bit_cast(bf16x8, w); }
    }
    float l_reg = 0.f; f32x16 o[2]; o[0] = f32x16{}; o[1] = f32x16{}; const f32x16 negm = f32x16{};

#define START(P0, P1) do { _Pragma("unroll") for (int r = 0; r < 16; ++r) P0[r] = __builtin_amdgcn_exp2f(P0[r]); } while (0)
#define RESC() do {} while (0)
    f32x16 pA0, pA1, pB0, pB1;
    int sl_prev = 0, sl_cur = 0, sl_next = SLOTB;
#define ROT() do { sl_prev = sl_cur; sl_cur = sl_next; sl_next = (sl_next == (NSLOT - 1) * SLOTB) ? 0 : sl_next + SLOTB; } while (0)
    DMA_K(2, 2 * SLOTB);
    WAIT_BAR(3);
    qkt(pA0, pA1, Kbase, qr, negm, r32, hi); asm volatile("s_nop 15\n\ts_nop 7" : "+v"(pA0), "+v"(pA1));
    START(pA0, pA1);
    _Pragma("unroll") for (int r = 0; r < 16; ++r) pA1[r] = __builtin_amdgcn_exp2f(pA1[r]);
    WAIT_BAR(0);
    DMA_K(3, 0); DMA_V(1, SLOTB);
    ROT();
    kload8(kf, kp0 + sl_cur);
    WAIT_BAR(2);
    s16x4 vlo[8], vhi[8]; u32x4 pw0, pw1, pw2, pw3;
#define PKW(P, B) cvtpk_s(P[B], P[B + 1])
#define PAF(k) __builtin_bit_cast(bf16x8, pw##k)
#define VFR(i) (bf16x8){vlo[i][0], vlo[i][1], vlo[i][2], vlo[i][3], vhi[i][0], vhi[i][1], vhi[i][2], vhi[i][3]}
#define PIN(x) asm volatile("" : "+v"(x))
#define MX3(a, b, c) __builtin_fmaxf(__builtin_fmaxf((a), (b)), (c))
#define GAPA(MF, A0, A1, A2, A3, W0, W1, PW) do { MF; sacc += A0; sacc += A1; sacc += A2; sacc += A3; PIN(sacc); W0; W1; PIN(PW); SBAR(); } while (0)
#define EX(v) __builtin_amdgcn_exp2f(v)
#define GAPB(MF, X, B) do { MF; X[B] = EX(X[B]); X[B + 1] = EX(X[B + 1]); X[B + 2] = EX(X[B + 2]); X[B + 3] = EX(X[B + 3]); PIN(X); SBAR(); } while (0)
#define VRD(i) do { vlo[i] = vtr(vp_ + (((i) >> 2) * 4096 + ((i) & 3) * 1024)); vhi[i] = vtr(vp_ + (((i) >> 2) * 4096 + ((i) & 3) * 1024 + 512)); } while (0)
#define KRD(G, j) do { if (G) { kload2(kf, kp0 + sl_next, j); SBAR(); } } while (0)
#define STEP(C0, C1, P0, P1, t, GK, GV, GL) do { SBAR(); \
    const lds_cptr vp_ = vp0 + sl_prev; \
    VRD(0); SBAR(); float sacc = (P0[0] + P0[1]); \
    GAPA(C0 = __builtin_amdgcn_mfma_f32_32x32x16_bf16(kf[0], qr[0], negm, 0, 0, 0), P0[2], P0[3], P0[4], P0[5],     pw0[0] = PKW(P0, 0), pw0[1] = PKW(P0, 2), pw0); \
    VRD(4); SBAR(); GAPA(C1 = __builtin_amdgcn_mfma_f32_32x32x16_bf16(kf[1], qr[0], negm, 0, 0, 0), P0[6], P0[7], P0[8], P0[9],     pw0[2] = PKW(P0, 4), pw0[3] = PKW(P0, 6), pw0); \
    VRD(1); SBAR(); GAPA(C0 = __builtin_amdgcn_mfma_f32_32x32x16_bf16(kf[2], qr[1], C0, 0, 0, 0),   P0[10], P0[11], P0[12], P0[13], pw1[0] = PKW(P0, 8), pw1[1] = PKW(P0, 10), pw1); \
    VRD(5); SBAR(); GAPA(C1 = __builtin_amdgcn_mfma_f32_32x32x16_bf16(kf[3], qr[1], C1, 0, 0, 0),   P0[14], P0[15], P1[0], P1[1],   pw1[2] = PKW(P0, 12), pw1[3] = PKW(P0, 14), pw1); \
    VRD(2); SBAR(); GAPA(C0 = __builtin_amdgcn_mfma_f32_32x32x16_bf16(kf[4], qr[2], C0, 0, 0, 0),   P1[2], P1[3], P1[4], P1[5],     pw2[0] = PKW(P1, 0), pw2[1] = PKW(P1, 2), pw2); \
    VRD(6); SBAR(); GAPA(C1 = __builtin_amdgcn_mfma_f32_32x32x16_bf16(kf[5], qr[2], C1, 0, 0, 0),   P1[6], P1[7], P1[8], P1[9],     pw2[2] = PKW(P1, 4), pw2[3] = PKW(P1, 6), pw2); \
    VRD(3); SBAR(); GAPA(C0 = __builtin_amdgcn_mfma_f32_32x32x16_bf16(kf[6], qr[3], C0, 0, 0, 0),   P1[10], P1[11], P1[12], P1[13], pw3[0] = PKW(P1, 8), pw3[1] = PKW(P1, 10), pw3); \
    VRD(7); SBAR(); GAPA(C1 = __builtin_amdgcn_mfma_f32_32x32x16_bf16(kf[7], qr[3], C1, 0, 0, 0),   P1[14], P1[15], 0.f, 0.f,       pw3[2] = PKW(P1, 12), pw3[3] = PKW(P1, 14), pw3); \
    l_reg += sacc; \
    if (GK) { DMA_K((t) + 3, sl_cur); } if (GV) { DMA_V((t) + 1, sl_next); } \
    SBAR(); \
    GAPB(o[0] = __builtin_amdgcn_mfma_f32_32x32x16_bf16(PAF(0), VFR(0), o[0], 0, 0, 0), C0, 0); \
    GAPB(o[1] = __builtin_amdgcn_mfma_f32_32x32x16_bf16(PAF(0), VFR(4), o[1], 0, 0, 0), C0, 4); \
    KRD(GL, 0); GAPB(o[0] = __builtin_amdgcn_mfma_f32_32x32x16_bf16(PAF(1), VFR(1), o[0], 0, 0, 0), C0, 8); \
    KRD(GL, 1); GAPB(o[1] = __builtin_amdgcn_mfma_f32_32x32x16_bf16(PAF(1), VFR(5), o[1], 0, 0, 0), C0, 12); \
    KRD(GL, 2); GAPB(o[0] = __builtin_amdgcn_mfma_f32_32x32x16_bf16(PAF(2), VFR(2), o[0], 0, 0, 0), C1, 0); \
    KRD(GL, 3); GAPB(o[1] = __builtin_amdgcn_mfma_f32_32x32x16_bf16(PAF(2), VFR(6), o[1], 0, 0, 0), C1, 4); \
    GAPB(o[0] = __builtin_amdgcn_mfma_f32_32x32x16_bf16(PAF(3), VFR(3), o[0], 0, 0, 0), C1, 8); \
    GAPB(o[1] = __builtin_amdgcn_mfma_f32_32x32x16_bf16(PAF(3), VFR(7), o[1], 0, 0, 0), C1, 12); \
    } while (0)
    int t = 1;
    for (; t + 5 < NT; t += 2) {
        STEP(pB0, pB1, pA0, pA1, t, true, true, true);     WAIT_BAR(2); RESC(); ROT();
        STEP(pA0, pA1, pB0, pB1, t + 1, true, true, true); WAIT_BAR(2); RESC(); ROT();
    }
#define ENDW(tt) do { if ((tt) + 3 < NT) { WAIT_BAR(2); } else if ((tt) + 2 < NT) { WAIT_BAR(1); } else { WAIT_BAR(0); } } while (0)
    for (; t + 1 < NT; t += 2) {
        STEP(pB0, pB1, pA0, pA1, t, (t + 3 < NT), (t + 1 < NT), (t + 1 < NT));         ENDW(t);     RESC(); ROT();
        STEP(pA0, pA1, pB0, pB1, t + 1, (t + 4 < NT), (t + 2 < NT), (t + 2 < NT));     ENDW(t + 1); RESC(); ROT();
    }
    STEP(pB0, pB1, pA0, pA1, NT - 1, false, false, false); RESC();
    { float sacc = pB0[0] + pB0[1]; _Pragma("unroll") for (int r = 2; r < 16; ++r) sacc += pB0[r]; _Pragma("unroll") for (int r = 0; r < 16; ++r) sacc += pB1[r]; l_reg += sacc;
      pw0 = (u32x4){PKW(pB0, 0), PKW(pB0, 2), PKW(pB0, 4), PKW(pB0, 6)}; pw1 = (u32x4){PKW(pB0, 8), PKW(pB0, 10), PKW(pB0, 12), PKW(pB0, 14)}; pw2 = (u32x4){PKW(pB1, 0), PKW(pB1, 2), PKW(pB1, 4), PKW(pB1, 6)}; pw3 = (u32x4){PKW(pB1, 8), PKW(pB1, 10), PKW(pB1, 12), PKW(pB1, 14)};
      SBAR(); pv(o, vb0 + sl_cur, PAF(0), PAF(1), PAF(2), PAF(3)); }
#undef PKW
#undef PAF
#undef VFR
#undef PIN
#undef MX3
#undef GAPA
#undef GAPB
#undef EX
#undef VRD
#undef KRD
#undef STEP
#undef ENDW
    { auto rr = __builtin_amdgcn_permlane32_swap(__float_as_uint(l_reg), __float_as_uint(l_reg), false, false); l_reg = __uint_as_float(rr[0]) + __uint_as_float(rr[1]); }
    if (hi == 0) wsf[32 + r32] = l_reg; asm volatile("s_waitcnt lgkmcnt(0)" ::: "memory");
    float rli[16];
#pragma unroll
    for (int r = 0; r < 16; ++r) rli[r] = __builtin_amdgcn_rcpf(wsf[32 + crow(r, hi)]);
    bf16_t* Ow = Y + (rowbase + q0 + wid * QBLK) * PO + 512 + h * D;
    { bf16_t* stg = (bf16_t*)(shm + LDS_OST) + wid * 2048;
#pragma unroll
      for (int r = 0; r < 16; ++r) { const int orow = crow(r, hi);
#pragma unroll
        for (int d0 = 0; d0 < 2; ++d0) stg[orow * 64 + d0 * 32 + r32] = (bf16_t)f2bf(o[d0][r] * rli[r]); }
      asm volatile("s_waitcnt lgkmcnt(0)" ::: "memory");
#pragma unroll
      for (int i = 0; i < 4; ++i) { const int row = i * 8 + (lane >> 3), ch = lane & 7; const u32x4 v = *(const u32x4*)(stg + row * 64 + ch * 8);
        float f[8]; float ss = 0.f;
#pragma unroll
        for (int j = 0; j < 4; ++j) { f[2 * j] = bflo(v[j]); f[2 * j + 1] = bfhi(v[j]); ss += f[2 * j] * f[2 * j] + f[2 * j + 1] * f[2 * j + 1]; }
        ss += __shfl_xor(ss, 1); ss += __shfl_xor(ss, 2); ss += __shfl_xor(ss, 4);
        const float rs = 1.0f / sqrtf(ss * (1.0f / 64.0f) + EPSN);
        u32x4 w;
#pragma unroll
        for (int j = 0; j < 4; ++j) w[j] = pk2(f[2 * j] * rs, f[2 * j + 1] * rs);
        *(u32x4*)(Ow + (long)row * PO + ch * 8) = w; } }
    asm volatile("s_waitcnt lgkmcnt(0)\n\ts_barrier" ::: "memory");
#undef DMA_K
#undef DMA_V
#undef START
#undef RESC
#undef ROT
}
#undef SBAR
#undef WAIT_BAR
}

namespace bgtr {
constexpr int NMOE = 16 * 3 * 1024, NIT = NMOE + 2048 + 1024 + 1024;
constexpr int SCR = 115200, SCRW = 2304;
struct State { int it, pend; };
struct Desc { const float* W; const float* gain; bf16_t* dst; int N, k0, n0, ldk; };
__device__ __forceinline__ Desc desc(int it, const float* const* in, unsigned char* ws) {
    Desc d; d.ldk = 1024;
    if (it < NMOE) { const int e = it / 3072, r = it % 3072, mat = r >> 10, q = r & 1023;
        if (mat < 2) { const int kb = q >> 4, nb = q & 15; d.k0 = 16 * kb; d.n0 = 32 * nb; d.N = 512; d.W = in[mat ? 32 : 31] + (size_t)e * 1024 * 512; d.gain = in[26];
            d.dst = (bf16_t*)(ws + WS_WGU) + ((size_t)e * 1024 + 256 * (d.n0 >> 7) + (d.n0 & 127) + 128 * mat) * 1024 + d.k0; }
        else { const int kb = q >> 5, nb = q & 31; d.k0 = 16 * kb; d.n0 = 32 * nb; d.N = 1024; d.W = in[33] + (size_t)e * 512 * 1024; d.gain = nullptr;
            d.dst = (bf16_t*)(ws + WS_WD) + ((size_t)e * 1024 + d.n0) * 1024 + d.k0; } }
    else { int r = it - NMOE;
        if (r < 2048) { const int kb = r >> 5, nb = r & 31; d.k0 = 16 * kb; d.n0 = 32 * nb; d.N = 1024; d.W = in[17]; d.gain = (kb < 32) ? in[15] : in[16] - 512;
            d.dst = (bf16_t*)(ws + WS_WOUT) + (size_t)d.n0 * 1024 + d.k0; }
        else if (r < 3072) { r -= 2048; const int kb = r >> 4, nb = r & 15; d.k0 = 16 * kb; d.n0 = 32 * nb; d.N = 512; d.W = in[20]; d.gain = in[18];
            d.dst = (bf16_t*)(ws + WS_WQM) + (size_t)d.n0 * 1024 + d.k0; }
        else { r -= 3072; const int kb = r >> 5, nb = r & 31; d.k0 = 16 * kb; d.n0 = 32 * nb; d.N = 1024; d.W = in[25]; d.gain = nullptr; d.ldk = 512;
            d.dst = (bf16_t*)(ws + WS_WOM) + (size_t)d.n0 * 512 + d.k0; } }
    return d;
}
__device__ __forceinline__ void glds16(const void* gsrc, unsigned lds_dst) { unsigned keep;
    asm volatile("s_mov_b32 %0, m0\n\ts_mov_b32 m0, %2\n\ts_nop 0\n\tglobal_load_lds_dwordx4 %1, off\n\ts_mov_b32 m0, %0" : "=&s"(keep) : "v"(gsrc), "s"(lds_dst) : "memory"); }
__device__ __forceinline__ void step(State& S, int stride, const float* const* in, unsigned char* ws, LAS unsigned char* lds, unsigned tile, int lane) {
    asm volatile("" : "+v"(lane));
    if (S.pend) { const Desc d = desc(S.it, in, ws); const int n = lane & 31, kh = lane >> 5;
        asm volatile("s_waitcnt vmcnt(0)" ::: "memory");
        u32x4 o;
#pragma unroll
        for (int h = 0; h < 2; ++h) { float x[4];
#pragma unroll
            for (int j = 0; j < 4; ++j) x[j] = *(const LAS float*)(lds + tile + kh * 1152 + (4 * h + j) * 128 + 4 * n);
            if (d.gain) { const f32x4 g0 = *(const f32x4*)(d.gain + d.k0 + 8 * kh + 4 * h);
#pragma unroll
                for (int j = 0; j < 4; ++j) x[j] *= g0[j]; }
            o[2 * h] = pk2(x[0], x[1]); o[2 * h + 1] = pk2(x[2], x[3]); }
        *(GAS u32x4*)(d.dst + (size_t)n * d.ldk + 8 * kh) = o;
        S.it += stride; }
    if (S.it < NIT) { const Desc d = desc(S.it, in, ws);
        const float* g = d.W + (size_t)(d.k0 + (lane >> 3)) * d.N + d.n0 + 4 * (lane & 7);
        asm volatile("s_waitcnt lgkmcnt(0)" ::: "memory");
        glds16(g, tile); glds16(g + (size_t)8 * d.N, tile + 1152u);
        S.pend = 1; }
    else S.pend = 0;
}
}

namespace hy {
constexpr int PADT = 512, ZT = SEQ + 2 * PADT, SB = ZT * 2 + 32;
constexpr int LZ = 0, LF0 = 8 * SB, LF1 = LF0 + 16384 + 68, LRED = LF1 + 16384 + 12, LEND = LRED + 64;
static_assert(LEND <= bgtr::SCR && bgtr::SCR + 8 * bgtr::SCRW <= MISC_OFF, "hyena + background-transposer LDS map");
static_assert(LF0 % 16 == 0 && LEND <= RING_BYTES, "hyena LDS map");
__device__ __forceinline__ int crow(int r, int hi) { return (r & 3) + 8 * (r >> 2) + 4 * hi; }
__device__ __forceinline__ void hyena_unit(int c, const bf16_t* UHT, bf16_t* ZS, bf16_t* YHT, const bf16_t* KF, const float* FN, const float* sw, const float* sbias, const float* skip, LAS unsigned char* lds,
                                           bgtr::State& BG, int bgstride, const float* const* in, unsigned char* ws) {
    int tid_ = threadIdx.x; asm volatile("" : "+v"(tid_));
    const int tid = tid_, lane = tid & 63, wid = __builtin_amdgcn_readfirstlane(tid >> 6);
    const int r32 = lane & 31, hi = lane >> 5;
    __syncthreads();
    if (tid < 17) *(LAS unsigned*)(lds + LF0 + 16384 + 4 * tid) = 0u;
    for (int i = tid; i < 8 * 2 * (PADT / 8); i += 512) { const int b = i / (2 * (PADT / 8)), rem = i % (2 * (PADT / 8)); const int side = rem / (PADT / 8), k = rem % (PADT / 8);
        unsigned z0 = 0u; asm volatile("" : "+v"(z0)); *(LAS u32x4*)(lds + LZ + b * SB + 2 * (side * (PADT + SEQ) + 8 * k)) = (u32x4){z0, z0, z0, z0}; }
#pragma unroll 1
    for (int ord = 0; ord < 2; ++ord) {
        {
            const bf16_t* kfp = KF + ((size_t)ord * 512 + c) * 8192; float as = 0.f;
            const u32x4 wf = *(const u32x4*)(kfp + 8 * tid), wb = *(const u32x4*)(kfp + 4096 + 8 * tid);
            *(LAS u32x4*)(lds + LF0 + 2 * (4096 + 8 * tid)) = wb;
#pragma unroll
            for (int j = 0; j < 4; ++j) { const int m = 4096 - 8 * tid - 2 * j;
                if (tid + j > 0) *(LAS bf16_t*)(lds + LF0 + 2 * m) = (bf16_t)(wf[j] & 0xffffu);
                *(LAS bf16_t*)(lds + LF0 + 2 * (m - 1)) = (bf16_t)(wf[j] >> 16);
                as += fabsf(bflo(wf[j])) + fabsf(bfhi(wf[j])) + fabsf(bflo(wb[j])) + fabsf(bfhi(wb[j])); }
            if (tid == 0) { *(LAS bf16_t*)(lds + LF0) = 0; as -= fabsf(bflo(wb[0])); }
            as = wsum_sw(as); if (lane == 0) *(LAS float*)(lds + LRED + 4 * wid) = as; }
        { const int cc = ord * 512 + c; const float w0 = sw[cc], w1 = sw[1536 + cc], w2 = sw[3072 + cc], bb = sbias[cc];
          const bf16_t* u = UHT + (size_t)cc * T; const bf16_t* zs = ZS + (size_t)c * T;
#pragma unroll 1
          for (int kh = 0; kh < 2; ++kh) {
            u32x4 wv[4], zv[4]; float pv_[4], nx_[4];
#pragma unroll
            for (int kk = 0; kk < 4; ++kk) { const int id = tid + 512 * (4 * kh + kk), b = id >> 9, t8 = (id & 511) * 8; const size_t g = (size_t)b * SEQ + t8;
                wv[kk] = *(const u32x4*)(u + g); pv_[kk] = t8 > 0 ? bf2f(u[g - 1]) : 0.f; nx_[kk] = t8 + 8 < SEQ ? bf2f(u[g + 8]) : 0.f;
                if (ord == 1) zv[kk] = *(const u32x4*)(zs + g); }
#pragma unroll
            for (int kk = 0; kk < 4; ++kk) { const int id = tid + 512 * (4 * kh + kk), b = id >> 9, t8 = (id & 511) * 8;
                const u32x4 w = wv[kk];
                float x[10]; x[0] = pv_[kk]; x[9] = nx_[kk];
#pragma unroll
                for (int j = 0; j < 4; ++j) { x[1 + 2 * j] = bflo(w[j]); x[2 + 2 * j] = bfhi(w[j]); }
                float y[8];
#pragma unroll
                for (int j = 0; j < 8; ++j) y[j] = w0 * x[j] + w1 * x[j + 1] + w2 * x[j + 2] + bb;
                if (ord == 1) { const u32x4 zw = zv[kk];
#pragma unroll
                    for (int j = 0; j < 4; ++j) { y[2 * j] *= bflo(zw[j]); y[2 * j + 1] *= bfhi(zw[j]); } }
                u32x4 ow;
#pragma unroll
                for (int j = 0; j < 4; ++j) ow[j] = pk2(y[2 * j], y[2 * j + 1]);
                *(LAS u32x4*)(lds + LZ + b * SB + 2 * (PADT + t8)) = ow; } } }
        __syncthreads();
#pragma unroll 2
        for (int k = 0; k < 8; ++k) { const int i = tid + 512 * k; const unsigned lo = *(const LAS unsigned*)(lds + LF0 + 4 * i), hi2 = (i < 4095) ? *(const LAS unsigned*)(lds + LF0 + 4 * i + 4) : 0u;
            *(LAS unsigned*)(lds + LF1 + 4 * i) = (lo >> 16) | (hi2 << 16); }
        __syncthreads();
        int ln_ = lane; asm volatile("" : "+v"(ln_));
        const unsigned bgtile = (unsigned)__builtin_amdgcn_readfirstlane(bgtr::SCR + wid * bgtr::SCRW);
        const int r16 = ln_ & 15, g4 = ln_ >> 4;
        const int bcol = ((r16 >> 2) & 1) | (((r16 >> 3) & 1) << 1) | (((r16 >> 1) & 1) << 2), pcol = r16 & 1;
        const int Dlo = 16 * wid - 127;
        f32x4 acc[8][2];
#pragma unroll
        for (int u = 0; u < 8; ++u) { acc[u][0] = (f32x4){0.f, 0.f, 0.f, 0.f}; acc[u][1] = (f32x4){0.f, 0.f, 0.f, 0.f}; }
        const int m0 = 4096 - 32 * Dlo - r16 + 8 * g4;
        const unsigned a0 = (r16 & 1) ? (unsigned)(LF1 + 2 * (m0 - 1)) : (unsigned)(LF0 + 2 * m0);
        const unsigned b0 = (unsigned)(LZ + bcol * SB + 2 * (PADT + 32 * (pcol + 127) + 8 * g4)) - 384u;
#define H16_LDA(A_, d_, a_) do { const unsigned ab_ = a0 - 416u - 64u * (unsigned)(d_); _Pragma("unroll") for (int j = 0; j < 4; ++j) { u32x4 t_; _Pragma("unroll") for (int e = 0; e < 4; ++e) t_[e] = *(const LAS unsigned*)(lds + ab_ + (128 * (3 - j) + 32 * (1 - (a_)) + 4 * e)); A_[j] = __builtin_bit_cast(bf16x8, t_); } } while (0)
#define H16_LDB(B_, d_) do { const unsigned bb_ = b0 - 64u * (unsigned)(d_); _Pragma("unroll") for (int m = 0; m < 11; ++m) B_[m] = *(const LAS bf16x8*)(lds + bb_ + 128 * m); } while (0)
#define H16_MMA(A_, B_, a_, COND) do { _Pragma("unroll") for (int j = 0; j < 4; ++j) _Pragma("unroll") for (int u = 0; u < 8; ++u) if (COND) acc[u][a_] = __builtin_amdgcn_mfma_f32_16x16x32_bf16(A_[j], B_[u - j + 3], acc[u][a_], 0, 0, 0); } while (0)
#define H16_SB() __builtin_amdgcn_sched_barrier(0)
#define H16_PAIR(k_, CE_, CO_, BGS_) do { const int dE = 8 * (k_); \
            H16_LDA(Ay, dE, 1); H16_SB(); H16_MMA(Ax, Bx, 0, CE_); H16_SB(); BGS_; H16_SB(); H16_LDA(Ax, dE + 1, 0); H16_LDB(By, dE + 1); H16_SB(); H16_MMA(Ay, Bx, 1, CE_); H16_SB(); \
            H16_LDA(Ay, dE + 1, 1); H16_SB(); H16_MMA(Ax, By, 0, CO_); H16_SB(); H16_LDA(Ax, dE + 8, 0); H16_LDB(Bx, dE + 8); H16_SB(); H16_MMA(Ay, By, 1, CO_); H16_SB(); } while (0)
        {
            bf16x8 Ax[4], Ay[4], Bx[11], By[11];
            H16_LDA(Ax, 0, 0); H16_LDB(Bx, 0);
            H16_PAIR(0, u <= j, u <= j, (void)0);
            H16_PAIR(1, u <= j + 4, u <= j + 4, (void)0);
            int kEnd = 16; asm volatile("" : "+s"(kEnd));
#pragma unroll 1
            for (int k = 2; k < kEnd; ++k) H16_PAIR(k, true, true, bgtr::step(BG, bgstride, in, ws, lds, bgtile, lane));
            H16_PAIR(16, u >= j, u >= j + 1, (void)0);
            H16_PAIR(17, u >= j + 4, u >= j + 5, (void)0);
        }
#undef H16_LDA
#undef H16_LDB
#undef H16_MMA
#undef H16_SB
#undef H16_PAIR
        float l1 = 0.f;
#pragma unroll
        for (int k = 0; k < 8; ++k) l1 += *(const LAS float*)(lds + LRED + 4 * k);
        const float inv = 1.0f / (l1 + 1e-6f), sk = skip[ord * 512 + c];
        bf16_t* dst = (ord == 0 ? ZS : YHT) + (size_t)c * T + (size_t)bcol * SEQ;
#pragma unroll
        for (int u = 0; u < 8; ++u)
#pragma unroll
            for (int a = 0; a < 2; ++a) { const int t4 = 32 * (2 * (8 * wid + u) + pcol) + 16 * a + 4 * g4;
                const u32x2 zw = *(const LAS u32x2*)(lds + LZ + bcol * SB + 2 * (PADT + t4));
                const float z0 = bflo(zw[0]), z1 = bfhi(zw[0]), z2 = bflo(zw[1]), z3 = bfhi(zw[1]);
                u32x2 ow; ow[0] = pk2(acc[u][a][0] * inv + sk * z0, acc[u][a][1] * inv + sk * z1); ow[1] = pk2(acc[u][a][2] * inv + sk * z2, acc[u][a][3] * inv + sk * z3);
                *(u32x2*)(dst + t4) = ow; }
        VM_WAIT();
        __syncthreads();
    }
}
}

struct P2cItem { u32x4 uw[8], zw[8]; float prev, last; };
__device__ __forceinline__ void p2c_load(P2cItem& I, const bf16_t* UHT, const bf16_t* YHT, int it, int lane) {
    const int g = it & 7, tb = it >> 3; const int t0 = tb * 64, ts0 = t0 & (SEQ - 1); const int c = 64 * g + lane, cc = 1024 + c;
    const bf16_t* u = UHT + (size_t)cc * T + t0; const bf16_t* zp = YHT + (size_t)c * T + t0;
#pragma unroll
    for (int k = 0; k < 8; ++k) { I.uw[k] = *(const u32x4*)(u + 8 * k); I.zw[k] = *(const u32x4*)(zp + 8 * k); }
    I.prev = ts0 > 0 ? bf2f(u[-1]) : 0.f; I.last = ts0 + 64 < SEQ ? bf2f(u[64]) : 0.f;
}
__device__ __forceinline__ void p2c_process(const P2cItem& I, const float* sw, const float* sbias, bf16_t* Y, LAS float* tile, int it, int lane) {
    const int g = it & 7, tb = it >> 3; const int t0 = tb * 64;
    {
        const int cc = 1024 + 64 * g + lane;
        const float w0 = sw[cc], w1 = sw[1536 + cc], w2 = sw[3072 + cc], bb = sbias[cc];
        float prev = I.prev;
#pragma unroll
        for (int k = 0; k < 8; ++k) { float x[10]; x[0] = prev;
#pragma unroll
            for (int j = 0; j < 4; ++j) { x[1 + 2 * j] = bflo(I.uw[k][j]); x[2 + 2 * j] = bfhi(I.uw[k][j]); }
            x[9] = (k < 7) ? bflo(I.uw[k < 7 ? k + 1 : 7][0]) : I.last; prev = x[8];
#pragma unroll
            for (int j = 0; j < 8; ++j) { const float gate = w0 * x[j] + w1 * x[j + 1] + w2 * x[j + 2] + bb; const float zc = (j & 1) ? bfhi(I.zw[k][j >> 1]) : bflo(I.zw[k][j >> 1]);
                tile[lane * 65 + 8 * k + j] = gate * zc; } }
    }
    LDS_WAIT(); asm volatile("" ::: "memory");
    {
        float ss = 0.f;
#pragma unroll 8
        for (int ch = 0; ch < 64; ++ch) { const float v = tile[ch * 65 + lane]; ss += v * v; }
        const float rs = 1.0f / sqrtf(ss * (1.0f / 64.0f) + EPSN);
        bf16_t* o = Y + (size_t)(t0 + lane) * 1024 + 64 * g;
#pragma unroll
        for (int k = 0; k < 8; ++k) { u32x4 w;
#pragma unroll
            for (int j = 0; j < 4; ++j) w[j] = pk2(tile[(8 * k + 2 * j) * 65 + lane] * rs, tile[(8 * k + 2 * j + 1) * 65 + lane] * rs);
            *(u32x4*)(o + 8 * k) = w; }
    }
    LDS_WAIT(); asm volatile("" ::: "memory");
}
__device__ __forceinline__ void p2c_transpose(Frame& F, bf16_t* Y) {
    const int gw = F.vcu * NWAVES + F.wave, NGW = F.G * NWAVES, lane = F.lane;
    const bf16_t* UHT = (const bf16_t*)(F.ws + WS_UHT); const bf16_t* YHT = (const bf16_t*)(F.ws + WS_YHT);
    const float* sw = F.in[4]; const float* sbias = F.in[5];
    LAS float* tile = (LAS float*)(F.lds + F.wave * 16640);
    constexpr int NIT = 8 * (T / 64);
    for (int it = gw; it < NIT; it += 2 * NGW) {
        P2cItem A, B; const bool hasB = it + NGW < NIT;
        p2c_load(A, UHT, YHT, it, lane);
        if (hasB) p2c_load(B, UHT, YHT, it + NGW, lane);
        p2c_process(A, sw, sbias, Y, tile, it, lane);
        if (hasB) p2c_process(B, sw, sbias, Y, tile, it + NGW, lane);
    }
}

struct TileSched {
    int G, vcu, nM, lgN; const char *A, *B; size_t tA, tB; int kt;
    __device__ __forceinline__ bool next(int i, pg8::Unit& u) const {
        const int L = i * G + vcu; if (L >= (nM << lgN)) return false;
        u.pm = L >> lgN; u.pn = L & ((1 << lgN) - 1); u.A = A + (size_t)u.pm * tA; u.B = B + (size_t)u.pn * tB; u.aux = 0; u.flags = 3; u.kt = kt; return true;
    }
};
template <bool BASE_BF16> struct EpiResid {
    const float* base; bf16_t* xb; float* ss; const float* rowscale;
    __device__ __forceinline__ void operator()(const f32x4 (&acc)[2][2][4][2], const pg8::Unit& u, int wr, int wc, int fr, int fq) const {
        const int row0 = u.pm * 256 + wr * 64 + fr, col0 = u.pn * 256 + wc * 32 + 8 * fq;
#pragma unroll
        for (int ai = 0; ai < 2; ++ai)
#pragma unroll
            for (int mh = 0; mh < 2; ++mh) {
                f32x4 b[4][2][2];
#pragma unroll
                for (int mm = 0; mm < 2; ++mm) { const int r = row0 + ai * 128 + (2 * mh + mm) * 16; const float rsc = (BASE_BF16 && rowscale) ? rowscale[r] : 1.0f;
#pragma unroll
                    for (int bj = 0; bj < 2; ++bj) { const size_t off = (size_t)r * 1024 + col0 + bj * 128;
                        if (BASE_BF16) { const u32x4 bw = *(const u32x4*)(xb + off); b[mm][bj][0] = (f32x4){bflo(bw[0]), bfhi(bw[0]), bflo(bw[1]), bfhi(bw[1])} * rsc; b[mm][bj][1] = (f32x4){bflo(bw[2]), bfhi(bw[2]), bflo(bw[3]), bfhi(bw[3])} * rsc; }
                        else { b[mm][bj][0] = *(const f32x4*)(base + off); b[mm][bj][1] = *(const f32x4*)(base + off + 4); } } }
#pragma unroll
                for (int mm = 0; mm < 2; ++mm) { const int m = 2 * mh + mm; const int r = row0 + ai * 128 + m * 16; float part = 0.f;
#pragma unroll
                    for (int bj = 0; bj < 2; ++bj) { const size_t off = (size_t)r * 1024 + col0 + bj * 128;
                        const f32x4 v0 = acc[ai][bj][m][0] + b[mm][bj][0], v1 = acc[ai][bj][m][1] + b[mm][bj][1];
                        u32x4 w; w.x = pg8::cvt_pk_bf16(v0[0], v0[1]); w.y = pg8::cvt_pk_bf16(v0[2], v0[3]); w.z = pg8::cvt_pk_bf16(v1[0], v1[1]); w.w = pg8::cvt_pk_bf16(v1[2], v1[3]);
                        *(u32x4*)(xb + off) = w;
                        part += (v0[0] * v0[0] + v0[1] * v0[1]) + (v0[2] * v0[2] + v0[3] * v0[3]) + (v1[0] * v1[0] + v1[1] * v1[1]) + (v1[2] * v1[2] + v1[3] * v1[3]); }
                    part += __shfl_xor(part, 16); part += __shfl_xor(part, 32);
                    if (fq == 0) ss[(size_t)r * 16 + u.pn * 4 + wc] = part; }
                asm volatile("" ::: "memory"); }
    }
};
__device__ __forceinline__ float row_rstd(const float* ssp, int r) {
    const f32x4* p = (const f32x4*)(ssp + (size_t)r * 16); const f32x4 a = p[0], b = p[1], c = p[2], d = p[3];
    const float t = (((a[0] + a[1]) + (a[2] + a[3])) + ((b[0] + b[1]) + (b[2] + b[3]))) + (((c[0] + c[1]) + (c[2] + c[3])) + ((d[0] + d[1]) + (d[2] + d[3])));
    return 1.0f / sqrtf(t * (1.0f / 1024.0f) + EPSN);
}
struct EpiRowScale {
    bf16_t* O; const float* ss;
    __device__ __forceinline__ void operator()(const f32x4 (&acc)[2][2][4][2], const pg8::Unit& u, int wr, int wc, int fr, int fq) const {
        const int row0 = u.pm * 256 + wr * 64 + fr, col0 = u.pn * 256 + wc * 32 + 8 * fq;
#pragma unroll
        for (int ai = 0; ai < 2; ++ai)
#pragma unroll
            for (int m = 0; m < 4; ++m) { const int r = row0 + ai * 128 + m * 16; const float rs = row_rstd(ss, r);
#pragma unroll
                for (int bj = 0; bj < 2; ++bj) { const f32x4 v0 = acc[ai][bj][m][0] * rs, v1 = acc[ai][bj][m][1] * rs;
                    u32x4 w; w.x = pg8::cvt_pk_bf16(v0[0], v0[1]); w.y = pg8::cvt_pk_bf16(v0[2], v0[3]); w.z = pg8::cvt_pk_bf16(v1[0], v1[1]); w.w = pg8::cvt_pk_bf16(v1[2], v1[3]);
                    *(u32x4*)(O + (size_t)r * 512 + col0 + bj * 128) = w; } }
    }
};

namespace ma {
constexpr int KP = 272, VP = 520;
constexpr int LK = 0, LV = 256 * KP, LEND = LV + 128 * VP;
static_assert(LEND <= MISC_OFF, "mem-attn LDS map");
__device__ __forceinline__ void memattn_unit(int b, int h, int rb, const bf16_t* QM, const bf16_t* KVM, bf16_t* OM, const float* gq, LAS unsigned char* lds) {
    const int tid = threadIdx.x, lane = tid & 63, wid = __builtin_amdgcn_readfirstlane(tid >> 6), r32 = lane & 31, hi = lane >> 5;
    __syncthreads();
#pragma unroll 2
    for (int k = 0; k < 8; ++k) { const int p = tid + 512 * k, key = p >> 4, ch = p & 15;
        const u32x4 w = *(const u32x4*)(KVM + (size_t)(b * 256 + key) * 1024 + h * 128 + ch * 8);
        *(LAS u32x4*)(lds + LK + key * KP + ch * 16) = w; }
#pragma unroll 2
    for (int k = 0; k < 8; ++k) { const int p = tid + 512 * k, key = p & 255, ch = p >> 8;
        const u32x4 w = *(const u32x4*)(KVM + (size_t)(b * 256 + key) * 1024 + 512 + h * 128 + ch * 8);
#pragma unroll
        for (int j = 0; j < 4; ++j) { *(LAS bf16_t*)(lds + LV + (ch * 8 + 2 * j) * VP + key * 2) = (bf16_t)(w[j] & 0xffffu); *(LAS bf16_t*)(lds + LV + (ch * 8 + 2 * j + 1) * VP + key * 2) = (bf16_t)(w[j] >> 16); } }
    const size_t qrow = (size_t)b * SEQ + rb * 256 + wid * 32 + r32;
    bf16x8 qf[8];
    {
        float qv[8][8]; float ssq = 0.f;
#pragma unroll
        for (int ks = 0; ks < 8; ++ks) { const u32x4 w = *(const u32x4*)(QM + qrow * 512 + h * 128 + ks * 16 + hi * 8);
#pragma unroll
            for (int j = 0; j < 4; ++j) { qv[ks][2 * j] = bflo(w[j]); qv[ks][2 * j + 1] = bfhi(w[j]); ssq += qv[ks][2 * j] * qv[ks][2 * j] + qv[ks][2 * j + 1] * qv[ks][2 * j + 1]; } }
        ssq += __shfl_xor(ssq, 32);
        const float rs = (0.08838834764831845f * 1.4426950408889634f) / sqrtf(ssq * (1.0f / 128.0f) + EPSN);
#pragma unroll
        for (int ks = 0; ks < 8; ++ks) { const f32x4 g0 = *(const f32x4*)(gq + ks * 16 + hi * 8), g1 = *(const f32x4*)(gq + ks * 16 + hi * 8 + 4); u32x4 w;
#pragma unroll
            for (int j = 0; j < 2; ++j) { w[j] = pk2(qv[ks][2 * j] * rs * g0[2 * j], qv[ks][2 * j + 1] * rs * g0[2 * j + 1]); w[2 + j] = pk2(qv[ks][4 + 2 * j] * rs * g1[2 * j], qv[ks][5 + 2 * j] * rs * g1[2 * j + 1]); }
            qf[ks] = __builtin_bit_cast(bf16x8, w); }
    }
    __syncthreads();
    f32x16 st[8];
#pragma unroll
    for (int kb = 0; kb < 8; ++kb) { f32x16 a = f32x16{};
#pragma unroll
        for (int ks = 0; ks < 8; ++ks) { const bf16x8 kf = *(const LAS bf16x8*)(lds + LK + (kb * 32 + r32) * KP + ks * 32 + hi * 16);
            a = __builtin_amdgcn_mfma_f32_32x32x16_bf16(kf, qf[ks], a, 0, 0, 0); }
        st[kb] = a; }
    float mx = -1e30f;
#pragma unroll
    for (int kb = 0; kb < 8; ++kb)
#pragma unroll
        for (int r = 0; r < 16; ++r) mx = fmaxf(mx, st[kb][r]);
    mx = fmaxf(mx, __shfl_xor(mx, 32));
    float l = 0.f; u32x4 pb[8][2];
#pragma unroll
    for (int kb = 0; kb < 8; ++kb) {
#pragma unroll
        for (int r = 0; r < 16; ++r) { st[kb][r] = __builtin_amdgcn_exp2f(st[kb][r] - mx); l += st[kb][r]; }
#pragma unroll
        for (int s2 = 0; s2 < 2; ++s2)
#pragma unroll
            for (int j = 0; j < 4; ++j) pb[kb][s2][j] = pk2(st[kb][8 * s2 + 2 * j], st[kb][8 * s2 + 2 * j + 1]); }
    l += __shfl_xor(l, 32);
    const float il = 1.0f / l;
    bf16_t* orow = OM + qrow * 512 + h * 128;
#pragma unroll
    for (int db = 0; db < 4; ++db) { f32x16 o = f32x16{};
#pragma unroll
        for (int kb = 0; kb < 8; ++kb)
#pragma unroll
            for (int s2 = 0; s2 < 2; ++s2) { const LAS unsigned char* vp = lds + LV + (db * 32 + r32) * VP + 2 * (kb * 32 + 16 * s2 + 4 * hi);
                const u32x2 v0 = *(const LAS u32x2*)vp, v1 = *(const LAS u32x2*)(vp + 16);
                const u32x4 vv = (u32x4){v0[0], v0[1], v1[0], v1[1]};
                o = __builtin_amdgcn_mfma_f32_32x32x16_bf16(__builtin_bit_cast(bf16x8, vv), __builtin_bit_cast(bf16x8, pb[kb][s2]), o, 0, 0, 0); }
#pragma unroll
        for (int g4 = 0; g4 < 4; ++g4) { u32x2 w; w[0] = pk2(o[4 * g4] * il, o[4 * g4 + 1] * il); w[1] = pk2(o[4 * g4 + 2] * il, o[4 * g4 + 3] * il);
            *(u32x2*)(orow + db * 32 + 8 * g4 + 4 * hi) = w; } }
}
}

constexpr size_t WS_SSP1 = WS_MOE + 6 * MiBx, WS_SSP2 = WS_MOE + 8 * MiBx;
constexpr size_t WS_TOKW = WS_MOE + 1 * MiBx, WS_RS = WS_MOE + 2 * MiBx, WS_TOKS = WS_MOE + 3 * MiBx;
constexpr size_t WS_HB = WS_UHT;
constexpr int XS_ROWS = T + 24 * 256;
constexpr int WRP = 336;
__device__ __forceinline__ void p6a_route(Frame& F) {
    const int lane = F.lane;
    const float* WR = (const float*)(F.ws + WS_WR); const float* brg = F.in[28]; const float* bre = F.in[30];
    int* cnt = (int*)(F.ctl + CW_CNT); int* toks = (int*)(F.ws + WS_TOKS); float* tokw = (float*)(F.ws + WS_TOKW); float* rs2 = (float*)(F.ws + WS_RS);
    const bf16_t* xb = (const bf16_t*)(F.ws + WS_XN);
    volatile LAS int* cntl = (volatile LAS int*)(F.lds + 256 * WRP); volatile LAS int* basel = cntl + 32;
    __syncthreads();
    for (int i = F.tid; i < 20 * 256; i += NWAVES * 64) { const int e = i >> 8, k4 = i & 255; *(LAS f32x4*)(F.lds + k4 * WRP + e * 16) = *(const f32x4*)(WR + e * 1024 + 4 * k4); }
    if (F.tid < 32) cntl[F.tid] = 0;
    __syncthreads();
    const int tl = lane >> 2, part = lane & 3;
    for (int tb = F.vcu; tb < T / 128; tb += F.G) {
        const int tok = tb * 128 + F.wave * 16 + tl;
        const u32x4* xr = (const u32x4*)(xb + (size_t)tok * 1024) + part;
        float lg[20]; float ssq = 0.f;
#pragma unroll
        for (int e = 0; e < 20; ++e) lg[e] = 0.f;
#pragma unroll 4
        for (int it = 0; it < 32; ++it) { const u32x4 xw = xr[4 * it];
            const f32x4 v0 = (f32x4){bflo(xw[0]), bfhi(xw[0]), bflo(xw[1]), bfhi(xw[1])}, v1 = (f32x4){bflo(xw[2]), bfhi(xw[2]), bflo(xw[3]), bfhi(xw[3])};
            ssq += (v0.x * v0.x + v0.y * v0.y) + (v0.z * v0.z + v0.w * v0.w) + (v1.x * v1.x + v1.y * v1.y) + (v1.z * v1.z + v1.w * v1.w);
            const LAS unsigned char* wp = F.lds + (8 * it + 2 * part) * WRP;
#pragma unroll
            for (int e = 0; e < 20; ++e) { const f32x4 w0 = *(const LAS f32x4*)(wp + e * 16), w1 = *(const LAS f32x4*)(wp + WRP + e * 16);
                lg[e] += ((v0.x * w0.x + v0.y * w0.y) + (v0.z * w0.z + v0.w * w0.w)) + ((v1.x * w1.x + v1.y * w1.y) + (v1.z * w1.z + v1.w * w1.w)); } }
        ssq += __shfl_xor(ssq, 1); ssq += __shfl_xor(ssq, 2);
        const float rstd = 1.0f / sqrtf(ssq * (1.0f / 1024.0f) + EPSN);
#pragma unroll
        for (int e = 0; e < 20; ++e) { lg[e] += __shfl_xor(lg[e], 1); lg[e] += __shfl_xor(lg[e], 2); lg[e] *= rstd; }
        float gl[4], gm = -1e30f;
#pragma unroll
        for (int j = 0; j < 4; ++j) { gl[j] = lg[j] + brg[j]; gm = fmaxf(gm, gl[j]); }
        float gs = 0.f, gp[4];
#pragma unroll
        for (int j = 0; j < 4; ++j) { gp[j] = expf(gl[j] - gm); gs += gp[j]; }
        int gi = 0; float best = gp[0];
#pragma unroll
        for (int j = 1; j < 4; ++j) if (gp[j] > best) { best = gp[j]; gi = j; }
        const float pg = best / gs;
        float el[4], em = -1e30f;
#pragma unroll
        for (int j = 0; j < 4; ++j) { float vv = 0.f;
#pragma unroll
            for (int q = 0; q < 4; ++q) if (q == gi) vv = lg[4 + q * 4 + j] + bre[q * 4 + j];
            el[j] = vv; em = fmaxf(em, vv); }
        float ep[4];
#pragma unroll
        for (int j = 0; j < 4; ++j) ep[j] = expf(el[j] - em);
        int e1 = 0; float p1 = ep[0];
#pragma unroll
        for (int j = 1; j < 4; ++j) if (ep[j] > p1) { p1 = ep[j]; e1 = j; }
        int e2 = -1; float p2 = -1.f;
#pragma unroll
        for (int j = 0; j < 4; ++j) if (j != e1 && ep[j] > p2) { p2 = ep[j]; e2 = j; }
        const float w1 = pg * p1 / (p1 + p2), w2 = pg * p2 / (p1 + p2);
        const int lo = e1 < e2 ? e1 : e2, hi2 = e1 < e2 ? e2 : e1; const float wlo = e1 < e2 ? w1 : w2, whi = e1 < e2 ? w2 : w1;
        const int pidx = (lo == 0) ? (hi2 - 1) : (lo == 1 ? hi2 + 1 : 5);
        const int bucket = gi * 6 + pidx;
        int rank = 0;
        if (part == 0) rank = __hip_atomic_fetch_add((LAS int*)&cntl[bucket], 1, __ATOMIC_RELAXED, __HIP_MEMORY_SCOPE_WORKGROUP);
        __syncthreads();
        if (F.tid < 24) { const int c = cntl[F.tid]; basel[F.tid] = c ? atomicAdd(&cnt[F.tid * 64], c) : 0; }
        __syncthreads();
        if (part == 0) { const int pos = basel[bucket] + rank; toks[(size_t)bucket * T + pos] = tok; tokw[2 * tok] = wlo; tokw[2 * tok + 1] = whi; rs2[tok] = rstd; }
        __syncthreads();
        if (F.tid < 32) cntl[F.tid] = 0;
        __syncthreads();
    }
}
__device__ __forceinline__ void moe_prefix(Frame& F, volatile LAS int* tp) {
    if (F.tid == 0) { const int* cnt = (const int*)(F.ctl + CW_CNT); int s = 0; for (int b = 0; b < 24; ++b) { tp[b] = s; s += (cnt[b * 64] + 255) >> 8; } tp[24] = s; }
    __syncthreads();
}
__device__ __forceinline__ int moe_bucket_of_tile(volatile LAS int* tp, int tau) { int b = 0;
#pragma unroll
    for (int k = 1; k < 24; ++k) b += (tau >= tp[k]) ? 1 : 0;
    return b; }
__device__ __forceinline__ int moe_expert(int bucket, int slot) { const int g = bucket / 6, p = bucket % 6; const int lo = p < 3 ? 0 : (p < 5 ? 1 : 2), hi2 = p < 3 ? p + 1 : (p < 5 ? p - 1 : 3); return g * 4 + (slot ? hi2 : lo); }
constexpr int CW_TCNT = 11264;
static_assert((CW_TCNT + 160 * 16) * 4 <= (int)CTL_ZERO_BYTES, "ctl region");
struct MoeSched {
    int G, vcu; volatile LAS int* tp; const int* cnt; const char *xb, *wgu, *hb, *wd; const int* toks; unsigned* tcnt;
    __device__ __forceinline__ void tile_rows(int tau, pg8::Unit& u) const { const int b = moe_bucket_of_tile(tp, tau); const int off = (tau - tp[b]) * 256; u.rows = toks + (size_t)b * T + off; const int c = cnt[b * 64] - off; u.nvalid = c < 256 ? c : 256; }
    __device__ __forceinline__ bool next(int i, pg8::Unit& u) const {
        const int ntile = tp[24]; const int NU = ntile * 8, ND = ntile * 4;
        const int nu = (NU > vcu) ? (NU - vcu + G - 1) / G : 0;
        if (i < nu) { const int L = i * G + vcu; const int tau = L >> 3, slot = (L >> 2) & 1, pn = L & 3; const int e = moe_expert(moe_bucket_of_tile(tp, tau), slot);
            u.pm = tau; u.pn = pn; u.aux = slot; u.flags = 3; u.kt = 16; u.A = xb; u.B = wgu + ((size_t)e * 1024 + pn * 256) * 2048; tile_rows(tau, u); return true; }
        const int j = i - nu; const int Ld = (nu + (j >> 1)) * G + vcu - NU, slot = j & 1; if (Ld >= ND) return false;
        const int tau = Ld >> 2, pn = Ld & 3; const int e = moe_expert(moe_bucket_of_tile(tp, tau), slot);
        if (slot == 0) { unsigned spins = 0; while (__hip_atomic_load(tcnt + tau * 16, __ATOMIC_RELAXED, __HIP_MEMORY_SCOPE_AGENT) < 8u) { __builtin_amdgcn_s_sleep(4); if (++spins > (1u << 22)) break; }
            __builtin_amdgcn_fence(__ATOMIC_ACQUIRE, "agent"); }
        u.pm = tau; u.pn = pn; u.aux = 2 | slot; u.flags = slot ? 2 : 1; u.kt = 8; u.A = hb + (size_t)tau * 256 * 2048 + slot * 1024; u.B = wd + ((size_t)e * 1024 + pn * 256) * 2048; tile_rows(tau, u); return true;
    }
    __device__ __forceinline__ unsigned rowoff(const pg8::Unit& u, int R) const {
        if (u.aux & 2) return (unsigned)R * 2048u;
        const int tok = (R < u.nvalid) ? u.rows[R] : 0; return (unsigned)tok * 2048u;
    }
};
struct EpiMoeUp {
    bf16_t* H; const float* rs2; const float* tokw;
    __device__ __forceinline__ void operator()(const f32x4 (&acc)[2][2][4][2], const pg8::Unit& u, int wr, int wc, int fr, int fq) const {
        const int rl0 = wr * 64 + fr, col0 = u.aux * 512 + u.pn * 128 + wc * 32 + 8 * fq;
#pragma unroll
        for (int ai = 0; ai < 2; ++ai)
#pragma unroll
            for (int m = 0; m < 4; ++m) { const int rl = rl0 + ai * 128 + m * 16; const int tok = (rl < u.nvalid) ? u.rows[rl] : -1;
                const float rs = tok >= 0 ? rs2[tok] : 0.f, gwt = tok >= 0 ? tokw[2 * tok + u.aux] : 0.f;
                float hv[8];
#pragma unroll
                for (int n = 0; n < 2; ++n)
#pragma unroll
                    for (int k = 0; k < 4; ++k) { const float g = acc[ai][0][m][n][k] * rs, uu = acc[ai][1][m][n][k] * rs; hv[4 * n + k] = g / (1.0f + __expf(-g)) * uu * gwt; }
                u32x4 w; w.x = pg8::cvt_pk_bf16(hv[0], hv[1]); w.y = pg8::cvt_pk_bf16(hv[2], hv[3]); w.z = pg8::cvt_pk_bf16(hv[4], hv[5]); w.w = pg8::cvt_pk_bf16(hv[6], hv[7]);
                { bf16_t* hp = H + (size_t)(u.pm * 256 + rl) * 1024 + col0; asm volatile("global_store_dwordx4 %0, %1, off sc1\n\ts_nop 1" :: "v"(hp), "v"(w) : "memory"); } }
    }
};
struct EpiMoeDown {
    float* out; const bf16_t* xb;
    __device__ __forceinline__ void operator()(const f32x4 (&acc)[2][2][4][2], const pg8::Unit& u, int wr, int wc, int fr, int fq) const {
        const int rl0 = wr * 64 + fr, col0 = u.pn * 256 + wc * 32 + 8 * fq;
        int tk[2][4];
#pragma unroll
        for (int ai = 0; ai < 2; ++ai)
#pragma unroll
            for (int m = 0; m < 4; ++m) { const int rl = rl0 + ai * 128 + m * 16; tk[ai][m] = (rl < u.nvalid) ? u.rows[rl] : -1; }
#pragma unroll
        for (int ai = 0; ai < 2; ++ai) {
            u32x4 bw[4][2];
#pragma unroll
            for (int m = 0; m < 4; ++m)
#pragma unroll
                for (int bj = 0; bj < 2; ++bj) bw[m][bj] = *(const u32x4*)(xb + (size_t)(tk[ai][m] < 0 ? 0 : tk[ai][m]) * 1024 + col0 + bj * 128);
#pragma unroll
            for (int m = 0; m < 4; ++m) { const int tok = tk[ai][m];
                if (tok >= 0) {
#pragma unroll
                    for (int bj = 0; bj < 2; ++bj) { float* p = out + (size_t)tok * 1024 + col0 + bj * 128; const u32x4 w = bw[m][bj];
                        __builtin_nontemporal_store((f32x4){bflo(w[0]), bfhi(w[0]), bflo(w[1]), bfhi(w[1])} + acc[ai][bj][m][0], (f32x4*)p); __builtin_nontemporal_store((f32x4){bflo(w[2]), bfhi(w[2]), bflo(w[3]), bfhi(w[3])} + acc[ai][bj][m][1], (f32x4*)(p + 4)); } } }
            asm volatile("" ::: "memory"); }
    }
};
struct EpiMoe {
    EpiMoeUp up; EpiMoeDown down; unsigned* tcnt;
    __device__ __forceinline__ void operator()(const f32x4 (&acc)[2][2][4][2], const pg8::Unit& u, int wr, int wc, int fr, int fq) const {
        if (u.aux & 2) { down(acc, u, wr, wc, fr, fq); return; }
        up(acc, u, wr, wc, fr, fq);
        asm volatile("s_waitcnt vmcnt(0)" ::: "memory");
        __builtin_amdgcn_s_barrier();
        if (threadIdx.x == 0) __hip_atomic_fetch_add(tcnt + u.pm * 16, 1u, __ATOMIC_RELAXED, __HIP_MEMORY_SCOPE_AGENT);
    }
};

struct Args { const float* in[34]; float* out; unsigned char* ws; unsigned char* ybuf; int ph_lo, ph_hi; };
__global__ void __launch_bounds__(NWAVES * 64, 2) mk_fwd(Args args) {
    extern __shared__ __attribute__((aligned(16))) unsigned char lds[];
    Frame F;
    F.lds = (LAS unsigned char*)lds;
    F.tid = threadIdx.x; F.lane = F.tid & 63; F.wave = __builtin_amdgcn_readfirstlane(F.tid >> 6);
    F.G = gridDim.x; { const int bx = blockIdx.x; F.vcu = (F.G % 8 == 0) ? (bx % 8) * (F.G / 8) + bx / 8 : bx; }
    F.ws = args.ws; F.ctl = (unsigned*)(args.ws + WS_CTL); F.in = args.in; F.out = args.out;
    volatile LAS unsigned* MISC = (volatile LAS unsigned*)(F.lds + MISC_OFF);
    for (int u = F.tid; u < 128; u += NWAVES * 64) MISC[u] = 0u;
    __syncthreads();
    XcdBarrier bar = xcd_barrier_post(F.ctl + CW_BAR, MISC + 8);
    const int lo = args.ph_lo, hi = args.ph_hi;
#ifdef MK_TS
    if (blockIdx.x == MK_TSB && F.tid == 0) { const unsigned long long t_ = __builtin_amdgcn_s_memrealtime(); MISC[58] = (unsigned)t_; MISC[59] = (unsigned)(t_ >> 32); }
#define TSTAMP(k) TSI(k)
#else
#define TSTAMP(k) do {} while (0)
#endif
#define IN(k) (lo <= (k) && (k) < hi)
#define SEAM(k) do { if (IN(k) && IN((k) + 1)) xcd_barrier(bar); TSTAMP(k); } while (0)
    unsigned char* ws = args.ws;
    if (IN(0)) { p0_prologue(F); }
    SEAM(0);
    if (IN(1)) {
        P1Sched S{F.G, F.vcu, (const char*)(ws + WS_WIN), (const char*)(ws + WS_XN), (const char*)(ws + WS_MEMN), (const char*)(ws + WS_WKV)};
        EpiBf16Multi E{ws};
        pg8::gemm_phase(F.lds, 1024, 1024, 1024, S, E);
        VM_WAIT(); __syncthreads();
        { pg8::Unit u; for (int i = 0; S.next(i, u); ++i) { if (u.aux == 1 && u.pn == 2) kprep_tile(F, u.pm); else if (u.aux == 2 && u.pn < 2) kmem_norm_tile(F, u.pm, u.pn); } }
    }
    SEAM(1);
    TSTAMP(2);
    if (IN(3)) {
        const bf16_t* QKV = (const bf16_t*)(ws + WS_QKV); bf16_t* Yb = (bf16_t*)args.ybuf;
#ifndef NO_HY
        bgtr::State BG; BG.it = __builtin_amdgcn_readfirstlane(F.vcu * NWAVES + F.wave); BG.pend = 0;
        const int bgstride = F.G * NWAVES;
        for (int j = 0; j < 2; ++j) { const int c = j * F.G + F.vcu; if (c < 512)
            hy::hyena_unit(c, (const bf16_t*)(ws + WS_UHT), (bf16_t*)(ws + WS_ZS), (bf16_t*)(ws + WS_YHT), (const bf16_t*)(ws + WS_KF), (const float*)(F.ctl + CW_FN), args.in[4], args.in[5], args.in[12], F.lds, BG, bgstride, args.in, ws); }
        while (BG.it < bgtr::NIT || BG.pend) bgtr::step(BG, bgstride, args.in, ws, F.lds, (unsigned)__builtin_amdgcn_readfirstlane(bgtr::SCR + F.wave * bgtr::SCRW), F.lane);
        __syncthreads();
        TSI(30);
#endif
#ifndef NO_AT
        for (int i = 0; i < 4; ++i) { const int uid = i * F.G + F.vcu; if (uid < 1024) { const int pair = uid >> 6, rem = uid & 63;
            at::attn_unit<8>(pair >> 1, (pair & 1) * 4 + (rem >> 4), rem & 15, QKV, Yb, args.in[13], args.in[14], (const float*)(ws + WS_ROPE), (char*)lds); } }
#endif
    }
    SEAM(3);
#ifndef NO_P2C
    if (IN(4)) { p2c_transpose(F, (bf16_t*)args.ybuf); }
#endif
    SEAM(4);
    if (IN(5)) {
        TileSched S{F.G, F.vcu, T / 256, 2, (const char*)args.ybuf, (const char*)(ws + WS_WOUT), (size_t)256 * 2048, (size_t)256 * 2048, 16};
        EpiResid<true> E{nullptr, (bf16_t*)(ws + WS_XN), (float*)(ws + WS_SSP1), (const float*)(ws + WS_RMS0)};
        pg8::gemm_phase(F.lds, 1024, 1024, 1024, S, E);
    }
    SEAM(5);
    if (IN(6)) {
        TileSched S{F.G, F.vcu, T / 256, 1, (const char*)(ws + WS_XN), (const char*)(ws + WS_WQM), (size_t)256 * 2048, (size_t)256 * 2048, 16};
        EpiRowScale E{(bf16_t*)(ws + WS_QM), (const float*)(ws + WS_SSP1)};
        pg8::gemm_phase(F.lds, 1024, 1024, 1024, S, E);
        VM_WAIT(); __syncthreads();
        { pg8::Unit u; for (int i = 0; S.next(i, u); ++i) for (int hh = 0; hh < 2; ++hh)
            ma::memattn_unit(u.pm >> 4, 2 * u.pn + hh, u.pm & 15, (const bf16_t*)(ws + WS_QM), (const bf16_t*)(ws + WS_KVM), (bf16_t*)(ws + WS_OM), args.in[23], F.lds); }
        __syncthreads();
    }
    SEAM(6);
    TSTAMP(7);
    if (IN(8)) {
        TileSched S{F.G, F.vcu, T / 256, 2, (const char*)(ws + WS_OM), (const char*)(ws + WS_WOM), (size_t)256 * 1024, (size_t)256 * 1024, 8};
        EpiResid<true> E{nullptr, (bf16_t*)(ws + WS_XN), (float*)(ws + WS_SSP2), nullptr};
        pg8::gemm_phase(F.lds, 512, 512, 512, S, E);
    }
    SEAM(8);
    if (IN(9)) { p6a_route(F); }
    SEAM(9);
    volatile LAS int* tp = (volatile LAS int*)(MISC + 32);
    TSTAMP(10);
    if (IN(11)) {
        moe_prefix(F, tp);
        unsigned* tcnt = F.ctl + CW_TCNT;
        MoeSched S{F.G, F.vcu, tp, (const int*)(F.ctl + CW_CNT), (const char*)(ws + WS_XN), (const char*)(ws + WS_WGU), (const char*)(ws + WS_HB), (const char*)(ws + WS_WD), (const int*)(ws + WS_TOKS), tcnt};
        EpiMoe E{EpiMoeUp{(bf16_t*)(ws + WS_HB), (const float*)(ws + WS_RS), (const float*)(ws + WS_TOKW)}, EpiMoeDown{args.out, (const bf16_t*)(ws + WS_XN)}, tcnt};
        pg8::gemm_phase<EpiMoe, MoeSched, true>(F.lds, 1024, 1024, 1024, S, E);
        TSI(13);
    }
#ifdef MK_TS
    xcd_barrier(bar); TSTAMP(12);
    if (blockIdx.x == MK_TSB && F.tid == 0) { const unsigned long long ts1 = ((unsigned long long)MISC[61] << 32) | MISC[60], ts0 = ((unsigned long long)MISC[59] << 32) | MISC[58]; args.out[0] += (float)(ts1 - ts0) * 1e-3f; }
#endif
#undef IN
#undef SEAM
}

extern "C" void kernel_launch(void* const* d_in, const int* in_sizes, int n_in, void* d_out, int out_size, void* d_ws, size_t ws_size, hipStream_t stream) {
    static int grid = 0;
    if (grid == 0) {
        int dev = 0, cus = 0;
        if (hipGetDevice(&dev) != hipSuccess || hipDeviceGetAttribute(&cus, hipDeviceAttributeMultiprocessorCount, dev) != hipSuccess) { grid = -1; return; }
        if (hipFuncSetAttribute((const void*)mk_fwd, hipFuncAttributeMaxDynamicSharedMemorySize, LDS_BYTES) != hipSuccess) { fprintf(stderr, "hipFuncSetAttribute failed\n"); grid = -1; return; }
        (void)hipGetLastError();
        grid = cus;
    }
    if (grid < 0) return;
    (void)hipMemsetAsync((char*)d_ws + WS_CTL, 0, CTL_ZERO_BYTES, stream);
    Args a{};
    for (int i = 0; i < 34; ++i) a.in[i] = (const float*)d_in[i];
    a.out = (float*)d_out; a.ws = (unsigned char*)d_ws;
    a.ybuf = (unsigned char*)d_ws + WS_Y;
    a.ph_lo = 0; a.ph_hi = MK_STAGE;
    hipLaunchKernelGGL(mk_fwd, dim3(grid), dim3(NWAVES * 64), LDS_BYTES, stream, a);

}
```

```cpp
#include <hip/hip_runtime.h>
#include <cstdio>
#include <cstdint>
#include <cmath>
#define MK_STAGE 99
#define GAS __attribute__((address_space(1)))
#define LAS __attribute__((address_space(3)))
typedef unsigned short bf16_t;
typedef short bf16x8 __attribute__((ext_vector_type(8)));
typedef short s16x4 __attribute__((ext_vector_type(4)));
typedef float f32x4 __attribute__((ext_vector_type(4)));
typedef float f32x2 __attribute__((ext_vector_type(2)));
typedef float f32x16 __attribute__((ext_vector_type(16)));
typedef unsigned u32x4 __attribute__((ext_vector_type(4)));
typedef unsigned u32x2 __attribute__((ext_vector_type(2)));

constexpr int NB = 8, SEQ = 4096, T = NB * SEQ, DM = 1024, DIN = 2304, NMEMT = NB * 256;
constexpr int NWAVES = 8;
constexpr float EPSN = 1e-6f;

constexpr size_t MiBx = 1u << 20;
constexpr size_t WS_CTL = 0, CTL_ZERO_BYTES = 65536;
constexpr size_t WS_WR = 1 * MiBx;
constexpr size_t WS_ROPE = WS_WR + 98304;
constexpr size_t WS_WIN = 2 * MiBx;
constexpr size_t WS_WOUT = 8 * MiBx;
constexpr size_t WS_WQM = 10 * MiBx;
constexpr size_t WS_WKV = 11 * MiBx;
constexpr size_t WS_WOM = 13 * MiBx;
constexpr size_t WS_WGU = 14 * MiBx;
constexpr size_t WS_WD = 288 * MiBx;
constexpr size_t WS_MEMN = 62 * MiBx;
constexpr size_t WS_KVM = 66 * MiBx;
constexpr size_t WS_KF = 70 * MiBx;
constexpr size_t WS_MOE = 86 * MiBx;
constexpr size_t WS_RMS0 = WS_MOE + 2 * MiBx + 512 * 1024;
constexpr size_t WS_XN = 96 * MiBx;
constexpr size_t WS_UHT = 336 * MiBx;
constexpr size_t WS_QKV = 432 * MiBx;
constexpr size_t WS_YHT = 224 * MiBx;
constexpr size_t WS_Y = 160 * MiBx;
constexpr size_t WS_ZS = 256 * MiBx;
constexpr size_t WS_QM = 336 * MiBx, WS_OM = 368 * MiBx;
constexpr size_t WS_END = 480 * MiBx;
constexpr int CW_TMO = 0, CW_BAR = 4096;
constexpr int CW_FN = 8192;
constexpr int CW_CNT = 9472;
static_assert((CW_CNT + 24 * 64) * 4 <= (int)CTL_ZERO_BYTES, "ctl region");

constexpr int RING_BYTES = 131072;
constexpr int LDS_BYTES = 147456;
constexpr int MISC_OFF = LDS_BYTES - 512;

#define LDS_WAIT() asm volatile("s_waitcnt lgkmcnt(0)" ::: "memory")
#define VM_WAIT() asm volatile("s_waitcnt vmcnt(0)" ::: "memory")
__device__ __forceinline__ unsigned f2bf(float f) { unsigned u = __builtin_bit_cast(unsigned, f); return (u + 0x7fffu + ((u >> 16) & 1u)) >> 16; }
__device__ __forceinline__ unsigned pk2(float lo, float hi) { return f2bf(lo) | (f2bf(hi) << 16); }
__device__ __forceinline__ float bf2f(unsigned short b) { return __builtin_bit_cast(float, (unsigned)b << 16); }
__device__ __forceinline__ float bflo(unsigned w) { return __builtin_bit_cast(float, w << 16); }
__device__ __forceinline__ float bfhi(unsigned w) { return __builtin_bit_cast(float, w & 0xffff0000u); }
__device__ __forceinline__ float wsum_sw(float v) {
#define SWZ_(m) v += __int_as_float(__builtin_amdgcn_ds_swizzle(__float_as_int(v), 0x1F | ((m) << 10)))
    SWZ_(1); SWZ_(2); SWZ_(4); SWZ_(8); SWZ_(16);
#undef SWZ_
    return __int_as_float(__builtin_amdgcn_readlane(__float_as_int(v), 0)) + __int_as_float(__builtin_amdgcn_readlane(__float_as_int(v), 32));
}
__device__ __forceinline__ float wsum(float v) {
#pragma unroll
    for (int o = 1; o < 64; o <<= 1) v += __shfl_xor(v, o);
    return v;
}

namespace pg8 {
constexpr int BM = 256, BK = 64, HALF = 128, HTB = HALF * BK * 2, STAGE_BYTES = 8 * HTB;
__host__ __device__ __forceinline__ int lds_byte(int r, int c) { const int st = (r >> 4) * 2 + (c >> 5), rr = r & 15, cc = c & 31, ob = rr * 64 + cc * 2; return st * 1024 + (ob ^ (((ob >> 9) & 1) << 5)); }
__host__ __device__ __forceinline__ void stage_rc(int b, int& R, int& C) { const int st = b / 1024, sb = b % 1024, swz = sb ^ (((sb >> 9) & 1) << 5); R = (st >> 1) * 16 + swz / 64; C = (st & 1) * 32 + (swz % 64) / 2; }
__host__ __device__ __forceinline__ int perm32(int rho) { const int n = rho >> 4, i = rho & 15; return 8 * (i >> 2) + 4 * n + (i & 3); }

struct Unit { const char* A; const char* B; const int* rows; int pm, pn, aux, flags, kt, nvalid; };
__device__ __forceinline__ unsigned cvt_pk_bf16(float lo, float hi) { unsigned r; asm volatile("v_cvt_pk_bf16_f32 %0, %1, %2" : "=v"(r) : "v"(lo), "v"(hi)); return r; }

template <class Epi, class Sched, bool GATHER = false>
__device__ __forceinline__ void gemm_phase(LAS unsigned char* lds, const int lda, const int ldb, const int K, const Sched& S, const Epi& E) {
    const int tid = threadIdx.x, wid = __builtin_amdgcn_readfirstlane(tid >> 6), lane = tid & 63, wr = wid >> 2, wc = wid & 3, fr = lane & 15, fq = lane >> 4;
    (void)K;
    unsigned voffA[2], voffB[2]; int rowA[2]; unsigned colA[2];
#pragma unroll
    for (int i = 0; i < 2; ++i) { int R, C; stage_rc(tid * 16 + i * 8192, R, C); const int Rb = (R & ~31) + perm32(R & 31);
        voffA[i] = (unsigned)(R * lda + C) * 2u; voffB[i] = (unsigned)(Rb * ldb + C) * 2u; rowA[i] = R; colA[i] = (unsigned)C * 2u; }
    unsigned gA[2][2], gN[2][2];
    const size_t kstep = (size_t)(BK * 2);
    const size_t hstepA = (size_t)HALF * lda * 2, hstepB = (size_t)HALF * ldb * 2;
    const unsigned ldsw = (unsigned)wid * 1024u;
    const int aoff = lds_byte(wr * 64 + fr, fq * 8), boff = lds_byte(wc * 32 + fr, fq * 8);
#define PG8_SA(b, h) (((b) * 2 + (h)) * HTB)
#define PG8_SB(b, h) ((4 + (b) * 2 + (h)) * HTB)
#define PG8_STAGE(bufoff, gbase, voff) do { _Pragma("unroll") for (int _i = 0; _i < 2; ++_i) \
        __builtin_amdgcn_global_load_lds((const unsigned*)((const char*)(gbase) + (voff)[_i]), (LAS unsigned*)(lds + (bufoff) + ldsw + _i * 8192), 16, 0, 0); } while (0)
#define PG8_STAGE_A(bufoff, gbase, H, G_) do { _Pragma("unroll") for (int _i = 0; _i < 2; ++_i) \
        __builtin_amdgcn_global_load_lds((const unsigned*)((const char*)(gbase) + (GATHER ? G_[H][_i] : ((H) ? (unsigned)hstepA : 0u) + voffA[_i])), (LAS unsigned*)(lds + (bufoff) + ldsw + _i * 8192), 16, 0, 0); } while (0)
#define PG8_ROWOFF(G_, U_) do { if constexpr (GATHER) { _Pragma("unroll") for (int _h = 0; _h < 2; ++_h) _Pragma("unroll") for (int _i = 0; _i < 2; ++_i) G_[_h][_i] = S.rowoff(U_, rowA[_i] + 128 * _h) + colA[_i]; } } while (0)
#define PG8_LDA(dst, b, h) do { _Pragma("unroll") for (int m = 0; m < 4; ++m) _Pragma("unroll") for (int k = 0; k < 2; ++k) dst[m][k] = *(const LAS bf16x8*)(lds + PG8_SA(b, h) + aoff + m * 2048 + k * 1024); } while (0)
#define PG8_LDB(dst, b, h) do { _Pragma("unroll") for (int n = 0; n < 2; ++n) _Pragma("unroll") for (int k = 0; k < 2; ++k) dst[n][k] = *(const LAS bf16x8*)(lds + PG8_SB(b, h) + boff + n * 2048 + k * 1024); } while (0)
#define PG8_MMA(ai, bj, At, Bt) do { __builtin_amdgcn_s_setprio(1); _Pragma("unroll") for (int m = 0; m < 4; ++m) _Pragma("unroll") for (int n = 0; n < 2; ++n) _Pragma("unroll") for (int k = 0; k < 2; ++k) \
        acc[ai][bj][m][n] = __builtin_amdgcn_mfma_f32_16x16x32_bf16(Bt[n][k], At[m][k], acc[ai][bj][m][n], 0, 0, 0); __builtin_amdgcn_s_setprio(0); } while (0)
#define PG8_WAIT_V(n) asm volatile("s_waitcnt vmcnt(" #n ")" ::: "memory")
#define PG8_WAIT_L(n) asm volatile("s_waitcnt lgkmcnt(" #n ")" ::: "memory")
#define PG8_BAR __builtin_amdgcn_s_barrier()
#define PG8_SCHED __builtin_amdgcn_sched_barrier(0)
#define PG8_ZERO() do { _Pragma("unroll") for (int a = 0; a < 2; ++a) _Pragma("unroll") for (int b = 0; b < 2; ++b) _Pragma("unroll") for (int m = 0; m < 4; ++m) _Pragma("unroll") for (int n = 0; n < 2; ++n) acc[a][b][m][n] = (f32x4){0.f, 0.f, 0.f, 0.f}; } while (0)
    Unit cur, nxt; int ui = 0;
    if (!S.next(0, cur)) return;
    f32x4 acc[2][2][4][2];
    PG8_ZERO();
    bf16x8 At[4][2], B0[2][2], B1[2][2];
    const char* cA = cur.A; const char* cB = cur.B;
    PG8_ROWOFF(gA, cur);
    PG8_STAGE(PG8_SB(0, 0), cB, voffB); PG8_STAGE(PG8_SB(0, 1), cB + hstepB, voffB); PG8_STAGE_A(PG8_SA(0, 0), cA, 0, gA); PG8_STAGE_A(PG8_SA(0, 1), cA, 1, gA);
    if (wr == 1) PG8_BAR;
    PG8_WAIT_V(2); PG8_BAR;
    PG8_STAGE(PG8_SB(1, 0), cB + kstep, voffB); PG8_STAGE_A(PG8_SA(1, 0), cA + kstep, 0, gA); PG8_STAGE(PG8_SB(1, 1), cB + hstepB + kstep, voffB);
    PG8_WAIT_V(6); PG8_BAR;
    for (;;) {
        const bool has_next = S.next(ui + 1, nxt);
        const char* nA = has_next ? nxt.A : cA; const char* nB = has_next ? nxt.B : cB;
        if (has_next) PG8_ROWOFF(gN, nxt); else if constexpr (GATHER) { _Pragma("unroll") for (int _h = 0; _h < 2; ++_h) _Pragma("unroll") for (int _i = 0; _i < 2; ++_i) gN[_h][_i] = gA[_h][_i]; }
        const int nt = cur.kt;
        for (int t = 0; t < nt; t += 2) {
            const bool last = (t == nt - 2);
            const char* a1 = cA + (size_t)(t + 1) * kstep;
            const char* a2 = last ? nA : cA + (size_t)(t + 2) * kstep; const char* b2 = last ? nB : cB + (size_t)(t + 2) * kstep;
            const char* a3 = a2 + kstep; const char* b3 = b2 + kstep;
            unsigned g2[2][2];
            if constexpr (GATHER) { _Pragma("unroll") for (int _h = 0; _h < 2; ++_h) _Pragma("unroll") for (int _i = 0; _i < 2; ++_i) g2[_h][_i] = last ? gN[_h][_i] : gA[_h][_i]; }
            PG8_LDB(B0, 0, 0); PG8_LDB(B1, 0, 1); PG8_SCHED; PG8_LDA(At, 0, 0); PG8_STAGE_A(PG8_SA(1, 1), a1, 1, gA);
            PG8_WAIT_V(8); PG8_WAIT_L(0); PG8_BAR; PG8_MMA(0, 0, At, B0); PG8_MMA(0, 1, At, B1); PG8_BAR; PG8_SCHED;
            PG8_LDA(At, 0, 1); PG8_STAGE(PG8_SB(0, 0), b2, voffB); PG8_STAGE(PG8_SB(0, 1), b2 + hstepB, voffB); PG8_STAGE_A(PG8_SA(0, 0), a2, 0, g2);
            PG8_WAIT_V(8); PG8_WAIT_L(0); PG8_BAR; PG8_MMA(1, 0, At, B0); PG8_MMA(1, 1, At, B1); PG8_BAR; PG8_SCHED;
            PG8_LDB(B0, 1, 0); PG8_LDB(B1, 1, 1); PG8_SCHED; PG8_LDA(At, 1, 0); PG8_STAGE_A(PG8_SA(0, 1), a2, 1, g2);
            PG8_WAIT_V(8); PG8_WAIT_L(0); PG8_BAR; PG8_MMA(0, 0, At, B0); PG8_MMA(0, 1, At, B1); PG8_BAR; PG8_SCHED;
            PG8_LDA(At, 1, 1); PG8_STAGE(PG8_SB(1, 0), b3, voffB); PG8_STAGE(PG8_SB(1, 1), b3 + hstepB, voffB); PG8_STAGE_A(PG8_SA(1, 0), a3, 0, g2);
            PG8_WAIT_V(8); PG8_WAIT_L(0); PG8_BAR; PG8_MMA(1, 0, At, B0); PG8_MMA(1, 1, At, B1); PG8_BAR; PG8_SCHED;
        }
        if (wr == 0) PG8_BAR;
        if (cur.flags & 2) E(acc, cur, wr, wc, fr, fq);
        if (!has_next) break;
        if (nxt.flags & 1) PG8_ZERO();
        cur = nxt; cA = nA; cB = nB; ++ui;
        if constexpr (GATHER) { _Pragma("unroll") for (int _h = 0; _h < 2; ++_h) _Pragma("unroll") for (int _i = 0; _i < 2; ++_i) gA[_h][_i] = gN[_h][_i]; }
        if (wr == 1) PG8_BAR;
    }
    PG8_WAIT_V(0);
    PG8_BAR;
#undef PG8_SA
#undef PG8_SB
#undef PG8_STAGE
#undef PG8_STAGE_A
#undef PG8_ROWOFF
#undef PG8_LDA
#undef PG8_LDB
#undef PG8_MMA
#undef PG8_WAIT_V
#undef PG8_WAIT_L
#undef PG8_BAR
#undef PG8_SCHED
#undef PG8_ZERO
}
}

#define XB_TMO      128
#define XB_XCNT(j)  (256  + 64 * (j))
#define XB_XSUB(j)  (1280 + 64 * (j))
#define XB_XGEN(j)  (2304 + 64 * (j))
#define XB_TOP      3328
#define XB_TOPGEN   3392
#define XCD_BAR_WORDS 3456
#define XB_SPIN_CAP (1u << 18)
__device__ __forceinline__ unsigned xb_ld(unsigned* p)              { return __hip_atomic_load(p, __ATOMIC_RELAXED, __HIP_MEMORY_SCOPE_AGENT); }
__device__ __forceinline__ unsigned xb_add(unsigned* p, unsigned v) { return __hip_atomic_fetch_add(p, v, __ATOMIC_RELAXED, __HIP_MEMORY_SCOPE_AGENT); }
__device__ __forceinline__ unsigned xb_xcc_id() { return (unsigned)__builtin_amdgcn_s_getreg((3 << 11) | 20) & 0xFu; }
#define XB_SPIN(cond, bar) do { unsigned _sp = 0; while (cond) { __builtin_amdgcn_s_sleep(1); \
    if ((++_sp & 255u) == 0u) { if (xb_ld(&(bar)[XB_TMO])) break; if (_sp > XB_SPIN_CAP) { atomicAdd(&(bar)[XB_TMO], 1u); break; } } } } while (0)
struct XcdBarrier { unsigned* bar; unsigned x; volatile LAS unsigned* st; };
__device__ __forceinline__ XcdBarrier xcd_barrier_post(unsigned* bar, volatile LAS unsigned* st) {
    XcdBarrier b; b.bar = bar; b.x = xb_xcc_id(); b.st = st;
    if (threadIdx.x == 0) (void)xb_add(&bar[XB_XCNT(b.x)], 1u);
    return b;
}
__device__ __forceinline__ void xcd_barrier_complete(unsigned* bar, unsigned x, unsigned& nloc, unsigned& nx) {
    const unsigned G = gridDim.x * gridDim.y * gridDim.z;
    unsigned sum, cnt, mine, sp = 0u;
    for (;;) {
        sum = 0u; cnt = 0u; mine = 0u;
#pragma unroll
        for (unsigned j = 0; j < 16; ++j) { const unsigned c = xb_ld(&bar[XB_XCNT(j)]); sum += c; cnt += (c > 0u) ? 1u : 0u; mine = (j == x) ? c : mine; }
        if (sum == G) break;
        __builtin_amdgcn_s_sleep(1);
        if ((++sp & 255u) == 0u) { if (xb_ld(&bar[XB_TMO])) break; if (sp > XB_SPIN_CAP) { atomicAdd(&bar[XB_TMO], 1u); break; } }
    }
    nloc = mine > 0u ? mine : 1u; nx = cnt > 0u ? cnt : 1u;
}
__device__ __forceinline__ void xcd_barrier(const XcdBarrier& b) {
    asm volatile("s_waitcnt vmcnt(0)" ::: "memory");
    __syncthreads();
    if (threadIdx.x == 0) {
        unsigned* bar = b.bar;
        __builtin_amdgcn_s_waitcnt(0);
        unsigned nloc = b.st[0], nx = b.st[1];
        if (nloc == 0u) { xcd_barrier_complete(bar, b.x, nloc, nx); b.st[0] = nloc; b.st[1] = nx; }
        const unsigned old = xb_add(&bar[XB_XSUB(b.x)], 1u);
        const unsigned gen = old / nloc;
        if (old + 1u == (gen + 1u) * nloc) {
            __builtin_amdgcn_fence(__ATOMIC_RELEASE, "agent");
            asm volatile("s_waitcnt vmcnt(0)" ::: "memory");
            const unsigned og = xb_add(&bar[XB_TOP], 1u);
            const unsigned tg = og / nx;
            if (og + 1u == (tg + 1u) * nx) xb_add(&bar[XB_TOPGEN], 1u);
            else XB_SPIN(xb_ld(&bar[XB_TOPGEN]) == tg, bar);
            __builtin_amdgcn_fence(__ATOMIC_ACQUIRE, "agent");
            xb_add(&bar[XB_XGEN(b.x)], 1u);
            asm volatile("s_waitcnt vmcnt(0)" ::: "memory");
        } else {
            XB_SPIN(xb_ld(&bar[XB_XGEN(b.x)]) == gen, bar);
            __builtin_amdgcn_fence(__ATOMIC_ACQUIRE, "agent");
            asm volatile("s_waitcnt vmcnt(0)" ::: "memory");
        }
    }
    __syncthreads();
}

struct Frame {
    LAS unsigned char* lds;
    unsigned* ctl;
    unsigned char* ws;
    const float* const* in;
    float* out;
    int tid, lane, wave, vcu, G;
};

#ifndef MK_TSB
#define MK_TSB 0
#endif
#ifdef MK_TS
#define TSI(k) do { if ((k) == MK_TS && blockIdx.x == MK_TSB && threadIdx.x == 0) { const unsigned long long t_ = __builtin_amdgcn_s_memrealtime(); ((volatile LAS unsigned*)(F.lds + MISC_OFF))[60] = (unsigned)t_; ((volatile LAS unsigned*)(F.lds + MISC_OFF))[61] = (unsigned)(t_ >> 32); } } while (0)
#else
#define TSI(k) do {} while (0)
#endif
template <bool GU> __device__ __forceinline__ void p0_transpose_item(const float* W, int N, int k0, int n0, bf16_t* dst, int ldk, const float* gain, LAS unsigned char* scr, int lane) {
    constexpr int TP = 264;
#pragma unroll 4
    for (int i = 0; i < 16; ++i) { const int kk = 2 * i + (lane >> 5); f32x4 v = *(const f32x4*)(W + (size_t)(k0 + kk) * N + n0 + 4 * (lane & 31)); if (gain) v = v * gain[k0 + kk];
        u32x2 w; w[0] = pk2(v[0], v[1]); w[1] = pk2(v[2], v[3]); *(LAS u32x2*)(scr + kk * TP + 8 * (lane & 31)) = w; }
    LDS_WAIT(); asm volatile("" ::: "memory");
#pragma unroll 2
    for (int sI = 0; sI < 8; ++sI) { const int n = 16 * sI + (lane >> 2), kc = lane & 3; unsigned short e[8];
#pragma unroll
        for (int q = 0; q < 8; ++q) e[q] = *(const LAS unsigned short*)(scr + (8 * kc + q) * TP + 2 * n);
        u32x4 o; o.x = e[0] | ((unsigned)e[1] << 16); o.y = e[2] | ((unsigned)e[3] << 16); o.z = e[4] | ((unsigned)e[5] << 16); o.w = e[6] | ((unsigned)e[7] << 16);
        const int drow = GU ? ((n >> 7) * 256 + (n & 127)) : n;
        *(GAS u32x4*)(dst + (size_t)drow * ldk + 8 * kc) = o; }
    LDS_WAIT(); asm volatile("" ::: "memory");
}
template <int NR> __device__ __forceinline__ void rms_rows_to_bf16(const float* x, bf16_t* o, float* rms, int row0, int lane) {
    f32x4 v[NR][4];
#pragma unroll
    for (int r = 0; r < NR; ++r) { const GAS f32x4* xr = (const GAS f32x4*)(x + (size_t)(row0 + r) * 1024) + lane;
#pragma unroll
        for (int j = 0; j < 4; ++j) v[r][j] = xr[64 * j]; }
#pragma unroll
    for (int r = 0; r < NR; ++r) { float s = 0.f;
#pragma unroll
        for (int j = 0; j < 4; ++j) s += (v[r][j].x * v[r][j].x + v[r][j].y * v[r][j].y) + (v[r][j].z * v[r][j].z + v[r][j].w * v[r][j].w);
        const float ms = wsum(s) * (1.f / 1024.f) + EPSN; const float rstd = 1.f / sqrtf(ms);
        if (rms && lane == 0) rms[row0 + r] = sqrtf(ms);
        GAS unsigned long long* o8 = (GAS unsigned long long*)(o + (size_t)(row0 + r) * 1024) + lane;
#pragma unroll
        for (int j = 0; j < 4; ++j) o8[64 * j] = (unsigned long long)pk2(v[r][j].x * rstd, v[r][j].y * rstd) | ((unsigned long long)pk2(v[r][j].z * rstd, v[r][j].w * rstd) << 32); }
}
__device__ __forceinline__ void rms2_load(f32x4 (&v)[2][4], const float* x, int row0, int lane) {
#pragma unroll
    for (int r = 0; r < 2; ++r) { const GAS f32x4* xr = (const GAS f32x4*)(x + (size_t)(row0 + r) * 1024) + lane;
#pragma unroll
        for (int j = 0; j < 4; ++j) v[r][j] = xr[64 * j]; }
}
__device__ __forceinline__ void rms2_finish(const f32x4 (&v)[2][4], bf16_t* o, float* rms, int row0, int lane) {
#pragma unroll
    for (int r = 0; r < 2; ++r) { float s = 0.f;
#pragma unroll
        for (int j = 0; j < 4; ++j) s += (v[r][j].x * v[r][j].x + v[r][j].y * v[r][j].y) + (v[r][j].z * v[r][j].z + v[r][j].w * v[r][j].w);
        const float ms = wsum(s) * (1.f / 1024.f) + EPSN; const float rstd = 1.f / sqrtf(ms);
        if (lane == 0) rms[row0 + r] = sqrtf(ms);
        GAS unsigned long long* o8 = (GAS unsigned long long*)(o + (size_t)(row0 + r) * 1024) + lane;
#pragma unroll
        for (int j = 0; j < 4; ++j) o8[64 * j] = (unsigned long long)pk2(v[r][j].x * rstd, v[r][j].y * rstd) | ((unsigned long long)pk2(v[r][j].z * rstd, v[r][j].w * rstd) << 32); }
}
__device__ __forceinline__ void p0_prologue(Frame& F) {
    const int gw = F.vcu * NWAVES + F.wave, NGW = F.G * NWAVES;
    const float* const* in = F.in;
    unsigned char* ws = F.ws;
    int xn_m = 2 * gw;
    {
        LAS float* zs = (LAS float*)(F.lds + 8 * 16384);
        LAS float* a1s = zs + 16 * 34;
        LAS float* a2s = a1s + 16 * 64;
        const float* w1 = in[6]; const float* b1 = in[7]; const float* w2 = in[8]; const float* b2 = in[9]; const float* w3 = in[10]; const float* freq = in[11];
        bf16_t* KF = (bf16_t*)(ws + WS_KF);
        for (int pb = F.vcu; pb < SEQ / 16; pb += F.G) {
            __syncthreads();
            for (int zi = F.tid; zi < 16 * 33; zi += NWAVES * 64) {
                const int p = zi / 33, f = zi % 33, pos = pb * 16 + p;
                const float tt = (float)pos / (float)(SEQ - 1);
                const float w = (2.0f * 3.14159265358979323846f / (float)SEQ) * (float)pos;
                float val;
                if (f == 0) val = tt;
                else { const int j = (f - 1) & 15; const float band = 1e-4f + (float)j * ((15.0f - 1e-4f) / 15.0f); val = (f <= 16) ? cosf(band * w) : sinf(band * w); }
                zs[p * 34 + f] = val;
            }
            __syncthreads();
            {
                LAS float* w1s = (LAS float*)(F.lds); LAS float* w2s = w1s + 33 * 64;
                for (int i = F.tid; i < 33 * 64; i += NWAVES * 64) w1s[i] = w1[i];
                for (int i = F.tid; i < 64 * 64; i += NWAVES * 64) w2s[i] = w2[i];
                __syncthreads();
#pragma unroll
                for (int pp = 0; pp < 2; ++pp) { const int p = F.wave * 2 + pp; float s = b1[F.lane];
#pragma unroll 11
                    for (int i = 0; i < 33; ++i) s += zs[p * 34 + i] * w1s[i * 64 + F.lane];
                    a1s[p * 64 + F.lane] = sinf(freq[F.lane] * s); }
                __syncthreads();
#pragma unroll
                for (int pp = 0; pp < 2; ++pp) { const int p = F.wave * 2 + pp; float s = b2[F.lane];
#pragma unroll 8
                    for (int i = 0; i < 64; ++i) s += a1s[p * 64 + i] * w2s[i * 64 + F.lane];
                    a2s[p * 64 + F.lane] = sinf(freq[64 + F.lane] * s); }
            }
            __syncthreads();
            float acc[16][4];
#pragma unroll
            for (int p = 0; p < 16; ++p)
#pragma unroll
                for (int j = 0; j < 4; ++j) acc[p][j] = 0.f;
            f32x4 nxtw[8];
#pragma unroll
            for (int k = 0; k < 8; ++k) nxtw[k] = *(const f32x4*)(w3 + 4 * (F.tid + 512 * k));
#pragma unroll 1
            for (int fc = 0; fc < 8; ++fc) {
                __syncthreads();
#pragma unroll
                for (int k = 0; k < 8; ++k) *(LAS f32x4*)(F.lds + 16 * (F.tid + 512 * k)) = nxtw[k];
                if (fc < 7) {
#pragma unroll
                    for (int k = 0; k < 8; ++k) nxtw[k] = *(const f32x4*)(w3 + (size_t)(8 * (fc + 1)) * 2048 + 4 * (F.tid + 512 * k)); }
                f32x4 xv[2][4]; const int xm = xn_m; const bool xdo = xm < T;
                if (xdo) { rms2_load(xv, in[0], xm, F.lane); xn_m += 2 * NGW; }
                __syncthreads();
#pragma unroll 2
                for (int f = 0; f < 8; ++f) {
                    float wv[4];
#pragma unroll
                    for (int j = 0; j < 4; ++j) wv[j] = *(const LAS float*)(F.lds + 4 * (f * 2048 + F.tid + 512 * j));
#pragma unroll
                    for (int p = 0; p < 16; ++p) { const float a = a2s[p * 64 + 8 * fc + f];
#pragma unroll
                        for (int j = 0; j < 4; ++j) acc[p][j] += a * wv[j]; }
                }
                if (xdo) rms2_finish(xv, (bf16_t*)(ws + WS_XN), (float*)(ws + WS_RMS0), xm, F.lane);
            }
            const float dlo = logf(1e-2f) / 1.5f, dhi = logf(1e-2f) / 0.3f;
#pragma unroll
            for (int j = 0; j < 4; ++j) {
                const int col = F.tid + 512 * j, o = col >> 10, dir = (col >> 9) & 1, c = col & 511;
                const float delta = fabsf(dlo + (float)c * ((dhi - dlo) / 511.0f));
                bf16_t* kf = KF + ((size_t)o * 512 + c) * 8192 + dir * 4096 + pb * 16;
#pragma unroll
                for (int hh = 0; hh < 2; ++hh) {
                    float v[8];
#pragma unroll
                    for (int p = 0; p < 8; ++p) { const int pos = pb * 16 + hh * 8 + p; v[p] = acc[hh * 8 + p][j] * expf(-((float)pos / (float)(SEQ - 1)) * delta); }
                    if (dir == 1 && pb == 0 && hh == 0) v[0] = acc[0][j - 1];
                    u32x4 w;
#pragma unroll
                    for (int p = 0; p < 4; ++p) w[p] = pk2(v[2 * p], v[2 * p + 1]);
                    *(u32x4*)(kf + hh * 8) = w;
                }
            }
        }
        __syncthreads();
    }
    TSI(20);
    {
        constexpr int I_IN = 32 * 18, I_OUT = 32 * 8, I_Q = 32 * 4, I_OM = 16 * 8;
        constexpr int NITEMS_P0 = I_IN + I_OUT + 3 * I_Q + I_OM;
        LAS unsigned char* scrb = F.lds + F.wave * 16384;
        for (int it = gw; it < NITEMS_P0; it += NGW) {
            int r = it;
            if (r < I_IN) { const int kb = r / 18, nb = r % 18; p0_transpose_item<false>(in[3], DIN, 32 * kb, 128 * nb, (bf16_t*)(ws + WS_WIN) + (size_t)(128 * nb) * 1024 + 32 * kb, 1024, in[2], scrb, F.lane); continue; } r -= I_IN;
            if (r < I_OUT) { const int kb = r / 8, nb = r % 8; const float* gn = (kb < 16) ? in[15] : in[16] - 512; p0_transpose_item<false>(in[17], 1024, 32 * kb, 128 * nb, (bf16_t*)(ws + WS_WOUT) + (size_t)(128 * nb) * 1024 + 32 * kb, 1024, gn, scrb, F.lane); continue; } r -= I_OUT;
            if (r < I_Q) { const int kb = r / 4, nb = r % 4; p0_transpose_item<false>(in[20], 512, 32 * kb, 128 * nb, (bf16_t*)(ws + WS_WQM) + (size_t)(128 * nb) * 1024 + 32 * kb, 1024, in[18], scrb, F.lane); continue; } r -= I_Q;
            if (r < I_Q) { const int kb = r / 4, nb = r % 4; p0_transpose_item<false>(in[21], 512, 32 * kb, 128 * nb, (bf16_t*)(ws + WS_WKV) + (size_t)(128 * nb) * 1024 + 32 * kb, 1024, in[19], scrb, F.lane); continue; } r -= I_Q;
            if (r < I_Q) { const int kb = r / 4, nb = r % 4; p0_transpose_item<false>(in[22], 512, 32 * kb, 128 * nb, (bf16_t*)(ws + WS_WKV) + (size_t)(512 + 128 * nb) * 1024 + 32 * kb, 1024, in[19], scrb, F.lane); continue; } r -= I_Q;
            if (r < I_OM) { const int kb = r / 8, nb = r % 8; p0_transpose_item<false>(in[25], 1024, 32 * kb, 128 * nb, (bf16_t*)(ws + WS_WOM) + (size_t)(128 * nb) * 512 + 32 * kb, 512, nullptr, scrb, F.lane); continue; } r -= I_OM;
        }
    }
    TSI(21);
    {
        float* WR = (float*)(ws + WS_WR);
        for (int i = (F.vcu * NWAVES * 64) + F.tid; i < 20 * 1024; i += F.G * NWAVES * 64) { const int j = i >> 10, k = i & 1023;
            WR[i] = (j < 4 ? in[27][k * 4 + j] : in[29][k * 16 + (j - 4)]) * in[26][k]; }
    }
    {
        float* rope = (float*)(ws + WS_ROPE);
        for (int i = (F.vcu * NWAVES * 64) + F.tid; i < 1024; i += F.G * NWAVES * 64) { const float ang = (float)(i >> 4) * powf(10000.0f, -(float)(i & 15) / 16.0f); rope[i] = cosf(ang); rope[1024 + i] = sinf(ang); }
    }
    for (int m = xn_m; m < T; m += 2 * NGW) rms_rows_to_bf16<2>(in[0], (bf16_t*)(ws + WS_XN), (float*)(ws + WS_RMS0), m, F.lane);
    for (int m = gw; m < NMEMT; m += NGW) rms_rows_to_bf16<1>(in[1], (bf16_t*)(ws + WS_MEMN), nullptr, m, F.lane);
}

struct P1Sched {
    int G, vcu; const char *win, *xn, *memn, *wkv;
    __device__ __forceinline__ bool next(int i, pg8::Unit& u) const {
        int L = i * G + vcu; constexpr size_t TILE = (size_t)256 * 1024 * 2;
        if (L < 768) { u.pm = L % 6; u.pn = L / 6; u.A = win + (size_t)u.pm * TILE; u.B = xn + (size_t)u.pn * TILE; u.aux = 0; }
        else if (L < 1152) { L -= 768; u.pn = L % 3; u.pm = L / 3; u.A = xn + (size_t)u.pm * TILE; u.B = win + (size_t)(6 + u.pn) * TILE; u.aux = 1; }
        else if (L < 1184) { L -= 1152; u.pn = L % 4; u.pm = L / 4; u.A = memn + (size_t)u.pm * TILE; u.B = wkv + (size_t)u.pn * TILE; u.aux = 2; }
        else return false;
        u.flags = 3; u.kt = 16; return true;
    }
};
__device__ __forceinline__ void store_tile_bf16(const f32x4 (&acc)[2][2][4][2], bf16_t* base, int ld, int row0, int col0) {
#pragma unroll
    for (int ai = 0; ai < 2; ++ai)
#pragma unroll
        for (int m = 0; m < 4; ++m) { bf16_t* rowp = base + (size_t)(row0 + ai * 128 + m * 16) * ld + col0;
#pragma unroll
            for (int bj = 0; bj < 2; ++bj) { const f32x4 v0 = acc[ai][bj][m][0], v1 = acc[ai][bj][m][1];
                u32x4 w; w.x = pg8::cvt_pk_bf16(v0[0], v0[1]); w.y = pg8::cvt_pk_bf16(v0[2], v0[3]); w.z = pg8::cvt_pk_bf16(v1[0], v1[1]); w.w = pg8::cvt_pk_bf16(v1[2], v1[3]);
                *(u32x4*)(rowp + bj * 128) = w; } }
}
struct EpiBf16Multi {
    unsigned char* ws;
    __device__ __forceinline__ void operator()(const f32x4 (&acc)[2][2][4][2], const pg8::Unit& u, int wr, int wc, int fr, int fq) const {
        const int row0 = u.pm * 256 + wr * 64 + fr, col0 = u.pn * 256 + wc * 32 + 8 * fq;
        if (u.aux == 0) store_tile_bf16(acc, (bf16_t*)(ws + WS_UHT), T, row0, col0);
        else if (u.aux == 1) store_tile_bf16(acc, (bf16_t*)(ws + WS_QKV), 768, row0, col0);
        else store_tile_bf16(acc, (bf16_t*)(ws + WS_KVM), 1024, row0, col0);
    }
};


__device__ __forceinline__ void kprep_tile(Frame& F, int pm) {
    bf16_t* QKV = (bf16_t*)(F.ws + WS_QKV); const float* rope = (const float*)(F.ws + WS_ROPE); const float* gk = F.in[14];
    const int row = pm * 256 + (F.tid >> 1), kh = F.tid & 1; const int t = row & (SEQ - 1);
    bf16_t* p = QKV + (size_t)row * 768 + 512 + kh * 64;
    u32x4 w[8]; float v[64]; float ss = 0.f;
#pragma unroll
    for (int k = 0; k < 8; ++k) w[k] = *(const u32x4*)(p + 8 * k);
#pragma unroll
    for (int k = 0; k < 8; ++k)
#pragma unroll
        for (int j = 0; j < 4; ++j) { v[8 * k + 2 * j] = bflo(w[k][j]); v[8 * k + 2 * j + 1] = bfhi(w[k][j]); ss += v[8 * k + 2 * j] * v[8 * k + 2 * j] + v[8 * k + 2 * j + 1] * v[8 * k + 2 * j + 1]; }
    const float rstd = 1.0f / sqrtf(ss * (1.0f / 64.0f) + EPSN);
#pragma unroll
    for (int d = 0; d < 64; ++d) v[d] *= rstd * gk[d];
#pragma unroll
    for (int sec = 0; sec < 2; ++sec) { const int pos = sec ? (t & 63) : (t >> 6);
#pragma unroll
        for (int i = 0; i < 16; ++i) { const float c = rope[pos * 16 + i], sn = rope[1024 + pos * 16 + i]; const float x1 = v[32 * sec + i], x2 = v[32 * sec + 16 + i];
            v[32 * sec + i] = x1 * c - x2 * sn; v[32 * sec + 16 + i] = x2 * c + x1 * sn; } }
#pragma unroll
    for (int k = 0; k < 8; ++k) { u32x4 o;
#pragma unroll
        for (int j = 0; j < 4; ++j) o[j] = pk2(v[8 * k + 2 * j], v[8 * k + 2 * j + 1]);
        *(u32x4*)(p + 8 * k) = o; }
}
__device__ __forceinline__ void kmem_norm_tile(Frame& F, int pm, int pn) {
    bf16_t* KVM = (bf16_t*)(F.ws + WS_KVM); const float* g = F.in[24];
    const int row = pm * 256 + (F.tid >> 1), hh = F.tid & 1;
    bf16_t* p = KVM + (size_t)row * 1024 + pn * 256 + hh * 128;
    u32x4 w[16]; float ss = 0.f;
#pragma unroll
    for (int k = 0; k < 16; ++k) w[k] = *(const u32x4*)(p + 8 * k);
#pragma unroll
    for (int k = 0; k < 16; ++k)
#pragma unroll
        for (int j = 0; j < 4; ++j) { const float a = bflo(w[k][j]), b2 = bfhi(w[k][j]); ss += a * a + b2 * b2; }
    const float rstd = 1.0f / sqrtf(ss * (1.0f / 128.0f) + EPSN);
#pragma unroll
    for (int k = 0; k < 16; ++k) { u32x4 o;
#pragma unroll
        for (int j = 0; j < 4; ++j) o[j] = pk2(bflo(w[k][j]) * rstd * g[8 * k + 2 * j], bfhi(w[k][j]) * rstd * g[8 * k + 2 * j + 1]);
        *(u32x4*)(p + 8 * k) = o; }
}

namespace at {
constexpr int D = 64, PQ = 768, PO = 1024;
constexpr int NW = 8, QBLK = 32, QB = QBLK * NW, KVBLK = 64;
__device__ __forceinline__ int crow(int r, int hi) { return (r & 3) + 8 * (r >> 2) + 4 * hi; }
#define SBAR() __builtin_amdgcn_sched_barrier(0)
constexpr int NSLOT = 3, SLOTB = 8192;
constexpr int LDS_K = 0, LDS_V = NSLOT * SLOTB, LDS_WS = 2 * NSLOT * SLOTB, LDS_OST = LDS_WS + NW * 64 * 4, LDS_BYTES_AT = LDS_OST + NW * 4096;
constexpr float C2 = 0.125f * 1.4426950408889634f;
__device__ __forceinline__ void glds16(const void* gsrc, unsigned lds_dst) { unsigned keep;
    asm volatile("s_mov_b32 %0, m0\n\ts_mov_b32 m0, %2\n\ts_nop 0\n\tglobal_load_lds_dwordx4 %1, off\n\ts_mov_b32 m0, %0" : "=&s"(keep) : "v"(gsrc), "s"(lds_dst) : "memory"); }
__device__ __forceinline__ float max3f(float a, float b, float c) { float r; asm("v_max3_f32 %0, %1, %2, %3" : "=v"(r) : "v"(a), "v"(b), "v"(c)); return r; }
__device__ __forceinline__ float max2f(float a, float b) { float r; asm("v_max_f32_e32 %0, %1, %2" : "=v"(r) : "v"(a), "v"(b)); return r; }
__device__ __forceinline__ float fadd_s(float a, float b) { float r; asm("v_add_f32_e32 %0, %1, %2" : "=v"(r) : "v"(a), "v"(b)); return r; }
__device__ __forceinline__ float fsub_s(float a, float b) { float r; asm("v_sub_f32_e32 %0, %1, %2" : "=v"(r) : "v"(a), "v"(b)); return r; }
typedef __bf16 bf16x2_t __attribute__((ext_vector_type(2)));
__device__ __forceinline__ unsigned cvtpk_s(float lo, float hi) { f32x2 v = {lo, hi}; bf16x2_t b = __builtin_convertvector(v, bf16x2_t); return __builtin_bit_cast(unsigned, b); }
#define WAIT_BAR(N) asm volatile("s_waitcnt vmcnt(" #N ") lgkmcnt(0)\n\ts_barrier" ::: "memory")
__device__ __forceinline__ void qkt(f32x16& p0, f32x16& p1, const char* Kslot, const bf16x8* qr, const f32x16& negm, int r32, int hi) {
    const char* kb = Kslot + hi * 1024 + r32 * 16;
#pragma unroll
    for (int d0 = 0; d0 < 4; ++d0) {
        const bf16x8 b0 = *reinterpret_cast<const bf16x8*>(kb + d0 * 2048);
        const bf16x8 b1 = *reinterpret_cast<const bf16x8*>(kb + d0 * 2048 + 512);
        if (d0 == 0) { p0 = __builtin_amdgcn_mfma_f32_32x32x16_bf16(b0, qr[0], negm, 0, 0, 0); p1 = __builtin_amdgcn_mfma_f32_32x32x16_bf16(b1, qr[0], negm, 0, 0, 0); }
        else { p0 = __builtin_amdgcn_mfma_f32_32x32x16_bf16(b0, qr[d0], p0, 0, 0, 0); p1 = __builtin_amdgcn_mfma_f32_32x32x16_bf16(b1, qr[d0], p1, 0, 0, 0); } }
}
typedef LAS const char* lds_cptr;
typedef short v4i16_t __attribute__((ext_vector_type(4)));
__device__ __forceinline__ void kload8(bf16x8* kf, lds_cptr kp) {
    kf[0] = *(const LAS bf16x8*)(kp);        kf[1] = *(const LAS bf16x8*)(kp + 512);
    kf[2] = *(const LAS bf16x8*)(kp + 2048); kf[3] = *(const LAS bf16x8*)(kp + 2560);
    kf[4] = *(const LAS bf16x8*)(kp + 4096); kf[5] = *(const LAS bf16x8*)(kp + 4608);
    kf[6] = *(const LAS bf16x8*)(kp + 6144); kf[7] = *(const LAS bf16x8*)(kp + 6656);
}
__device__ __forceinline__ void kload2(bf16x8* kf, lds_cptr kp, int j) { kf[2 * j] = *(const LAS bf16x8*)(kp + j * 2048); kf[2 * j + 1] = *(const LAS bf16x8*)(kp + j * 2048 + 512); }
__device__ __forceinline__ s16x4 vtr(lds_cptr p) { return __builtin_bit_cast(s16x4, __builtin_amdgcn_ds_read_tr16_b64_v4i16((LAS v4i16_t*)p)); }
__device__ __forceinline__ float rowmax(const f32x16& p0, const f32x16& p1) {
    float a = max3f(p0[0], p0[1], p1[0]), b = max3f(p0[2], p0[3], p1[1]); a = max3f(a, p1[2], p1[3]);
#pragma unroll
    for (int r = 4; r < 16; r += 4) { a = max3f(a, p0[r], p0[r + 1]); b = max3f(b, p0[r + 2], p0[r + 3]); a = max3f(a, p1[r], p1[r + 1]); b = max3f(b, p1[r + 2], p1[r + 3]); }
    const float m = max2f(a, b);
    auto rr = __builtin_amdgcn_permlane32_swap(__float_as_uint(m), __float_as_uint(m), false, false);
    return max2f(__uint_as_float(rr[0]), __uint_as_float(rr[1]));
}
__device__ __forceinline__ void pv(f32x16* o, int vb, bf16x8 pa0, bf16x8 pa1, bf16x8 pa2, bf16x8 pa3) {
#pragma unroll
    for (int d0 = 0; d0 < 2; ++d0) { s16x4 lo[4], hi[4];
#pragma unroll
        for (int ks = 0; ks < 4; ++ks) {
            asm volatile("ds_read_b64_tr_b16 %0,%1 offset:%c2" : "=&v"(lo[ks]) : "v"(vb), "i"(d0 * 4096 + ks * 1024) : "memory");
            asm volatile("ds_read_b64_tr_b16 %0,%1 offset:%c2" : "=&v"(hi[ks]) : "v"(vb), "i"(d0 * 4096 + ks * 1024 + 512) : "memory"); }
        asm volatile("s_waitcnt lgkmcnt(0)" ::: "memory"); SBAR();
#define PK(k) (bf16x8){lo[k][0], lo[k][1], lo[k][2], lo[k][3], hi[k][0], hi[k][1], hi[k][2], hi[k][3]}
        o[d0] = __builtin_amdgcn_mfma_f32_32x32x16_bf16(pa0, PK(0), o[d0], 0, 0, 0);
        o[d0] = __builtin_amdgcn_mfma_f32_32x32x16_bf16(pa1, PK(1), o[d0], 0, 0, 0);
        o[d0] = __builtin_amdgcn_mfma_f32_32x32x16_bf16(pa2, PK(2), o[d0], 0, 0, 0);
        o[d0] = __builtin_amdgcn_mfma_f32_32x32x16_bf16(pa3, PK(3), o[d0], 0, 0, 0);
#undef PK
    }
}
template <int THRL> __device__ __forceinline__ void attn_unit(int b, int h, int qb, const bf16_t* QKV, bf16_t* Y, const float* gq, const float* gk, const float* rope, char* shm) {
    const int tid = threadIdx.x, lane = tid & 63, r32 = lane & 31, hi = lane >> 5; const int wid = __builtin_amdgcn_readfirstlane(tid >> 6);
    const long rowbase = (long)b * SEQ; const int q0 = qb * QB; const int kvh = h >> 2;
    const bf16_t* Qw = QKV + (rowbase + q0 + wid * QBLK) * PQ + h * D;
    const bf16_t* Kh = QKV + rowbase * PQ + 512 + kvh * D; const bf16_t* Vh = QKV + rowbase * PQ + 640 + kvh * D;
    const unsigned lds0 = (unsigned)(uintptr_t)shm;
    float* wsf = (float*)(shm + LDS_WS) + wid * 64;
    const bf16_t* ksrc = Kh + (long)lane * PQ + wid * 8;
    const bf16_t* vsrc = Vh + (long)(16 * (wid & 3) + (lane >> 2)) * PQ + (wid >> 2) * 32 + (lane & 3) * 8;
    const unsigned kdst = lds0 + LDS_K + wid * 1024, vdst = lds0 + LDS_V + wid * 1024;
#define DMA_K(t, slot) glds16(ksrc + (long)(t) * KVBLK * PQ, (unsigned)__builtin_amdgcn_readfirstlane(kdst + (slot)))
#define DMA_V(t, slot) glds16(vsrc + (long)(t) * KVBLK * PQ, (unsigned)__builtin_amdgcn_readfirstlane(vdst + (slot)))
    const int vb0 = (int)(lds0 + LDS_V) + ((lane >> 4) & 1) * 32 + (lane & 3) * 8 + (4 * hi + ((lane & 15) >> 2)) * 64;
    const char* Kbase = shm + LDS_K; bf16x8 kf[8];
    const lds_cptr shm3 = (lds_cptr)shm; const lds_cptr kp0 = shm3 + LDS_K + hi * 1024 + r32 * 16; const lds_cptr vp0 = shm3 + LDS_V + ((lane >> 4) & 1) * 32 + (lane & 3) * 8 + (4 * hi + ((lane & 15) >> 2)) * 64;
    constexpr int NT = SEQ / KVBLK;
    DMA_K(0, 0); DMA_V(0, 0); DMA_K(1, SLOTB);
    bf16x8 qr[4];
    {
        float qf[4][8]; float ss = 0.f;
#pragma unroll
        for (int d0 = 0; d0 < 4; ++d0) { const u32x4 w = *reinterpret_cast<const u32x4*>(&Qw[(long)r32 * PQ + d0 * 16 + hi * 8]);
#pragma unroll
            for (int j = 0; j < 4; ++j) { qf[d0][2 * j] = bflo(w[j]); qf[d0][2 * j + 1] = bfhi(w[j]); }
#pragma unroll
            for (int j = 0; j < 8; ++j) ss += qf[d0][j] * qf[d0][j]; }
        ss += __shfl_xor(ss, 32);
        const float rstd = C2 / sqrtf(ss * (1.0f / 64.0f) + EPSN);
#pragma unroll
        for (int d0 = 0; d0 < 4; ++d0) { const f32x4 g0 = *(const f32x4*)(gq + d0 * 16 + hi * 8), g1 = *(const f32x4*)(gq + d0 * 16 + hi * 8 + 4);
#pragma unroll
            for (int j = 0; j < 4; ++j) { qf[d0][j] *= rstd * g0[j]; qf[d0][4 + j] *= rstd * g1[j]; } }
        const int tq = q0 + wid * QBLK + r32;
#pragma unroll
        for (int sec = 0; sec < 2; ++sec) { const int pos = sec ? (tq & 63) : (tq >> 6);
            const f32x4 c0 = *(const f32x4*)(rope + pos * 16 + hi * 8), c1 = *(const f32x4*)(rope + pos * 16 + hi * 8 + 4);
            const f32x4 s0 = *(const f32x4*)(rope + 1024 + pos * 16 + hi * 8), s1 = *(const f32x4*)(rope + 1024 + pos * 16 + hi * 8 + 4);
#pragma unroll
            for (int j = 0; j < 8; ++j) { const float c = j < 4 ? c0[j & 3] : c1[j & 3], sn = j < 4 ? s0[j & 3] : s1[j & 3];
                const float x1 = qf[2 * sec][j], x2 = qf[2 * sec + 1][j];
                qf[2 * sec][j] = x1 * c - x2 * sn; qf[2 * sec + 1][j] = x2 * c + x1 * sn; } }
#pragma unroll
        for (int d0 = 0; d0 < 4; ++d0) { u32x4 w;
#pragma unroll
            for (int j = 0; j < 4; ++j) w[j] = cvtpk_s(qf[d0][2 * j], qf[d0][2 * j + 1]);
            qr[d0] = __builtin_bit_cast(bf16x8, w); }
    }
    float l_reg = 0.f; f32x16 o[2]; o[0] = f32x16{}; o[1] = f32x16{}; const f32x16 negm = f32x16{};

#define START(P0, P1) do { _Pragma("unroll") for (int r = 0; r < 16; ++r) P0[r] = __builtin_amdgcn_exp2f(P0[r]); } while (0)
#define RESC() do {} while (0)
    f32x16 pA0, pA1, pB0, pB1;
    int sl_prev = 0, sl_cur = 0, sl_next = SLOTB;
#define ROT() do { sl_prev = sl_cur; sl_cur = sl_next; sl_next = (sl_next == (NSLOT - 1) * SLOTB) ? 0 : sl_next + SLOTB; } while (0)
    DMA_K(2, 2 * SLOTB);
    WAIT_BAR(3);
    qkt(pA0, pA1, Kbase, qr, negm, r32, hi); asm volatile("s_nop 15\n\ts_nop 7" : "+v"(pA0), "+v"(pA1));
    START(pA0, pA1);
    _Pragma("unroll") for (int r = 0; r < 16; ++r) pA1[r] = __builtin_amdgcn_exp2f(pA1[r]);
    WAIT_BAR(0);
    DMA_K(3, 0); DMA_V(1, SLOTB);
    ROT();
    kload8(kf, kp0 + sl_cur);
    WAIT_BAR(2);
    s16x4 vlo[8], vhi[8]; u32x4 pw0, pw1, pw2, pw3;
#define PKW(P, B) cvtpk_s(P[B], P[B + 1])
#define PAF(k) __builtin_bit_cast(bf16x8, pw##k)
#define VFR(i) (bf16x8){vlo[i][0], vlo[i][1], vlo[i][2], vlo[i][3], vhi[i][0], vhi[i][1], vhi[i][2], vhi[i][3]}
#define PIN(x) asm volatile("" : "+v"(x))
#define MX3(a, b, c) __builtin_fmaxf(__builtin_fmaxf((a), (b)), (c))
#define GAPA(MF, A0, A1, A2, A3, W0, W1, PW) do { MF; sacc += A0; sacc += A1; sacc += A2; sacc += A3; PIN(sacc); W0; W1; PIN(PW); SBAR(); } while (0)
#define EX(v) __builtin_amdgcn_exp2f(v)
#define GAPB(MF, X, B) do { MF; X[B] = EX(X[B]); X[B + 1] = EX(X[B + 1]); X[B + 2] = EX(X[B + 2]); X[B + 3] = EX(X[B + 3]); PIN(X); SBAR(); } while (0)
#define VRD(i) do { vlo[i] = vtr(vp_ + (((i) >> 2) * 4096 + ((i) & 3) * 1024)); vhi[i] = vtr(vp_ + (((i) >> 2) * 4096 + ((i) & 3) * 1024 + 512)); } while (0)
#define KRD(G, j) do { if (G) { kload2(kf, kp0 + sl_next, j); SBAR(); } } while (0)
#define STEP(C0, C1, P0, P1, t, GK, GV, GL) do { SBAR(); \
    const lds_cptr vp_ = vp0 + sl_prev; \
    VRD(0); SBAR(); float sacc = (P0[0] + P0[1]); \
    GAPA(C0 = __builtin_amdgcn_mfma_f32_32x32x16_bf16(kf[0], qr[0], negm, 0, 0, 0), P0[2], P0[3], P0[4], P0[5],     pw0[0] = PKW(P0, 0), pw0[1] = PKW(P0, 2), pw0); \
    VRD(4); SBAR(); GAPA(C1 = __builtin_amdgcn_mfma_f32_32x32x16_bf16(kf[1], qr[0], negm, 0, 0, 0), P0[6], P0[7], P0[8], P0[9],     pw0[2] = PKW(P0, 4), pw0[3] = PKW(P0, 6), pw0); \
    VRD(1); SBAR(); GAPA(C0 = __builtin_amdgcn_mfma_f32_32x32x16_bf16(kf[2], qr[1], C0, 0, 0, 0),   P0[10], P0[11], P0[12], P0[13], pw1[0] = PKW(P0, 8), pw1[1] = PKW(P0, 10), pw1); \
    VRD(5); SBAR(); GAPA(C1 = __builtin_amdgcn_mfma_f32_32x32x16_bf16(kf[3], qr[1], C1, 0, 0, 0),   P0[14], P0[15], P1[0], P1[1],   pw1[2] = PKW(P0, 12), pw1[3] = PKW(P0, 14), pw1); \
    VRD(2); SBAR(); GAPA(C0 = __builtin_amdgcn_mfma_f32_32x32x16_bf16(kf[4], qr[2], C0, 0, 0, 0),   P1[2], P1[3], P1[4], P1[5],     pw2[0] = PKW(P1, 0), pw2[1] = PKW(P1, 2), pw2); \
    VRD(6); SBAR(); GAPA(C1 = __builtin_amdgcn_mfma_f32_32x32x16_bf16(kf[5], qr[2], C1, 0, 0, 0),   P1[6], P1[7], P1[8], P1[9],     pw2[2] = PKW(P1, 4), pw2[3] = PKW(P1, 6), pw2); \
    VRD(3); SBAR(); GAPA(C0 = __builtin_amdgcn_mfma_f32_32x32x16_bf16(kf[6], qr[3], C0, 0, 0, 0),   P1[10], P1[11], P1[12], P1[13], pw3[0] = PKW(P1, 8), pw3[1] = PKW(P1, 10), pw3); \
    VRD(7); SBAR(); GAPA(C1 = __builtin_amdgcn_mfma_f32_32x32x16_bf16(kf[7], qr[3], C1, 0, 0, 0),   P1[14], P1[15], 0.f, 0.f,       pw3[2] = PKW(P1, 12), pw3[3] = PKW(P1, 14), pw3); \
    l_reg += sacc; \
    if (GK) { DMA_K((t) + 3, sl_cur); } if (GV) { DMA_V((t) + 1, sl_next); } \
    SBAR(); \
    GAPB(o[0] = __builtin_amdgcn_mfma_f32_32x32x16_bf16(PAF(0), VFR(0), o[0], 0, 0, 0), C0, 0); \
    GAPB(o[1] = __builtin_amdgcn_mfma_f32_32x32x16_bf16(PAF(0), VFR(4), o[1], 0, 0, 0), C0, 4); \
    KRD(GL, 0); GAPB(o[0] = __builtin_amdgcn_mfma_f32_32x32x16_bf16(PAF(1), VFR(1), o[0], 0, 0, 0), C0, 8); \
    KRD(GL, 1); GAPB(o[1] = __builtin_amdgcn_mfma_f32_32x32x16_bf16(PAF(1), VFR(5), o[1], 0, 0, 0), C0, 12); \
    KRD(GL, 2); GAPB(o[0] = __builtin_amdgcn_mfma_f32_32x32x16_bf16(PAF(2), VFR(2), o[0], 0, 0, 0), C1, 0); \
    KRD(GL, 3); GAPB(o[1] = __builtin_amdgcn_mfma_f32_32x32x16_bf16(PAF(2), VFR(6), o[1], 0, 0, 0), C1, 4); \
    GAPB(o[0] = __builtin_amdgcn_mfma_f32_32x32x16_bf16(PAF(3), VFR(3), o[0], 0, 0, 0), C1, 8); \
    GAPB(o[1] = __builtin_amdgcn_mfma_f32_32x32x16_bf16(PAF(3), VFR(7), o[1], 0, 0, 0), C1, 12); \
    } while (0)
    int t = 1;
    for (; t + 5 < NT; t += 2) {
        STEP(pB0, pB1, pA0, pA1, t, true, true, true);     WAIT_BAR(2); RESC(); ROT();
        STEP(pA0, pA1, pB0, pB1, t + 1, true, true, true); WAIT_BAR(2); RESC(); ROT();
    }
#define ENDW(tt) do { if ((tt) + 3 < NT) { WAIT_BAR(2); } else if ((tt) + 2 < NT) { WAIT_BAR(1); } else { WAIT_BAR(0); } } while (0)
    for (; t + 1 < NT; t += 2) {
        STEP(pB0, pB1, pA0, pA1, t, (t + 3 < NT), (t + 1 < NT), (t + 1 < NT));         ENDW(t);     RESC(); ROT();
        STEP(pA0, pA1, pB0, pB1, t + 1, (t + 4 < NT), (t + 2 < NT), (t + 2 < NT));     ENDW(t + 1); RESC(); ROT();
    }
    STEP(pB0, pB1, pA0, pA1, NT - 1, false, false, false); RESC();
    { float sacc = pB0[0] + pB0[1]; _Pragma("unroll") for (int r = 2; r < 16; ++r) sacc += pB0[r]; _Pragma("unroll") for (int r = 0; r < 16; ++r) sacc += pB1[r]; l_reg += sacc;
      pw0 = (u32x4){PKW(pB0, 0), PKW(pB0, 2), PKW(pB0, 4), PKW(pB0, 6)}; pw1 = (u32x4){PKW(pB0, 8), PKW(pB0, 10), PKW(pB0, 12), PKW(pB0, 14)}; pw2 = (u32x4){PKW(pB1, 0), PKW(pB1, 2), PKW(pB1, 4), PKW(pB1, 6)}; pw3 = (u32x4){PKW(pB1, 8), PKW(pB1, 10), PKW(pB1, 12), PKW(pB1, 14)};
      SBAR(); pv(o, vb0 + sl_cur, PAF(0), PAF(1), PAF(2), PAF(3)); }
#undef PKW
#undef PAF
#undef VFR
#undef PIN
#undef MX3
#undef GAPA
#undef GAPB
#undef EX
#undef VRD
#undef KRD
#undef STEP
#undef ENDW
    { auto rr = __builtin_amdgcn_permlane32_swap(__float_as_uint(l_reg), __float_as_uint(l_reg), false, false); l_reg = __uint_as_float(rr[0]) + __uint_as_float(rr[1]); }
    if (hi == 0) wsf[32 + r32] = l_reg; asm volatile("s_waitcnt lgkmcnt(0)" ::: "memory");
    float rli[16];
#pragma unroll
    for (int r = 0; r < 16; ++r) rli[r] = __builtin_amdgcn_rcpf(wsf[32 + crow(r, hi)]);
    bf16_t* Ow = Y + (rowbase + q0 + wid * QBLK) * PO + 512 + h * D;
    { bf16_t* stg = (bf16_t*)(shm + LDS_OST) + wid * 2048;
#pragma unroll
      for (int r = 0; r < 16; ++r) { const int orow = crow(r, hi);
#pragma unroll
        for (int d0 = 0; d0 < 2; ++d0) stg[orow * 64 + d0 * 32 + r32] = (bf16_t)f2bf(o[d0][r] * rli[r]); }
      asm volatile("s_waitcnt lgkmcnt(0)" ::: "memory");
#pragma unroll
      for (int i = 0; i < 4; ++i) { const int row = i * 8 + (lane >> 3), ch = lane & 7; const u32x4 v = *(const u32x4*)(stg + row * 64 + ch * 8);
        float f[8]; float ss = 0.f;
#pragma unroll
        for (int j = 0; j < 4; ++j) { f[2 * j] = bflo(v[j]); f[2 * j + 1] = bfhi(v[j]); ss += f[2 * j] * f[2 * j] + f[2 * j + 1] * f[2 * j + 1]; }
        ss += __shfl_xor(ss, 1); ss += __shfl_xor(ss, 2); ss += __shfl_xor(ss, 4);
        const float rs = 1.0f / sqrtf(ss * (1.0f / 64.0f) + EPSN);
        u32x4 w;
#pragma unroll
        for (int j = 0; j < 4; ++j) w[j] = pk2(f[2 * j] * rs, f[2 * j + 1] * rs);
        *(u32x4*)(Ow + (long)row * PO + ch * 8) = w; } }
    asm volatile("s_waitcnt lgkmcnt(0)\n\ts_barrier" ::: "memory");
#undef DMA_K
#undef DMA_V
#undef START
#undef RESC
#undef ROT
}
#undef SBAR
#undef WAIT_BAR
}

namespace bgtr {
constexpr int NIT = 16 * 3 * 1024;
constexpr int SCR = 115200, SCRW = 2560;
struct State { int it, pend; };
struct Desc { const float* W; const float* gain; bf16_t* dst; int N, k0, n0; };
__device__ __forceinline__ Desc desc(int it, const float* const* in, unsigned char* ws) {
    const int e = it / 3072, r = it % 3072, mat = r >> 10, q = r & 1023; Desc d;
    if (mat < 2) { const int kb = q >> 4, nb = q & 15; d.k0 = 16 * kb; d.n0 = 32 * nb; d.N = 512; d.W = in[mat ? 32 : 31] + (size_t)e * 1024 * 512; d.gain = in[26];
        d.dst = (bf16_t*)(ws + WS_WGU) + ((size_t)e * 1024 + 256 * (d.n0 >> 7) + (d.n0 & 127) + 128 * mat) * 1024 + d.k0; }
    else { const int kb = q >> 5, nb = q & 31; d.k0 = 16 * kb; d.n0 = 32 * nb; d.N = 1024; d.W = in[33] + (size_t)e * 512 * 1024; d.gain = nullptr;
        d.dst = (bf16_t*)(ws + WS_WD) + ((size_t)e * 1024 + d.n0) * 1024 + d.k0; }
    return d;
}
__device__ __forceinline__ void glds16(const void* gsrc, unsigned lds_dst) { unsigned keep;
    asm volatile("s_mov_b32 %0, m0\n\ts_mov_b32 m0, %2\n\ts_nop 0\n\tglobal_load_lds_dwordx4 %1, off\n\ts_mov_b32 m0, %0" : "=&s"(keep) : "v"(gsrc), "s"(lds_dst) : "memory"); }
__device__ __forceinline__ void glds4(const void* gsrc, unsigned lds_dst) { unsigned keep;
    asm volatile("s_mov_b32 %0, m0\n\ts_mov_b32 m0, %2\n\ts_nop 0\n\tglobal_load_lds_dword %1, off\n\ts_mov_b32 m0, %0" : "=&s"(keep) : "v"(gsrc), "s"(lds_dst) : "memory"); }
__device__ __forceinline__ void step(State& S, int stride, const float* const* in, unsigned char* ws, LAS unsigned char* lds, unsigned tile, int lane) {
    asm volatile("" : "+v"(lane));
    if (S.pend) { const Desc d = desc(S.it, in, ws); const int n = lane & 31, kh = lane >> 5;
        asm volatile("s_waitcnt vmcnt(0)" ::: "memory");
        u32x4 o;
#pragma unroll
        for (int h = 0; h < 2; ++h) { float x[4];
#pragma unroll
            for (int j = 0; j < 4; ++j) x[j] = *(const LAS float*)(lds + tile + kh * 1152 + (4 * h + j) * 128 + 4 * n);
            if (d.gain) { const f32x4 g0 = *(const LAS f32x4*)(lds + tile + 2304 + 16 * (2 * kh + h));
#pragma unroll
                for (int j = 0; j < 4; ++j) x[j] *= g0[j]; }
            o[2 * h] = pg8::cvt_pk_bf16(x[0], x[1]); o[2 * h + 1] = pg8::cvt_pk_bf16(x[2], x[3]); }
        *(GAS u32x4*)(d.dst + (size_t)n * 1024 + 8 * kh) = o;
        S.it += stride; }
    if (S.it < NIT) { const Desc d = desc(S.it, in, ws);
        const float* g = d.W + (size_t)(d.k0 + (lane >> 3)) * d.N + d.n0 + 4 * (lane & 7);
        asm volatile("s_waitcnt lgkmcnt(0)" ::: "memory");
        glds16(g, tile); glds16(g + (size_t)8 * d.N, tile + 1152u);
        if (d.gain) glds4(d.gain + d.k0 + (lane & 15), tile + 2304u);
        S.pend = 1; }
    else S.pend = 0;
}
}

namespace hy {
constexpr int PADT = 512, ZT = SEQ + 2 * PADT, SB = ZT * 2 + 32;
constexpr int LZ = 0, LF0 = 8 * SB, LF1 = LF0 + 16384 + 68, LRED = LF1 + 16384 + 12, LEND = LRED + 64;
static_assert(LEND <= bgtr::SCR && bgtr::SCR + 8 * bgtr::SCRW <= MISC_OFF, "hyena + background-transposer LDS map");
static_assert(LF0 % 16 == 0 && LEND <= RING_BYTES, "hyena LDS map");
__device__ __forceinline__ int crow(int r, int hi) { return (r & 3) + 8 * (r >> 2) + 4 * hi; }
__device__ __forceinline__ void hyena_unit(int c, const bf16_t* UHT, bf16_t* ZS, bf16_t* YHT, const bf16_t* KF, const float* FN, const float* sw, const float* sbias, const float* skip, LAS unsigned char* lds,
                                           bgtr::State& BG, int bgstride, const float* const* in, unsigned char* ws) {
    int tid_ = threadIdx.x; asm volatile("" : "+v"(tid_));
    const int tid = tid_, lane = tid & 63, wid = __builtin_amdgcn_readfirstlane(tid >> 6);
    const int r32 = lane & 31, hi = lane >> 5;
    __syncthreads();
    if (tid < 17) *(LAS unsigned*)(lds + LF0 + 16384 + 4 * tid) = 0u;
    for (int i = tid; i < 8 * 2 * (PADT / 8); i += 512) { const int b = i / (2 * (PADT / 8)), rem = i % (2 * (PADT / 8)); const int side = rem / (PADT / 8), k = rem % (PADT / 8);
        unsigned z0 = 0u; asm volatile("" : "+v"(z0)); *(LAS u32x4*)(lds + LZ + b * SB + 2 * (side * (PADT + SEQ) + 8 * k)) = (u32x4){z0, z0, z0, z0}; }
#pragma unroll 1
    for (int ord = 0; ord < 2; ++ord) {
        {
            const bf16_t* kfp = KF + ((size_t)ord * 512 + c) * 8192; float as = 0.f;
            const u32x4 wf = *(const u32x4*)(kfp + 8 * tid), wb = *(const u32x4*)(kfp + 4096 + 8 * tid);
            *(LAS u32x4*)(lds + LF0 + 2 * (4096 + 8 * tid)) = wb;
#pragma unroll
            for (int j = 0; j < 4; ++j) { const int m = 4096 - 8 * tid - 2 * j;
                if (tid + j > 0) *(LAS bf16_t*)(lds + LF0 + 2 * m) = (bf16_t)(wf[j] & 0xffffu);
                *(LAS bf16_t*)(lds + LF0 + 2 * (m - 1)) = (bf16_t)(wf[j] >> 16);
                as += fabsf(bflo(wf[j])) + fabsf(bfhi(wf[j])) + fabsf(bflo(wb[j])) + fabsf(bfhi(wb[j])); }
            if (tid == 0) { *(LAS bf16_t*)(lds + LF0) = 0; as -= fabsf(bflo(wb[0])); }
            as = wsum_sw(as); if (lane == 0) *(LAS float*)(lds + LRED + 4 * wid) = as; }
        { const int cc = ord * 512 + c; const float w0 = sw[cc], w1 = sw[1536 + cc], w2 = sw[3072 + cc], bb = sbias[cc];
          const bf16_t* u = UHT + (size_t)cc * T; const bf16_t* zs = ZS + (size_t)c * T;
#pragma unroll 1
          for (int kh = 0; kh < 2; ++kh) {
            u32x4 wv[4], zv[4]; float pv_[4], nx_[4];
#pragma unroll
            for (int kk = 0; kk < 4; ++kk) { const int id = tid + 512 * (4 * kh + kk), b = id >> 9, t8 = (id & 511) * 8; const size_t g = (size_t)b * SEQ + t8;
                wv[kk] = *(const u32x4*)(u + g); pv_[kk] = t8 > 0 ? bf2f(u[g - 1]) : 0.f; nx_[kk] = t8 + 8 < SEQ ? bf2f(u[g + 8]) : 0.f;
                if (ord == 1) zv[kk] = *(const u32x4*)(zs + g); }
#pragma unroll
            for (int kk = 0; kk < 4; ++kk) { const int id = tid + 512 * (4 * kh + kk), b = id >> 9, t8 = (id & 511) * 8;
                const u32x4 w = wv[kk];
                float x[10]; x[0] = pv_[kk]; x[9] = nx_[kk];
#pragma unroll
                for (int j = 0; j < 4; ++j) { x[1 + 2 * j] = bflo(w[j]); x[2 + 2 * j] = bfhi(w[j]); }
                float y[8];
#pragma unroll
                for (int j = 0; j < 8; ++j) y[j] = w0 * x[j] + w1 * x[j + 1] + w2 * x[j + 2] + bb;
                if (ord == 1) { const u32x4 zw = zv[kk];
#pragma unroll
                    for (int j = 0; j < 4; ++j) { y[2 * j] *= bflo(zw[j]); y[2 * j + 1] *= bfhi(zw[j]); } }
                u32x4 ow;
#pragma unroll
                for (int j = 0; j < 4; ++j) ow[j] = pk2(y[2 * j], y[2 * j + 1]);
                *(LAS u32x4*)(lds + LZ + b * SB + 2 * (PADT + t8)) = ow; } } }
        __syncthreads();
#pragma unroll 2
        for (int k = 0; k < 8; ++k) { const int i = tid + 512 * k; const unsigned lo = *(const LAS unsigned*)(lds + LF0 + 4 * i), hi2 = (i < 4095) ? *(const LAS unsigned*)(lds + LF0 + 4 * i + 4) : 0u;
            *(LAS unsigned*)(lds + LF1 + 4 * i) = (lo >> 16) | (hi2 << 16); }
        __syncthreads();
        int ln_ = lane; asm volatile("" : "+v"(ln_));
        const unsigned bgtile = (unsigned)__builtin_amdgcn_readfirstlane(bgtr::SCR + wid * bgtr::SCRW);
        const int r16 = ln_ & 15, g4 = ln_ >> 4;
        const int bcol = ((r16 >> 2) & 1) | (((r16 >> 3) & 1) << 1) | (((r16 >> 1) & 1) << 2), pcol = r16 & 1;
        const int Dlo = 16 * wid - 127;
        f32x4 acc[8][2];
#pragma unroll
        for (int u = 0; u < 8; ++u) { acc[u][0] = (f32x4){0.f, 0.f, 0.f, 0.f}; acc[u][1] = (f32x4){0.f, 0.f, 0.f, 0.f}; }
        const int m0 = 4096 - 32 * Dlo - r16 + 8 * g4;
        const unsigned a0 = (r16 & 1) ? (unsigned)(LF1 + 2 * (m0 - 1)) : (unsigned)(LF0 + 2 * m0);
        const unsigned b0 = (unsigned)(LZ + bcol * SB + 2 * (PADT + 32 * (pcol + 127) + 8 * g4)) - 384u;
#define H16_LDA(A_, d_, a_) do { const unsigned ab_ = a0 - 416u - 64u * (unsigned)(d_); _Pragma("unroll") for (int j = 0; j < 4; ++j) { u32x4 t_; _Pragma("unroll") for (int e = 0; e < 4; ++e) t_[e] = *(const LAS unsigned*)(lds + ab_ + (128 * (3 - j) + 32 * (1 - (a_)) + 4 * e)); A_[j] = __builtin_bit_cast(bf16x8, t_); } } while (0)
#define H16_LDB(B_, d_) do { const unsigned bb_ = b0 - 64u * (unsigned)(d_); _Pragma("unroll") for (int m = 0; m < 11; ++m) B_[m] = *(const LAS bf16x8*)(lds + bb_ + 128 * m); } while (0)
#define H16_MMA(A_, B_, a_, COND) do { _Pragma("unroll") for (int j = 0; j < 4; ++j) _Pragma("unroll") for (int u = 0; u < 8; ++u) if (COND) acc[u][a_] = __builtin_amdgcn_mfma_f32_16x16x32_bf16(A_[j], B_[u - j + 3], acc[u][a_], 0, 0, 0); } while (0)
#define H16_SB() __builtin_amdgcn_sched_barrier(0)
#define H16_PAIR(k_, CE_, CO_, BGS_) do { const int dE = 8 * (k_); \
            H16_LDA(Ay, dE, 1); H16_SB(); H16_MMA(Ax, Bx, 0, CE_); H16_SB(); BGS_; H16_SB(); H16_LDA(Ax, dE + 1, 0); H16_LDB(By, dE + 1); H16_SB(); H16_MMA(Ay, Bx, 1, CE_); H16_SB(); \
            H16_LDA(Ay, dE + 1, 1); H16_SB(); H16_MMA(Ax, By, 0, CO_); H16_SB(); H16_LDA(Ax, dE + 8, 0); H16_LDB(Bx, dE + 8); H16_SB(); H16_MMA(Ay, By, 1, CO_); H16_SB(); } while (0)
        {
            bf16x8 Ax[4], Ay[4], Bx[11], By[11];
            H16_LDA(Ax, 0, 0); H16_LDB(Bx, 0);
            H16_PAIR(0, u <= j, u <= j, (void)0);
            H16_PAIR(1, u <= j + 4, u <= j + 4, (void)0);
            int kEnd = 16; asm volatile("" : "+s"(kEnd));
#pragma unroll 1
            for (int k = 2; k < kEnd; ++k) H16_PAIR(k, true, true, bgtr::step(BG, bgstride, in, ws, lds, bgtile, lane));
            H16_PAIR(16, u >= j, u >= j + 1, (void)0);
            H16_PAIR(17, u >= j + 4, u >= j + 5, (void)0);
        }
#undef H16_LDA
#undef H16_LDB
#undef H16_MMA
#undef H16_SB
#undef H16_PAIR
        float l1 = 0.f;
#pragma unroll
        for (int k = 0; k < 8; ++k) l1 += *(const LAS float*)(lds + LRED + 4 * k);
        const float inv = 1.0f / (l1 + 1e-6f), sk = skip[ord * 512 + c];
        bf16_t* dst = (ord == 0 ? ZS : YHT) + (size_t)c * T + (size_t)bcol * SEQ;
#pragma unroll
        for (int u = 0; u < 8; ++u)
#pragma unroll
            for (int a = 0; a < 2; ++a) { const int t4 = 32 * (2 * (8 * wid + u) + pcol) + 16 * a + 4 * g4;
                const u32x2 zw = *(const LAS u32x2*)(lds + LZ + bcol * SB + 2 * (PADT + t4));
                const float z0 = bflo(zw[0]), z1 = bfhi(zw[0]), z2 = bflo(zw[1]), z3 = bfhi(zw[1]);
                u32x2 ow; ow[0] = pk2(acc[u][a][0] * inv + sk * z0, acc[u][a][1] * inv + sk * z1); ow[1] = pk2(acc[u][a][2] * inv + sk * z2, acc[u][a][3] * inv + sk * z3);
                *(u32x2*)(dst + t4) = ow; }
        VM_WAIT();
        __syncthreads();
    }
}
}

struct P2cItem { u32x4 uw[8], zw[8]; float prev, last; };
__device__ __forceinline__ void p2c_load(P2cItem& I, const bf16_t* UHT, const bf16_t* YHT, int it, int lane) {
    const int g = it & 7, tb = it >> 3; const int t0 = tb * 64, ts0 = t0 & (SEQ - 1); const int c = 64 * g + lane, cc = 1024 + c;
    const bf16_t* u = UHT + (size_t)cc * T + t0; const bf16_t* zp = YHT + (size_t)c * T + t0;
#pragma unroll
    for (int k = 0; k < 8; ++k) { I.uw[k] = *(const u32x4*)(u + 8 * k); I.zw[k] = *(const u32x4*)(zp + 8 * k); }
    I.prev = ts0 > 0 ? bf2f(u[-1]) : 0.f; I.last = ts0 + 64 < SEQ ? bf2f(u[64]) : 0.f;
}
__device__ __forceinline__ void p2c_process(const P2cItem& I, const float* sw, const float* sbias, bf16_t* Y, LAS float* tile, int it, int lane) {
    const int g = it & 7, tb = it >> 3; const int t0 = tb * 64;
    {
        const int cc = 1024 + 64 * g + lane;
        const float w0 = sw[cc], w1 = sw[1536 + cc], w2 = sw[3072 + cc], bb = sbias[cc];
        float prev = I.prev;
#pragma unroll
        for (int k = 0; k < 8; ++k) { float x[10]; x[0] = prev;
#pragma unroll
            for (int j = 0; j < 4; ++j) { x[1 + 2 * j] = bflo(I.uw[k][j]); x[2 + 2 * j] = bfhi(I.uw[k][j]); }
            x[9] = (k < 7) ? bflo(I.uw[k < 7 ? k + 1 : 7][0]) : I.last; prev = x[8];
#pragma unroll
            for (int j = 0; j < 8; ++j) { const float gate = w0 * x[j] + w1 * x[j + 1] + w2 * x[j + 2] + bb; const float zc = (j & 1) ? bfhi(I.zw[k][j >> 1]) : bflo(I.zw[k][j >> 1]);
                tile[lane * 65 + 8 * k + j] = gate * zc; } }
    }
    LDS_WAIT(); asm volatile("" ::: "memory");
    {
        float ss = 0.f;
#pragma unroll 8
        for (int ch = 0; ch < 64; ++ch) { const float v = tile[ch * 65 + lane]; ss += v * v; }
        const float rs = 1.0f / sqrtf(ss * (1.0f / 64.0f) + EPSN);
        bf16_t* o = Y + (size_t)(t0 + lane) * 1024 + 64 * g;
#pragma unroll
        for (int k = 0; k < 8; ++k) { u32x4 w;
#pragma unroll
            for (int j = 0; j < 4; ++j) w[j] = pk2(tile[(8 * k + 2 * j) * 65 + lane] * rs, tile[(8 * k + 2 * j + 1) * 65 + lane] * rs);
            *(u32x4*)(o + 8 * k) = w; }
    }
    LDS_WAIT(); asm volatile("" ::: "memory");
}
__device__ __forceinline__ void p2c_transpose(Frame& F, bf16_t* Y) {
    const int gw = F.vcu * NWAVES + F.wave, NGW = F.G * NWAVES, lane = F.lane;
    const bf16_t* UHT = (const bf16_t*)(F.ws + WS_UHT); const bf16_t* YHT = (const bf16_t*)(F.ws + WS_YHT);
    const float* sw = F.in[4]; const float* sbias = F.in[5];
    LAS float* tile = (LAS float*)(F.lds + F.wave * 16640);
    constexpr int NIT = 8 * (T / 64);
    for (int it = gw; it < NIT; it += 2 * NGW) {
        P2cItem A, B; const bool hasB = it + NGW < NIT;
        p2c_load(A, UHT, YHT, it, lane);
        if (hasB) p2c_load(B, UHT, YHT, it + NGW, lane);
        p2c_process(A, sw, sbias, Y, tile, it, lane);
        if (hasB) p2c_process(B, sw, sbias, Y, tile, it + NGW, lane);
    }
}

struct TileSched {
    int G, vcu, nM, lgN; const char *A, *B; size_t tA, tB; int kt;
    __device__ __forceinline__ bool next(int i, pg8::Unit& u) const {
        const int L = i * G + vcu; if (L >= (nM << lgN)) return false;
        u.pm = L >> lgN; u.pn = L & ((1 << lgN) - 1); u.A = A + (size_t)u.pm * tA; u.B = B + (size_t)u.pn * tB; u.aux = 0; u.flags = 3; u.kt = kt; return true;
    }
};
template <bool BASE_BF16> struct EpiResid {
    const float* base; bf16_t* xb; float* ss; const float* rowscale;
    __device__ __forceinline__ void operator()(const f32x4 (&acc)[2][2][4][2], const pg8::Unit& u, int wr, int wc, int fr, int fq) const {
        const int row0 = u.pm * 256 + wr * 64 + fr, col0 = u.pn * 256 + wc * 32 + 8 * fq;
#pragma unroll
        for (int ai = 0; ai < 2; ++ai)
#pragma unroll
            for (int mh = 0; mh < 2; ++mh) {
                f32x4 b[4][2][2];
#pragma unroll
                for (int mm = 0; mm < 2; ++mm) { const int r = row0 + ai * 128 + (2 * mh + mm) * 16; const float rsc = (BASE_BF16 && rowscale) ? rowscale[r] : 1.0f;
#pragma unroll
                    for (int bj = 0; bj < 2; ++bj) { const size_t off = (size_t)r * 1024 + col0 + bj * 128;
                        if (BASE_BF16) { const u32x4 bw = *(const u32x4*)(xb + off); b[mm][bj][0] = (f32x4){bflo(bw[0]), bfhi(bw[0]), bflo(bw[1]), bfhi(bw[1])} * rsc; b[mm][bj][1] = (f32x4){bflo(bw[2]), bfhi(bw[2]), bflo(bw[3]), bfhi(bw[3])} * rsc; }
                        else { b[mm][bj][0] = *(const f32x4*)(base + off); b[mm][bj][1] = *(const f32x4*)(base + off + 4); } } }
#pragma unroll
                for (int mm = 0; mm < 2; ++mm) { const int m = 2 * mh + mm; const int r = row0 + ai * 128 + m * 16; float part = 0.f;
#pragma unroll
                    for (int bj = 0; bj < 2; ++bj) { const size_t off = (size_t)r * 1024 + col0 + bj * 128;
                        const f32x4 v0 = acc[ai][bj][m][0] + b[mm][bj][0], v1 = acc[ai][bj][m][1] + b[mm][bj][1];
                        u32x4 w; w.x = pg8::cvt_pk_bf16(v0[0], v0[1]); w.y = pg8::cvt_pk_bf16(v0[2], v0[3]); w.z = pg8::cvt_pk_bf16(v1[0], v1[1]); w.w = pg8::cvt_pk_bf16(v1[2], v1[3]);
                        *(u32x4*)(xb + off) = w;
                        part += (v0[0] * v0[0] + v0[1] * v0[1]) + (v0[2] * v0[2] + v0[3] * v0[3]) + (v1[0] * v1[0] + v1[1] * v1[1]) + (v1[2] * v1[2] + v1[3] * v1[3]); }
                    part += __shfl_xor(part, 16); part += __shfl_xor(part, 32);
                    if (fq == 0) ss[(size_t)r * 16 + u.pn * 4 + wc] = part; }
                asm volatile("" ::: "memory"); }
    }
};
__device__ __forceinline__ float row_rstd(const float* ssp, int r) {
    const f32x4* p = (const f32x4*)(ssp + (size_t)r * 16); const f32x4 a = p[0], b = p[1], c = p[2], d = p[3];
    const float t = (((a[0] + a[1]) + (a[2] + a[3])) + ((b[0] + b[1]) + (b[2] + b[3]))) + (((c[0] + c[1]) + (c[2] + c[3])) + ((d[0] + d[1]) + (d[2] + d[3])));
    return 1.0f / sqrtf(t * (1.0f / 1024.0f) + EPSN);
}
struct EpiRowScale {
    bf16_t* O; const float* ss;
    __device__ __forceinline__ void operator()(const f32x4 (&acc)[2][2][4][2], const pg8::Unit& u, int wr, int wc, int fr, int fq) const {
        const int row0 = u.pm * 256 + wr * 64 + fr, col0 = u.pn * 256 + wc * 32 + 8 * fq;
#pragma unroll
        for (int ai = 0; ai < 2; ++ai)
#pragma unroll
            for (int m = 0; m < 4; ++m) { const int r = row0 + ai * 128 + m * 16; const float rs = row_rstd(ss, r);
#pragma unroll
                for (int bj = 0; bj < 2; ++bj) { const f32x4 v0 = acc[ai][bj][m][0] * rs, v1 = acc[ai][bj][m][1] * rs;
                    u32x4 w; w.x = pg8::cvt_pk_bf16(v0[0], v0[1]); w.y = pg8::cvt_pk_bf16(v0[2], v0[3]); w.z = pg8::cvt_pk_bf16(v1[0], v1[1]); w.w = pg8::cvt_pk_bf16(v1[2], v1[3]);
                    *(u32x4*)(O + (size_t)r * 512 + col0 + bj * 128) = w; } }
    }
};

namespace ma {
constexpr int KP = 272, VP = 520;
constexpr int LK = 0, LV = 256 * KP, LEND = LV + 128 * VP;
static_assert(LEND <= MISC_OFF, "mem-attn LDS map");
__device__ __forceinline__ void memattn_unit(int b, int h, int rb, const bf16_t* QM, const bf16_t* KVM, bf16_t* OM, const float* gq, LAS unsigned char* lds) {
    const int tid = threadIdx.x, lane = tid & 63, wid = __builtin_amdgcn_readfirstlane(tid >> 6), r32 = lane & 31, hi = lane >> 5;
    __syncthreads();
#pragma unroll 2
    for (int k = 0; k < 8; ++k) { const int p = tid + 512 * k, key = p >> 4, ch = p & 15;
        const u32x4 w = *(const u32x4*)(KVM + (size_t)(b * 256 + key) * 1024 + h * 128 + ch * 8);
        *(LAS u32x4*)(lds + LK + key * KP + ch * 16) = w; }
#pragma unroll 2
    for (int k = 0; k < 8; ++k) { const int p = tid + 512 * k, key = p & 255, ch = p >> 8;
        const u32x4 w = *(const u32x4*)(KVM + (size_t)(b * 256 + key) * 1024 + 512 + h * 128 + ch * 8);
#pragma unroll
        for (int j = 0; j < 4; ++j) { *(LAS bf16_t*)(lds + LV + (ch * 8 + 2 * j) * VP + key * 2) = (bf16_t)(w[j] & 0xffffu); *(LAS bf16_t*)(lds + LV + (ch * 8 + 2 * j + 1) * VP + key * 2) = (bf16_t)(w[j] >> 16); } }
    const size_t qrow = (size_t)b * SEQ + rb * 256 + wid * 32 + r32;
    bf16x8 qf[8];
    {
        float qv[8][8]; float ssq = 0.f;
#pragma unroll
        for (int ks = 0; ks < 8; ++ks) { const u32x4 w = *(const u32x4*)(QM + qrow * 512 + h * 128 + ks * 16 + hi * 8);
#pragma unroll
            for (int j = 0; j < 4; ++j) { qv[ks][2 * j] = bflo(w[j]); qv[ks][2 * j + 1] = bfhi(w[j]); ssq += qv[ks][2 * j] * qv[ks][2 * j] + qv[ks][2 * j + 1] * qv[ks][2 * j + 1]; } }
        ssq += __shfl_xor(ssq, 32);
        const float rs = (0.08838834764831845f * 1.4426950408889634f) / sqrtf(ssq * (1.0f / 128.0f) + EPSN);
#pragma unroll
        for (int ks = 0; ks < 8; ++ks) { const f32x4 g0 = *(const f32x4*)(gq + ks * 16 + hi * 8), g1 = *(const f32x4*)(gq + ks * 16 + hi * 8 + 4); u32x4 w;
#pragma unroll
            for (int j = 0; j < 2; ++j) { w[j] = pk2(qv[ks][2 * j] * rs * g0[2 * j], qv[ks][2 * j + 1] * rs * g0[2 * j + 1]); w[2 + j] = pk2(qv[ks][4 + 2 * j] * rs * g1[2 * j], qv[ks][5 + 2 * j] * rs * g1[2 * j + 1]); }
            qf[ks] = __builtin_bit_cast(bf16x8, w); }
    }
    __syncthreads();
    f32x16 st[8];
#pragma unroll
    for (int kb = 0; kb < 8; ++kb) { f32x16 a = f32x16{};
#pragma unroll
        for (int ks = 0; ks < 8; ++ks) { const bf16x8 kf = *(const LAS bf16x8*)(lds + LK + (kb * 32 + r32) * KP + ks * 32 + hi * 16);
            a = __builtin_amdgcn_mfma_f32_32x32x16_bf16(kf, qf[ks], a, 0, 0, 0); }
        st[kb] = a; }
    float mx = -1e30f;
#pragma unroll
    for (int kb = 0; kb < 8; ++kb)
#pragma unroll
        for (int r = 0; r < 16; ++r) mx = fmaxf(mx, st[kb][r]);
    mx = fmaxf(mx, __shfl_xor(mx, 32));
    float l = 0.f; u32x4 pb[8][2];
#pragma unroll
    for (int kb = 0; kb < 8; ++kb) {
#pragma unroll
        for (int r = 0; r < 16; ++r) { st[kb][r] = __builtin_amdgcn_exp2f(st[kb][r] - mx); l += st[kb][r]; }
#pragma unroll
        for (int s2 = 0; s2 < 2; ++s2)
#pragma unroll
            for (int j = 0; j < 4; ++j) pb[kb][s2][j] = pk2(st[kb][8 * s2 + 2 * j], st[kb][8 * s2 + 2 * j + 1]); }
    l += __shfl_xor(l, 32);
    const float il = 1.0f / l;
    bf16_t* orow = OM + qrow * 512 + h * 128;
#pragma unroll
    for (int db = 0; db < 4; ++db) { f32x16 o = f32x16{};
#pragma unroll
        for (int kb = 0; kb < 8; ++kb)
#pragma unroll
            for (int s2 = 0; s2 < 2; ++s2) { const LAS unsigned char* vp = lds + LV + (db * 32 + r32) * VP + 2 * (kb * 32 + 16 * s2 + 4 * hi);
                const u32x2 v0 = *(const LAS u32x2*)vp, v1 = *(const LAS u32x2*)(vp + 16);
                const u32x4 vv = (u32x4){v0[0], v0[1], v1[0], v1[1]};
                o = __builtin_amdgcn_mfma_f32_32x32x16_bf16(__builtin_bit_cast(bf16x8, vv), __builtin_bit_cast(bf16x8, pb[kb][s2]), o, 0, 0, 0); }
#pragma unroll
        for (int g4 = 0; g4 < 4; ++g4) { u32x2 w; w[0] = pk2(o[4 * g4] * il, o[4 * g4 + 1] * il); w[1] = pk2(o[4 * g4 + 2] * il, o[4 * g4 + 3] * il);
            *(u32x2*)(orow + db * 32 + 8 * g4 + 4 * hi) = w; } }
}
}

constexpr size_t WS_SSP1 = WS_MOE + 6 * MiBx, WS_SSP2 = WS_MOE + 8 * MiBx;
constexpr size_t WS_TOKW = WS_MOE + 1 * MiBx, WS_RS = WS_MOE + 2 * MiBx, WS_TOKS = WS_MOE + 3 * MiBx;
constexpr size_t WS_HB = WS_UHT;
constexpr int XS_ROWS = T + 24 * 256;
constexpr int WRP = 336;
__device__ __forceinline__ void p6a_route(Frame& F) {
    const int lane = F.lane;
    const float* WR = (const float*)(F.ws + WS_WR); const float* brg = F.in[28]; const float* bre = F.in[30];
    int* cnt = (int*)(F.ctl + CW_CNT); int* toks = (int*)(F.ws + WS_TOKS); float* tokw = (float*)(F.ws + WS_TOKW); float* rs2 = (float*)(F.ws + WS_RS);
    const bf16_t* xb = (const bf16_t*)(F.ws + WS_XN);
    volatile LAS int* cntl = (volatile LAS int*)(F.lds + 256 * WRP); volatile LAS int* basel = cntl + 32;
    __syncthreads();
    for (int i = F.tid; i < 20 * 256; i += NWAVES * 64) { const int e = i >> 8, k4 = i & 255; *(LAS f32x4*)(F.lds + k4 * WRP + e * 16) = *(const f32x4*)(WR + e * 1024 + 4 * k4); }
    if (F.tid < 32) cntl[F.tid] = 0;
    __syncthreads();
    const int tl = lane >> 2, part = lane & 3;
    for (int tb = F.vcu; tb < T / 128; tb += F.G) {
        const int tok = tb * 128 + F.wave * 16 + tl;
        const u32x4* xr = (const u32x4*)(xb + (size_t)tok * 1024) + part;
        float lg[20]; float ssq = 0.f;
#pragma unroll
        for (int e = 0; e < 20; ++e) lg[e] = 0.f;
#pragma unroll 4
        for (int it = 0; it < 32; ++it) { const u32x4 xw = xr[4 * it];
            const f32x4 v0 = (f32x4){bflo(xw[0]), bfhi(xw[0]), bflo(xw[1]), bfhi(xw[1])}, v1 = (f32x4){bflo(xw[2]), bfhi(xw[2]), bflo(xw[3]), bfhi(xw[3])};
            ssq += (v0.x * v0.x + v0.y * v0.y) + (v0.z * v0.z + v0.w * v0.w) + (v1.x * v1.x + v1.y * v1.y) + (v1.z * v1.z + v1.w * v1.w);
            const LAS unsigned char* wp = F.lds + (8 * it + 2 * part) * WRP;
#pragma unroll
            for (int e = 0; e < 20; ++e) { const f32x4 w0 = *(const LAS f32x4*)(wp + e * 16), w1 = *(const LAS f32x4*)(wp + WRP + e * 16);
                lg[e] += ((v0.x * w0.x + v0.y * w0.y) + (v0.z * w0.z + v0.w * w0.w)) + ((v1.x * w1.x + v1.y * w1.y) + (v1.z * w1.z + v1.w * w1.w)); } }
        ssq += __shfl_xor(ssq, 1); ssq += __shfl_xor(ssq, 2);
        const float rstd = 1.0f / sqrtf(ssq * (1.0f / 1024.0f) + EPSN);
#pragma unroll
        for (int e = 0; e < 20; ++e) { lg[e] += __shfl_xor(lg[e], 1); lg[e] += __shfl_xor(lg[e], 2); lg[e] *= rstd; }
        float gl[4], gm = -1e30f;
#pragma unroll
        for (int j = 0; j < 4; ++j) { gl[j] = lg[j] + brg[j]; gm = fmaxf(gm, gl[j]); }
        float gs = 0.f, gp[4];
#pragma unroll
        for (int j = 0; j < 4; ++j) { gp[j] = expf(gl[j] - gm); gs += gp[j]; }
        int gi = 0; float best = gp[0];
#pragma unroll
        for (int j = 1; j < 4; ++j) if (gp[j] > best) { best = gp[j]; gi = j; }
        const float pg = best / gs;
        float el[4], em = -1e30f;
#pragma unroll
        for (int j = 0; j < 4; ++j) { float vv = 0.f;
#pragma unroll
            for (int q = 0; q < 4; ++q) if (q == gi) vv = lg[4 + q * 4 + j] + bre[q * 4 + j];
            el[j] = vv; em = fmaxf(em, vv); }
        float ep[4];
#pragma unroll
        for (int j = 0; j < 4; ++j) ep[j] = expf(el[j] - em);
        int e1 = 0; float p1 = ep[0];
#pragma unroll
        for (int j = 1; j < 4; ++j) if (ep[j] > p1) { p1 = ep[j]; e1 = j; }
        int e2 = -1; float p2 = -1.f;
#pragma unroll
        for (int j = 0; j < 4; ++j) if (j != e1 && ep[j] > p2) { p2 = ep[j]; e2 = j; }
        const float w1 = pg * p1 / (p1 + p2), w2 = pg * p2 / (p1 + p2);
        const int lo = e1 < e2 ? e1 : e2, hi2 = e1 < e2 ? e2 : e1; const float wlo = e1 < e2 ? w1 : w2, whi = e1 < e2 ? w2 : w1;
        const int pidx = (lo == 0) ? (hi2 - 1) : (lo == 1 ? hi2 + 1 : 5);
        const int bucket = gi * 6 + pidx;
        int rank = 0;
        if (part == 0) rank = __hip_atomic_fetch_add((LAS int*)&cntl[bucket], 1, __ATOMIC_RELAXED, __HIP_MEMORY_SCOPE_WORKGROUP);
        __syncthreads();
        if (F.tid < 24) { const int c = cntl[F.tid]; basel[F.tid] = c ? atomicAdd(&cnt[F.tid * 64], c) : 0; }
        __syncthreads();
        if (part == 0) { const int pos = basel[bucket] + rank; toks[(size_t)bucket * T + pos] = tok; tokw[2 * tok] = wlo; tokw[2 * tok + 1] = whi; rs2[tok] = rstd; }
        __syncthreads();
        if (F.tid < 32) cntl[F.tid] = 0;
        __syncthreads();
    }
}
__device__ __forceinline__ void moe_prefix(Frame& F, volatile LAS int* tp) {
    if (F.tid == 0) { const int* cnt = (const int*)(F.ctl + CW_CNT); int s = 0; for (int b = 0; b < 24; ++b) { tp[b] = s; s += (cnt[b * 64] + 255) >> 8; } tp[24] = s; }
    __syncthreads();
}
__device__ __forceinline__ int moe_bucket_of_tile(volatile LAS int* tp, int tau) { int b = 0;
#pragma unroll
    for (int k = 1; k < 24; ++k) b += (tau >= tp[k]) ? 1 : 0;
    return b; }
__device__ __forceinline__ int moe_expert(int bucket, int slot) { const int g = bucket / 6, p = bucket % 6; const int lo = p < 3 ? 0 : (p < 5 ? 1 : 2), hi2 = p < 3 ? p + 1 : (p < 5 ? p - 1 : 3); return g * 4 + (slot ? hi2 : lo); }
constexpr int CW_TCNT = 11264;
static_assert((CW_TCNT + 160 * 16) * 4 <= (int)CTL_ZERO_BYTES, "ctl region");
struct MoeSched {
    int G, vcu; volatile LAS int* tp; const int* cnt; const char *xb, *wgu, *hb, *wd; const int* toks; unsigned* tcnt;
    __device__ __forceinline__ void tile_rows(int tau, pg8::Unit& u) const { const int b = moe_bucket_of_tile(tp, tau); const int off = (tau - tp[b]) * 256; u.rows = toks + (size_t)b * T + off; const int c = cnt[b * 64] - off; u.nvalid = c < 256 ? c : 256; }
    __device__ __forceinline__ bool next(int i, pg8::Unit& u) const {
        const int ntile = tp[24]; const int NU = ntile * 8, ND = ntile * 4;
        const int nu = (NU > vcu) ? (NU - vcu + G - 1) / G : 0;
        if (i < nu) { const int L = i * G + vcu; const int tau = L >> 3, slot = (L >> 2) & 1, pn = L & 3; const int e = moe_expert(moe_bucket_of_tile(tp, tau), slot);
            u.pm = tau; u.pn = pn; u.aux = slot; u.flags = 3; u.kt = 16; u.A = xb; u.B = wgu + ((size_t)e * 1024 + pn * 256) * 2048; tile_rows(tau, u); return true; }
        const int j = i - nu; const int Ld = (nu + (j >> 1)) * G + vcu - NU, slot = j & 1; if (Ld >= ND) return false;
        const int tau = Ld >> 2, pn = Ld & 3; const int e = moe_expert(moe_bucket_of_tile(tp, tau), slot);
        if (slot == 0) { unsigned spins = 0; while (__hip_atomic_load(tcnt + tau * 16, __ATOMIC_RELAXED, __HIP_MEMORY_SCOPE_AGENT) < 8u) { __builtin_amdgcn_s_sleep(4); if (++spins > (1u << 22)) break; }
            __builtin_amdgcn_fence(__ATOMIC_ACQUIRE, "agent"); }
        u.pm = tau; u.pn = pn; u.aux = 2 | slot; u.flags = slot ? 2 : 1; u.kt = 8; u.A = hb + (size_t)tau * 256 * 2048 + slot * 1024; u.B = wd + ((size_t)e * 1024 + pn * 256) * 2048; tile_rows(tau, u); return true;
    }
    __device__ __forceinline__ unsigned rowoff(const pg8::Unit& u, int R) const {
        if (u.aux & 2) return (unsigned)R * 2048u;
        const int tok = (R < u.nvalid) ? u.rows[R] : 0; return (unsigned)tok * 2048u;
    }
};
struct EpiMoeUp {
    bf16_t* H; const float* rs2; const float* tokw;
    __device__ __forceinline__ void operator()(const f32x4 (&acc)[2][2][4][2], const pg8::Unit& u, int wr, int wc, int fr, int fq) const {
        const int rl0 = wr * 64 + fr, col0 = u.aux * 512 + u.pn * 128 + wc * 32 + 8 * fq;
#pragma unroll
        for (int ai = 0; ai < 2; ++ai)
#pragma unroll
            for (int m = 0; m < 4; ++m) { const int rl = rl0 + ai * 128 + m * 16; const int tok = (rl < u.nvalid) ? u.rows[rl] : -1;
                const float rs = tok >= 0 ? rs2[tok] : 0.f, gwt = tok >= 0 ? tokw[2 * tok + u.aux] : 0.f;
                float hv[8];
#pragma unroll
                for (int n = 0; n < 2; ++n)
#pragma unroll
                    for (int k = 0; k < 4; ++k) { const float g = acc[ai][0][m][n][k] * rs, uu = acc[ai][1][m][n][k] * rs; hv[4 * n + k] = g / (1.0f + __expf(-g)) * uu * gwt; }
                u32x4 w; w.x = pg8::cvt_pk_bf16(hv[0], hv[1]); w.y = pg8::cvt_pk_bf16(hv[2], hv[3]); w.z = pg8::cvt_pk_bf16(hv[4], hv[5]); w.w = pg8::cvt_pk_bf16(hv[6], hv[7]);
                { bf16_t* hp = H + (size_t)(u.pm * 256 + rl) * 1024 + col0; asm volatile("global_store_dwordx4 %0, %1, off sc1\n\ts_nop 1" :: "v"(hp), "v"(w) : "memory"); } }
    }
};
struct EpiMoeDown {
    float* out; const bf16_t* xb;
    __device__ __forceinline__ void operator()(const f32x4 (&acc)[2][2][4][2], const pg8::Unit& u, int wr, int wc, int fr, int fq) const {
        const int rl0 = wr * 64 + fr, col0 = u.pn * 256 + wc * 32 + 8 * fq;
        int tk[2][4];
#pragma unroll
        for (int ai = 0; ai < 2; ++ai)
#pragma unroll
            for (int m = 0; m < 4; ++m) { const int rl = rl0 + ai * 128 + m * 16; tk[ai][m] = (rl < u.nvalid) ? u.rows[rl] : -1; }
#pragma unroll
        for (int ai = 0; ai < 2; ++ai) {
            u32x4 bw[4][2];
#pragma unroll
            for (int m = 0; m < 4; ++m)
#pragma unroll
                for (int bj = 0; bj < 2; ++bj) bw[m][bj] = *(const u32x4*)(xb + (size_t)(tk[ai][m] < 0 ? 0 : tk[ai][m]) * 1024 + col0 + bj * 128);
#pragma unroll
            for (int m = 0; m < 4; ++m) { const int tok = tk[ai][m];
                if (tok >= 0) {
#pragma unroll
                    for (int bj = 0; bj < 2; ++bj) { float* p = out + (size_t)tok * 1024 + col0 + bj * 128; const u32x4 w = bw[m][bj];
                        __builtin_nontemporal_store((f32x4){bflo(w[0]), bfhi(w[0]), bflo(w[1]), bfhi(w[1])} + acc[ai][bj][m][0], (f32x4*)p); __builtin_nontemporal_store((f32x4){bflo(w[2]), bfhi(w[2]), bflo(w[3]), bfhi(w[3])} + acc[ai][bj][m][1], (f32x4*)(p + 4)); } } }
            asm volatile("" ::: "memory"); }
    }
};
struct EpiMoe {
    EpiMoeUp up; EpiMoeDown down; unsigned* tcnt;
    __device__ __forceinline__ void operator()(const f32x4 (&acc)[2][2][4][2], const pg8::Unit& u, int wr, int wc, int fr, int fq) const {
        if (u.aux & 2) { down(acc, u, wr, wc, fr, fq); return; }
        up(acc, u, wr, wc, fr, fq);
        asm volatile("s_waitcnt vmcnt(0)" ::: "memory");
        __builtin_amdgcn_s_barrier();
        if (threadIdx.x == 0) __hip_atomic_fetch_add(tcnt + u.pm * 16, 1u, __ATOMIC_RELAXED, __HIP_MEMORY_SCOPE_AGENT);
    }
};

struct Args { const float* in[34]; float* out; unsigned char* ws; unsigned char* ybuf; int ph_lo, ph_hi; };
__global__ void __launch_bounds__(NWAVES * 64, 2) mk_fwd(Args args) {
    extern __shared__ __attribute__((aligned(16))) unsigned char lds[];
    Frame F;
    F.lds = (LAS unsigned char*)lds;
    F.tid = threadIdx.x; F.lane = F.tid & 63; F.wave = __builtin_amdgcn_readfirstlane(F.tid >> 6);
    F.G = gridDim.x; { const int bx = blockIdx.x; F.vcu = (F.G % 8 == 0) ? (bx % 8) * (F.G / 8) + bx / 8 : bx; }
    F.ws = args.ws; F.ctl = (unsigned*)(args.ws + WS_CTL); F.in = args.in; F.out = args.out;
    volatile LAS unsigned* MISC = (volatile LAS unsigned*)(F.lds + MISC_OFF);
    for (int u = F.tid; u < 128; u += NWAVES * 64) MISC[u] = 0u;
    __syncthreads();
    XcdBarrier bar = xcd_barrier_post(F.ctl + CW_BAR, MISC + 8);
    const int lo = args.ph_lo, hi = args.ph_hi;
#ifdef MK_TS
    if (blockIdx.x == MK_TSB && F.tid == 0) { const unsigned long long t_ = __builtin_amdgcn_s_memrealtime(); MISC[58] = (unsigned)t_; MISC[59] = (unsigned)(t_ >> 32); }
#define TSTAMP(k) TSI(k)
#else
#define TSTAMP(k) do {} while (0)
#endif
#define IN(k) (lo <= (k) && (k) < hi)
#define SEAM(k) do { if (IN(k) && IN((k) + 1)) xcd_barrier(bar); TSTAMP(k); } while (0)
    unsigned char* ws = args.ws;
    if (IN(0)) { p0_prologue(F); }
    SEAM(0);
    if (IN(1)) {
        P1Sched S{F.G, F.vcu, (const char*)(ws + WS_WIN), (const char*)(ws + WS_XN), (const char*)(ws + WS_MEMN), (const char*)(ws + WS_WKV)};
        EpiBf16Multi E{ws};
        pg8::gemm_phase(F.lds, 1024, 1024, 1024, S, E);
        VM_WAIT(); __syncthreads();
        { pg8::Unit u; for (int i = 0; S.next(i, u); ++i) { if (u.aux == 1 && u.pn == 2) kprep_tile(F, u.pm); else if (u.aux == 2 && u.pn < 2) kmem_norm_tile(F, u.pm, u.pn); } }
    }
    SEAM(1);
    TSTAMP(2);
    if (IN(3)) {
        const bf16_t* QKV = (const bf16_t*)(ws + WS_QKV); bf16_t* Yb = (bf16_t*)args.ybuf;
#ifndef NO_HY
        bgtr::State BG; BG.it = __builtin_amdgcn_readfirstlane(F.vcu * NWAVES + F.wave); BG.pend = 0;
        const int bgstride = F.G * NWAVES;
        for (int j = 0; j < 2; ++j) { const int c = j * F.G + F.vcu; if (c < 512)
            hy::hyena_unit(c, (const bf16_t*)(ws + WS_UHT), (bf16_t*)(ws + WS_ZS), (bf16_t*)(ws + WS_YHT), (const bf16_t*)(ws + WS_KF), (const float*)(F.ctl + CW_FN), args.in[4], args.in[5], args.in[12], F.lds, BG, bgstride, args.in, ws); }
        while (BG.it < bgtr::NIT || BG.pend) bgtr::step(BG, bgstride, args.in, ws, F.lds, (unsigned)__builtin_amdgcn_readfirstlane(bgtr::SCR + F.wave * bgtr::SCRW), F.lane);
        __syncthreads();
        TSI(30);
#endif
#ifndef NO_AT
        for (int i = 0; i < 4; ++i) { const int uid = i * F.G + F.vcu; if (uid < 1024) { const int pair = uid >> 6, rem = uid & 63;
            at::attn_unit<8>(pair >> 1, (pair & 1) * 4 + (rem >> 4), rem & 15, QKV, Yb, args.in[13], args.in[14], (const float*)(ws + WS_ROPE), (char*)lds); } }
#endif
    }
    SEAM(3);
#ifndef NO_P2C
    if (IN(4)) { p2c_transpose(F, (bf16_t*)args.ybuf); }
#endif
    SEAM(4);
    if (IN(5)) {
        TileSched S{F.G, F.vcu, T / 256, 2, (const char*)args.ybuf, (const char*)(ws + WS_WOUT), (size_t)256 * 2048, (size_t)256 * 2048, 16};
        EpiResid<true> E{nullptr, (bf16_t*)(ws + WS_XN), (float*)(ws + WS_SSP1), (const float*)(ws + WS_RMS0)};
        pg8::gemm_phase(F.lds, 1024, 1024, 1024, S, E);
    }
    SEAM(5);
    if (IN(6)) {
        TileSched S{F.G, F.vcu, T / 256, 1, (const char*)(ws + WS_XN), (const char*)(ws + WS_WQM), (size_t)256 * 2048, (size_t)256 * 2048, 16};
        EpiRowScale E{(bf16_t*)(ws + WS_QM), (const float*)(ws + WS_SSP1)};
        pg8::gemm_phase(F.lds, 1024, 1024, 1024, S, E);
        VM_WAIT(); __syncthreads();
        { pg8::Unit u; for (int i = 0; S.next(i, u); ++i) for (int hh = 0; hh < 2; ++hh)
            ma::memattn_unit(u.pm >> 4, 2 * u.pn + hh, u.pm & 15, (const bf16_t*)(ws + WS_QM), (const bf16_t*)(ws + WS_KVM), (bf16_t*)(ws + WS_OM), args.in[23], F.lds); }
        __syncthreads();
    }
    SEAM(6);
    TSTAMP(7);
    if (IN(8)) {
        TileSched S{F.G, F.vcu, T / 256, 2, (const char*)(ws + WS_OM), (const char*)(ws + WS_WOM), (size_t)256 * 1024, (size_t)256 * 1024, 8};
        EpiResid<true> E{nullptr, (bf16_t*)(ws + WS_XN), (float*)(ws + WS_SSP2), nullptr};
        pg8::gemm_phase(F.lds, 512, 512, 512, S, E);
    }
    SEAM(8);
    if (IN(9)) { p6a_route(F); }
    SEAM(9);
    volatile LAS int* tp = (volatile LAS int*)(MISC + 32);
    TSTAMP(10);
    if (IN(11)) {
        moe_prefix(F, tp);
        unsigned* tcnt = F.ctl + CW_TCNT;
        MoeSched S{F.G, F.vcu, tp, (const int*)(F.ctl + CW_CNT), (const char*)(ws + WS_XN), (const char*)(ws + WS_WGU), (const char*)(ws + WS_HB), (const char*)(ws + WS_WD), (const int*)(ws + WS_TOKS), tcnt};
        EpiMoe E{EpiMoeUp{(bf16_t*)(ws + WS_HB), (const float*)(ws + WS_RS), (const float*)(ws + WS_TOKW)}, EpiMoeDown{args.out, (const bf16_t*)(ws + WS_XN)}, tcnt};
        pg8::gemm_phase<EpiMoe, MoeSched, true>(F.lds, 1024, 1024, 1024, S, E);
        TSI(13);
    }
#ifdef MK_TS
    xcd_barrier(bar); TSTAMP(12);
    if (blockIdx.x == MK_TSB && F.tid == 0) { const unsigned long long ts1 = ((unsigned long long)MISC[61] << 32) | MISC[60], ts0 = ((unsigned long long)MISC[59] << 32) | MISC[58]; args.out[0] += (float)(ts1 - ts0) * 1e-3f; }
#endif
#undef IN
#undef SEAM
}

extern "C" void kernel_launch(void* const* d_in, const int* in_sizes, int n_in, void* d_out, int out_size, void* d_ws, size_t ws_size, hipStream_t stream) {
    static int grid = 0;
    if (grid == 0) {
        int dev = 0, cus = 0;
        if (hipGetDevice(&dev) != hipSuccess || hipDeviceGetAttribute(&cus, hipDeviceAttributeMultiprocessorCount, dev) != hipSuccess) { grid = -1; return; }
        if (hipFuncSetAttribute((const void*)mk_fwd, hipFuncAttributeMaxDynamicSharedMemorySize, LDS_BYTES) != hipSuccess) { fprintf(stderr, "hipFuncSetAttribute failed\n"); grid = -1; return; }
        (void)hipGetLastError();
        grid = cus;
    }
    if (grid < 0) return;
    (void)hipMemsetAsync((char*)d_ws + WS_CTL, 0, CTL_ZERO_BYTES, stream);
    Args a{};
    for (int i = 0; i < 34; ++i) a.in[i] = (const float*)d_in[i];
    a.out = (float*)d_out; a.ws = (unsigned char*)d_ws;
    a.ybuf = (unsigned char*)d_ws + WS_Y;
    a.ph_lo = 0; a.ph_hi = MK_STAGE;
    hipLaunchKernelGGL(mk_fwd, dim3(grid), dim3(NWAVES * 64), LDS_BYTES, stream, a);

}
```

```cpp
#include <hip/hip_runtime.h>
#include <cstdio>
#include <cstdint>
#include <cmath>
#define MK_STAGE 99
#define GAS __attribute__((address_space(1)))
#define LAS __attribute__((address_space(3)))
typedef unsigned short bf16_t;
typedef short bf16x8 __attribute__((ext_vector_type(8)));
typedef short s16x4 __attribute__((ext_vector_type(4)));
typedef float f32x4 __attribute__((ext_vector_type(4)));
typedef float f32x2 __attribute__((ext_vector_type(2)));
typedef float f32x16 __attribute__((ext_vector_type(16)));
typedef unsigned u32x4 __attribute__((ext_vector_type(4)));
typedef unsigned u32x2 __attribute__((ext_vector_type(2)));

constexpr int NB = 8, SEQ = 4096, T = NB * SEQ, DM = 1024, DIN = 2304, NMEMT = NB * 256;
constexpr int NWAVES = 8;
constexpr float EPSN = 1e-6f;

constexpr size_t MiBx = 1u << 20;
constexpr size_t WS_CTL = 0, CTL_ZERO_BYTES = 65536;
constexpr size_t WS_WR = 1 * MiBx;
constexpr size_t WS_ROPE = WS_WR + 98304;
constexpr size_t WS_WIN = 2 * MiBx;
constexpr size_t WS_WOUT = 8 * MiBx;
constexpr size_t WS_WQM = 10 * MiBx;
constexpr size_t WS_WKV = 11 * MiBx;
constexpr size_t WS_WOM = 13 * MiBx;
constexpr size_t WS_WGU = 14 * MiBx;
constexpr size_t WS_WD = 288 * MiBx;
constexpr size_t WS_MEMN = 62 * MiBx;
constexpr size_t WS_KVM = 66 * MiBx;
constexpr size_t WS_KF = 70 * MiBx;
constexpr size_t WS_MOE = 86 * MiBx;
constexpr size_t WS_RMS0 = WS_MOE + 2 * MiBx + 512 * 1024;
constexpr size_t WS_XN = 96 * MiBx;
constexpr size_t WS_UHT = 336 * MiBx;
constexpr size_t WS_QKV = 432 * MiBx;
constexpr size_t WS_YHT = 224 * MiBx;
constexpr size_t WS_Y = 160 * MiBx;
constexpr size_t WS_ZS = 256 * MiBx;
constexpr size_t WS_QM = 336 * MiBx, WS_OM = 368 * MiBx;
constexpr size_t WS_END = 480 * MiBx;
constexpr int CW_TMO = 0, CW_BAR = 4096;
constexpr int CW_FN = 8192;
constexpr int CW_CNT = 9472;
static_assert((CW_CNT + 24 * 64) * 4 <= (int)CTL_ZERO_BYTES, "ctl region");

constexpr int RING_BYTES = 131072;
constexpr int LDS_BYTES = 147456;
constexpr int MISC_OFF = LDS_BYTES - 512;

#define LDS_WAIT() asm volatile("s_waitcnt lgkmcnt(0)" ::: "memory")
#define VM_WAIT() asm volatile("s_waitcnt vmcnt(0)" ::: "memory")
__device__ __forceinline__ unsigned f2bf(float f) { unsigned u = __builtin_bit_cast(unsigned, f); return (u + 0x7fffu + ((u >> 16) & 1u)) >> 16; }
__device__ __forceinline__ unsigned pk2(float lo, float hi) { return f2bf(lo) | (f2bf(hi) << 16); }
__device__ __forceinline__ float bf2f(unsigned short b) { return __builtin_bit_cast(float, (unsigned)b << 16); }
__device__ __forceinline__ float bflo(unsigned w) { return __builtin_bit_cast(float, w << 16); }
__device__ __forceinline__ float bfhi(unsigned w) { return __builtin_bit_cast(float, w & 0xffff0000u); }
__device__ __forceinline__ float wsum_sw(float v) {
#define SWZ_(m) v += __int_as_float(__builtin_amdgcn_ds_swizzle(__float_as_int(v), 0x1F | ((m) << 10)))
    SWZ_(1); SWZ_(2); SWZ_(4); SWZ_(8); SWZ_(16);
#undef SWZ_
    return __int_as_float(__builtin_amdgcn_readlane(__float_as_int(v), 0)) + __int_as_float(__builtin_amdgcn_readlane(__float_as_int(v), 32));
}
__device__ __forceinline__ float wsum(float v) {
#pragma unroll
    for (int o = 1; o < 64; o <<= 1) v += __shfl_xor(v, o);
    return v;
}

namespace pg8 {
constexpr int BM = 256, BK = 64, HALF = 128, HTB = HALF * BK * 2, STAGE_BYTES = 8 * HTB;
__host__ __device__ __forceinline__ int lds_byte(int r, int c) { const int st = (r >> 4) * 2 + (c >> 5), rr = r & 15, cc = c & 31, ob = rr * 64 + cc * 2; return st * 1024 + (ob ^ (((ob >> 9) & 1) << 5)); }
__host__ __device__ __forceinline__ void stage_rc(int b, int& R, int& C) { const int st = b / 1024, sb = b % 1024, swz = sb ^ (((sb >> 9) & 1) << 5); R = (st >> 1) * 16 + swz / 64; C = (st & 1) * 32 + (swz % 64) / 2; }
__host__ __device__ __forceinline__ int perm32(int rho) { const int n = rho >> 4, i = rho & 15; return 8 * (i >> 2) + 4 * n + (i & 3); }

struct Unit { const char* A; const char* B; const int* rows; int pm, pn, aux, flags, kt, nvalid; };
__device__ __forceinline__ unsigned cvt_pk_bf16(float lo, float hi) { unsigned r; asm volatile("v_cvt_pk_bf16_f32 %0, %1, %2" : "=v"(r) : "v"(lo), "v"(hi)); return r; }

template <class Epi, class Sched, bool GATHER = false>
__device__ __forceinline__ void gemm_phase(LAS unsigned char* lds, const int lda, const int ldb, const int K, const Sched& S, const Epi& E) {
    const int tid = threadIdx.x, wid = __builtin_amdgcn_readfirstlane(tid >> 6), lane = tid & 63, wr = wid >> 2, wc = wid & 3, fr = lane & 15, fq = lane >> 4;
    (void)K;
    unsigned voffA[2], voffB[2]; int rowA[2]; unsigned colA[2];
#pragma unroll
    for (int i = 0; i < 2; ++i) { int R, C; stage_rc(tid * 16 + i * 8192, R, C); const int Rb = (R & ~31) + perm32(R & 31);
        voffA[i] = (unsigned)(R * lda + C) * 2u; voffB[i] = (unsigned)(Rb * ldb + C) * 2u; rowA[i] = R; colA[i] = (unsigned)C * 2u; }
    unsigned gA[2][2], gN[2][2];
    const size_t kstep = (size_t)(BK * 2);
    const size_t hstepA = (size_t)HALF * lda * 2, hstepB = (size_t)HALF * ldb * 2;
    const unsigned ldsw = (unsigned)wid * 1024u;
    const int aoff = lds_byte(wr * 64 + fr, fq * 8), boff = lds_byte(wc * 32 + fr, fq * 8);
#define PG8_SA(b, h) (((b) * 2 + (h)) * HTB)
#define PG8_SB(b, h) ((4 + (b) * 2 + (h)) * HTB)
#define PG8_STAGE(bufoff, gbase, voff) do { _Pragma("unroll") for (int _i = 0; _i < 2; ++_i) \
        __builtin_amdgcn_global_load_lds((const unsigned*)((const char*)(gbase) + (voff)[_i]), (LAS unsigned*)(lds + (bufoff) + ldsw + _i * 8192), 16, 0, 0); } while (0)
#define PG8_STAGE_A(bufoff, gbase, H, G_) do { _Pragma("unroll") for (int _i = 0; _i < 2; ++_i) \
        __builtin_amdgcn_global_load_lds((const unsigned*)((const char*)(gbase) + (GATHER ? G_[H][_i] : ((H) ? (unsigned)hstepA : 0u) + voffA[_i])), (LAS unsigned*)(lds + (bufoff) + ldsw + _i * 8192), 16, 0, 0); } while (0)
#define PG8_ROWOFF(G_, U_) do { if constexpr (GATHER) { _Pragma("unroll") for (int _h = 0; _h < 2; ++_h) _Pragma("unroll") for (int _i = 0; _i < 2; ++_i) G_[_h][_i] = S.rowoff(U_, rowA[_i] + 128 * _h) + colA[_i]; } } while (0)
#define PG8_LDA(dst, b, h) do { _Pragma("unroll") for (int m = 0; m < 4; ++m) _Pragma("unroll") for (int k = 0; k < 2; ++k) dst[m][k] = *(const LAS bf16x8*)(lds + PG8_SA(b, h) + aoff + m * 2048 + k * 1024); } while (0)
#define PG8_LDB(dst, b, h) do { _Pragma("unroll") for (int n = 0; n < 2; ++n) _Pragma("unroll") for (int k = 0; k < 2; ++k) dst[n][k] = *(const LAS bf16x8*)(lds + PG8_SB(b, h) + boff + n * 2048 + k * 1024); } while (0)
#define PG8_MMA(ai, bj, At, Bt) do { __builtin_amdgcn_s_setprio(1); _Pragma("unroll") for (int m = 0; m < 4; ++m) _Pragma("unroll") for (int n = 0; n < 2; ++n) _Pragma("unroll") for (int k = 0; k < 2; ++k) \
        acc[ai][bj][m][n] = __builtin_amdgcn_mfma_f32_16x16x32_bf16(Bt[n][k], At[m][k], acc[ai][bj][m][n], 0, 0, 0); __builtin_amdgcn_s_setprio(0); } while (0)
#define PG8_WAIT_V(n) asm volatile("s_waitcnt vmcnt(" #n ")" ::: "memory")
#define PG8_WAIT_L(n) asm volatile("s_waitcnt lgkmcnt(" #n ")" ::: "memory")
#define PG8_BAR __builtin_amdgcn_s_barrier()
#define PG8_SCHED __builtin_amdgcn_sched_barrier(0)
#define PG8_ZERO() do { _Pragma("unroll") for (int a = 0; a < 2; ++a) _Pragma("unroll") for (int b = 0; b < 2; ++b) _Pragma("unroll") for (int m = 0; m < 4; ++m) _Pragma("unroll") for (int n = 0; n < 2; ++n) acc[a][b][m][n] = (f32x4){0.f, 0.f, 0.f, 0.f}; } while (0)
    Unit cur, nxt; int ui = 0;
    if (!S.next(0, cur)) return;
    f32x4 acc[2][2][4][2];
    PG8_ZERO();
    bf16x8 At[4][2], B0[2][2], B1[2][2];
    const char* cA = cur.A; const char* cB = cur.B;
    PG8_ROWOFF(gA, cur);
    PG8_STAGE(PG8_SB(0, 0), cB, voffB); PG8_STAGE(PG8_SB(0, 1), cB + hstepB, voffB); PG8_STAGE_A(PG8_SA(0, 0), cA, 0, gA); PG8_STAGE_A(PG8_SA(0, 1), cA, 1, gA);
    if (wr == 1) PG8_BAR;
    PG8_WAIT_V(2); PG8_BAR;
    PG8_STAGE(PG8_SB(1, 0), cB + kstep, voffB); PG8_STAGE_A(PG8_SA(1, 0), cA + kstep, 0, gA); PG8_STAGE(PG8_SB(1, 1), cB + hstepB + kstep, voffB);
    PG8_WAIT_V(6); PG8_BAR;
    for (;;) {
        const bool has_next = S.next(ui + 1, nxt);
        const char* nA = has_next ? nxt.A : cA; const char* nB = has_next ? nxt.B : cB;
        if (has_next) PG8_ROWOFF(gN, nxt); else if constexpr (GATHER) { _Pragma("unroll") for (int _h = 0; _h < 2; ++_h) _Pragma("unroll") for (int _i = 0; _i < 2; ++_i) gN[_h][_i] = gA[_h][_i]; }
        const int nt = cur.kt;
        for (int t = 0; t < nt; t += 2) {
            const bool last = (t == nt - 2);
            const char* a1 = cA + (size_t)(t + 1) * kstep;
            const char* a2 = last ? nA : cA + (size_t)(t + 2) * kstep; const char* b2 = last ? nB : cB + (size_t)(t + 2) * kstep;
            const char* a3 = a2 + kstep; const char* b3 = b2 + kstep;
            unsigned g2[2][2];
            if constexpr (GATHER) { _Pragma("unroll") for (int _h = 0; _h < 2; ++_h) _Pragma("unroll") for (int _i = 0; _i < 2; ++_i) g2[_h][_i] = last ? gN[_h][_i] : gA[_h][_i]; }
            PG8_LDB(B0, 0, 0); PG8_LDB(B1, 0, 1); PG8_SCHED; PG8_LDA(At, 0, 0); PG8_STAGE_A(PG8_SA(1, 1), a1, 1, gA);
            PG8_WAIT_V(8); PG8_WAIT_L(0); PG8_BAR; PG8_MMA(0, 0, At, B0); PG8_MMA(0, 1, At, B1); PG8_BAR; PG8_SCHED;
            PG8_LDA(At, 0, 1); PG8_STAGE(PG8_SB(0, 0), b2, voffB); PG8_STAGE(PG8_SB(0, 1), b2 + hstepB, voffB); PG8_STAGE_A(PG8_SA(0, 0), a2, 0, g2);
            PG8_WAIT_V(8); PG8_WAIT_L(0); PG8_BAR; PG8_MMA(1, 0, At, B0); PG8_MMA(1, 1, At, B1); PG8_BAR; PG8_SCHED;
            PG8_LDB(B0, 1, 0); PG8_LDB(B1, 1, 1); PG8_SCHED; PG8_LDA(At, 1, 0); PG8_STAGE_A(PG8_SA(0, 1), a2, 1, g2);
            PG8_WAIT_V(8); PG8_WAIT_L(0); PG8_BAR; PG8_MMA(0, 0, At, B0); PG8_MMA(0, 1, At, B1); PG8_BAR; PG8_SCHED;
            PG8_LDA(At, 1, 1); PG8_STAGE(PG8_SB(1, 0), b3, voffB); PG8_STAGE(PG8_SB(1, 1), b3 + hstepB, voffB); PG8_STAGE_A(PG8_SA(1, 0), a3, 0, g2);
            PG8_WAIT_V(8); PG8_WAIT_L(0); PG8_BAR; PG8_MMA(1, 0, At, B0); PG8_MMA(1, 1, At, B1); PG8_BAR; PG8_SCHED;
        }
        if (wr == 0) PG8_BAR;
        if (cur.flags & 2) E(acc, cur, wr, wc, fr, fq);
        if (!has_next) break;
        if (nxt.flags & 1) PG8_ZERO();
        cur = nxt; cA = nA; cB = nB; ++ui;
        if constexpr (GATHER) { _Pragma("unroll") for (int _h = 0; _h < 2; ++_h) _Pragma("unroll") for (int _i = 0; _i < 2; ++_i) gA[_h][_i] = gN[_h][_i]; }
        if (wr == 1) PG8_BAR;
    }
    PG8_WAIT_V(0);
    PG8_BAR;
#undef PG8_SA
#undef PG8_SB
#undef PG8_STAGE
#undef PG8_STAGE_A
#undef PG8_ROWOFF
#undef PG8_LDA
#undef PG8_LDB
#undef PG8_MMA
#undef PG8_WAIT_V
#undef PG8_WAIT_L
#undef PG8_BAR
#undef PG8_SCHED
#undef PG8_ZERO
}
}

#define XB_TMO      128
#define XB_XCNT(j)  (256  + 64 * (j))
#define XB_XSUB(j)  (1280 + 64 * (j))
#define XB_XGEN(j)  (2304 + 64 * (j))
#define XB_TOP      3328
#define XB_TOPGEN   3392
#define XCD_BAR_WORDS 3456
#define XB_SPIN_CAP (1u << 18)
__device__ __forceinline__ unsigned xb_ld(unsigned* p)              { return __hip_atomic_load(p, __ATOMIC_RELAXED, __HIP_MEMORY_SCOPE_AGENT); }
__device__ __forceinline__ unsigned xb_add(unsigned* p, unsigned v) { return __hip_atomic_fetch_add(p, v, __ATOMIC_RELAXED, __HIP_MEMORY_SCOPE_AGENT); }
__device__ __forceinline__ unsigned xb_xcc_id() { return (unsigned)__builtin_amdgcn_s_getreg((3 << 11) | 20) & 0xFu; }
#define XB_SPIN(cond, bar) do { unsigned _sp = 0; while (cond) { __builtin_amdgcn_s_sleep(1); \
    if ((++_sp & 255u) == 0u) { if (xb_ld(&(bar)[XB_TMO])) break; if (_sp > XB_SPIN_CAP) { atomicAdd(&(bar)[XB_TMO], 1u); break; } } } } while (0)
struct XcdBarrier { unsigned* bar; unsigned x; volatile LAS unsigned* st; };
__device__ __forceinline__ XcdBarrier xcd_barrier_post(unsigned* bar, volatile LAS unsigned* st) {
    XcdBarrier b; b.bar = bar; b.x = xb_xcc_id(); b.st = st;
    if (threadIdx.x == 0) (void)xb_add(&bar[XB_XCNT(b.x)], 1u);
    return b;
}
__device__ __forceinline__ void xcd_barrier_complete(unsigned* bar, unsigned x, unsigned& nloc, unsigned& nx) {
    const unsigned G = gridDim.x * gridDim.y * gridDim.z;
    unsigned sum, cnt, mine, sp = 0u;
    for (;;) {
        sum = 0u; cnt = 0u; mine = 0u;
#pragma unroll
        for (unsigned j = 0; j < 16; ++j) { const unsigned c = xb_ld(&bar[XB_XCNT(j)]); sum += c; cnt += (c > 0u) ? 1u : 0u; mine = (j == x) ? c : mine; }
        if (sum == G) break;
        __builtin_amdgcn_s_sleep(1);
        if ((++sp & 255u) == 0u) { if (xb_ld(&bar[XB_TMO])) break; if (sp > XB_SPIN_CAP) { atomicAdd(&bar[XB_TMO], 1u); break; } }
    }
    nloc = mine > 0u ? mine : 1u; nx = cnt > 0u ? cnt : 1u;
}
__device__ __forceinline__ void xcd_barrier(const XcdBarrier& b) {
    asm volatile("s_waitcnt vmcnt(0)" ::: "memory");
    __syncthreads();
    if (threadIdx.x == 0) {
        unsigned* bar = b.bar;
        __builtin_amdgcn_s_waitcnt(0);
        unsigned nloc = b.st[0], nx = b.st[1];
        if (nloc == 0u) { xcd_barrier_complete(bar, b.x, nloc, nx); b.st[0] = nloc; b.st[1] = nx; }
        const unsigned old = xb_add(&bar[XB_XSUB(b.x)], 1u);
        const unsigned gen = old / nloc;
        if (old + 1u == (gen + 1u) * nloc) {
            __builtin_amdgcn_fence(__ATOMIC_RELEASE, "agent");
            asm volatile("s_waitcnt vmcnt(0)" ::: "memory");
            const unsigned og = xb_add(&bar[XB_TOP], 1u);
            const unsigned tg = og / nx;
            if (og + 1u == (tg + 1u) * nx) xb_add(&bar[XB_TOPGEN], 1u);
            else XB_SPIN(xb_ld(&bar[XB_TOPGEN]) == tg, bar);
            __builtin_amdgcn_fence(__ATOMIC_ACQUIRE, "agent");
            xb_add(&bar[XB_XGEN(b.x)], 1u);
            asm volatile("s_waitcnt vmcnt(0)" ::: "memory");
        } else {
            XB_SPIN(xb_ld(&bar[XB_XGEN(b.x)]) == gen, bar);
            __builtin_amdgcn_fence(__ATOMIC_ACQUIRE, "agent");
            asm volatile("s_waitcnt vmcnt(0)" ::: "memory");
        }
    }
    __syncthreads();
}

struct Frame {
    LAS unsigned char* lds;
    unsigned* ctl;
    unsigned char* ws;
    const float* const* in;
    float* out;
    int tid, lane, wave, vcu, G;
};

#ifndef MK_TSB
#define MK_TSB 0
#endif
#ifdef MK_TS
#define TSI(k) do { if ((k) == MK_TS && blockIdx.x == MK_TSB && threadIdx.x == 0) { const unsigned long long t_ = __builtin_amdgcn_s_memrealtime(); ((volatile LAS unsigned*)(F.lds + MISC_OFF))[60] = (unsigned)t_; ((volatile LAS unsigned*)(F.lds + MISC_OFF))[61] = (unsigned)(t_ >> 32); } } while (0)
#else
#define TSI(k) do {} while (0)
#endif
template <bool GU> __device__ __forceinline__ void p0_transpose_item(const float* W, int N, int k0, int n0, bf16_t* dst, int ldk, const float* gain, LAS unsigned char* scr, int lane) {
    constexpr int TP = 264;
#pragma unroll 4
    for (int i = 0; i < 16; ++i) { const int kk = 2 * i + (lane >> 5); f32x4 v = *(const f32x4*)(W + (size_t)(k0 + kk) * N + n0 + 4 * (lane & 31)); if (gain) v = v * gain[k0 + kk];
        u32x2 w; w[0] = pk2(v[0], v[1]); w[1] = pk2(v[2], v[3]); *(LAS u32x2*)(scr + kk * TP + 8 * (lane & 31)) = w; }
    LDS_WAIT(); asm volatile("" ::: "memory");
#pragma unroll 2
    for (int sI = 0; sI < 8; ++sI) { const int n = 16 * sI + (lane >> 2), kc = lane & 3; unsigned short e[8];
#pragma unroll
        for (int q = 0; q < 8; ++q) e[q] = *(const LAS unsigned short*)(scr + (8 * kc + q) * TP + 2 * n);
        u32x4 o; o.x = e[0] | ((unsigned)e[1] << 16); o.y = e[2] | ((unsigned)e[3] << 16); o.z = e[4] | ((unsigned)e[5] << 16); o.w = e[6] | ((unsigned)e[7] << 16);
        const int drow = GU ? ((n >> 7) * 256 + (n & 127)) : n;
        *(GAS u32x4*)(dst + (size_t)drow * ldk + 8 * kc) = o; }
    LDS_WAIT(); asm volatile("" ::: "memory");
}
template <int NR> __device__ __forceinline__ void rms_rows_to_bf16(const float* x, bf16_t* o, float* rms, int row0, int lane) {
    f32x4 v[NR][4];
#pragma unroll
    for (int r = 0; r < NR; ++r) { const GAS f32x4* xr = (const GAS f32x4*)(x + (size_t)(row0 + r) * 1024) + lane;
#pragma unroll
        for (int j = 0; j < 4; ++j) v[r][j] = xr[64 * j]; }
#pragma unroll
    for (int r = 0; r < NR; ++r) { float s = 0.f;
#pragma unroll
        for (int j = 0; j < 4; ++j) s += (v[r][j].x * v[r][j].x + v[r][j].y * v[r][j].y) + (v[r][j].z * v[r][j].z + v[r][j].w * v[r][j].w);
        const float ms = wsum(s) * (1.f / 1024.f) + EPSN; const float rstd = 1.f / sqrtf(ms);
        if (rms && lane == 0) rms[row0 + r] = sqrtf(ms);
        GAS unsigned long long* o8 = (GAS unsigned long long*)(o + (size_t)(row0 + r) * 1024) + lane;
#pragma unroll
        for (int j = 0; j < 4; ++j) o8[64 * j] = (unsigned long long)pk2(v[r][j].x * rstd, v[r][j].y * rstd) | ((unsigned long long)pk2(v[r][j].z * rstd, v[r][j].w * rstd) << 32); }
}
__device__ __forceinline__ void rms2_load(f32x4 (&v)[2][4], const float* x, int row0, int lane) {
#pragma unroll
    for (int r = 0; r < 2; ++r) { const GAS f32x4* xr = (const GAS f32x4*)(x + (size_t)(row0 + r) * 1024) + lane;
#pragma unroll
        for (int j = 0; j < 4; ++j) v[r][j] = xr[64 * j]; }
}
__device__ __forceinline__ void rms2_finish(const f32x4 (&v)[2][4], bf16_t* o, float* rms, int row0, int lane) {
#pragma unroll
    for (int r = 0; r < 2; ++r) { float s = 0.f;
#pragma unroll
        for (int j = 0; j < 4; ++j) s += (v[r][j].x * v[r][j].x + v[r][j].y * v[r][j].y) + (v[r][j].z * v[r][j].z + v[r][j].w * v[r][j].w);
        const float ms = wsum(s) * (1.f / 1024.f) + EPSN; const float rstd = 1.f / sqrtf(ms);
        if (lane == 0) rms[row0 + r] = sqrtf(ms);
        GAS unsigned long long* o8 = (GAS unsigned long long*)(o + (size_t)(row0 + r) * 1024) + lane;
#pragma unroll
        for (int j = 0; j < 4; ++j) o8[64 * j] = (unsigned long long)pk2(v[r][j].x * rstd, v[r][j].y * rstd) | ((unsigned long long)pk2(v[r][j].z * rstd, v[r][j].w * rstd) << 32); }
}
__device__ __forceinline__ void p0_prologue(Frame& F) {
    const int gw = F.vcu * NWAVES + F.wave, NGW = F.G * NWAVES;
    const float* const* in = F.in;
    unsigned char* ws = F.ws;
    int xn_m = 2 * gw;
    {
        LAS float* zs = (LAS float*)(F.lds + 8 * 16384);
        LAS float* a1s = zs + 16 * 34;
        LAS float* a2s = a1s + 16 * 64;
        const float* w1 = in[6]; const float* b1 = in[7]; const float* w2 = in[8]; const float* b2 = in[9]; const float* w3 = in[10]; const float* freq = in[11];
        bf16_t* KF = (bf16_t*)(ws + WS_KF);
        for (int pb = F.vcu; pb < SEQ / 16; pb += F.G) {
            __syncthreads();
            for (int zi = F.tid; zi < 16 * 33; zi += NWAVES * 64) {
                const int p = zi / 33, f = zi % 33, pos = pb * 16 + p;
                const float tt = (float)pos / (float)(SEQ - 1);
                const float w = (2.0f * 3.14159265358979323846f / (float)SEQ) * (float)pos;
                float val;
                if (f == 0) val = tt;
                else { const int j = (f - 1) & 15; const float band = 1e-4f + (float)j * ((15.0f - 1e-4f) / 15.0f); val = (f <= 16) ? cosf(band * w) : sinf(band * w); }
                zs[p * 34 + f] = val;
            }
            __syncthreads();
            {
                LAS float* w1s = (LAS float*)(F.lds); LAS float* w2s = w1s + 33 * 64;
                for (int i = F.tid; i < 33 * 64; i += NWAVES * 64) w1s[i] = w1[i];
                for (int i = F.tid; i < 64 * 64; i += NWAVES * 64) w2s[i] = w2[i];
                __syncthreads();
#pragma unroll
                for (int pp = 0; pp < 2; ++pp) { const int p = F.wave * 2 + pp; float s = b1[F.lane];
#pragma unroll 11
                    for (int i = 0; i < 33; ++i) s += zs[p * 34 + i] * w1s[i * 64 + F.lane];
                    a1s[p * 64 + F.lane] = sinf(freq[F.lane] * s); }
                __syncthreads();
#pragma unroll
                for (int pp = 0; pp < 2; ++pp) { const int p = F.wave * 2 + pp; float s = b2[F.lane];
#pragma unroll 8
                    for (int i = 0; i < 64; ++i) s += a1s[p * 64 + i] * w2s[i * 64 + F.lane];
                    a2s[p * 64 + F.lane] = sinf(freq[64 + F.lane] * s); }
            }
            __syncthreads();
            float acc[16][4];
#pragma unroll
            for (int p = 0; p < 16; ++p)
#pragma unroll
                for (int j = 0; j < 4; ++j) acc[p][j] = 0.f;
            f32x4 nxtw[8];
#pragma unroll
            for (int k = 0; k < 8; ++k) nxtw[k] = *(const f32x4*)(w3 + 4 * (F.tid + 512 * k));
#pragma unroll 1
            for (int fc = 0; fc < 8; ++fc) {
                __syncthreads();
#pragma unroll
                for (int k = 0; k < 8; ++k) *(LAS f32x4*)(F.lds + 16 * (F.tid + 512 * k)) = nxtw[k];
                if (fc < 7) {
#pragma unroll
                    for (int k = 0; k < 8; ++k) nxtw[k] = *(const f32x4*)(w3 + (size_t)(8 * (fc + 1)) * 2048 + 4 * (F.tid + 512 * k)); }
                f32x4 xv[2][4]; const int xm = xn_m; const bool xdo = xm < T;
                if (xdo) { rms2_load(xv, in[0], xm, F.lane); xn_m += 2 * NGW; }
                __syncthreads();
#pragma unroll 2
                for (int f = 0; f < 8; ++f) {
                    float wv[4];
#pragma unroll
                    for (int j = 0; j < 4; ++j) wv[j] = *(const LAS float*)(F.lds + 4 * (f * 2048 + F.tid + 512 * j));
#pragma unroll
                    for (int p = 0; p < 16; ++p) { const float a = a2s[p * 64 + 8 * fc + f];
#pragma unroll
                        for (int j = 0; j < 4; ++j) acc[p][j] += a * wv[j]; }
                }
                if (xdo) rms2_finish(xv, (bf16_t*)(ws + WS_XN), (float*)(ws + WS_RMS0), xm, F.lane);
            }
            const float dlo = logf(1e-2f) / 1.5f, dhi = logf(1e-2f) / 0.3f;
#pragma unroll
            for (int j = 0; j < 4; ++j) {
                const int col = F.tid + 512 * j, o = col >> 10, dir = (col >> 9) & 1, c = col & 511;
                const float delta = fabsf(dlo + (float)c * ((dhi - dlo) / 511.0f));
                bf16_t* kf = KF + ((size_t)o * 512 + c) * 8192 + dir * 4096 + pb * 16;
#pragma unroll
                for (int hh = 0; hh < 2; ++hh) {
                    float v[8];
#pragma unroll
                    for (int p = 0; p < 8; ++p) { const int pos = pb * 16 + hh * 8 + p; v[p] = acc[hh * 8 + p][j] * expf(-((float)pos / (float)(SEQ - 1)) * delta); }
                    if (dir == 1 && pb == 0 && hh == 0) v[0] = acc[0][j - 1];
                    u32x4 w;
#pragma unroll
                    for (int p = 0; p < 4; ++p) w[p] = pk2(v[2 * p], v[2 * p + 1]);
                    *(u32x4*)(kf + hh * 8) = w;
                }
            }
        }
        __syncthreads();
    }
    TSI(20);
    {
        constexpr int I_IN = 32 * 18, I_OUT = 32 * 8, I_Q = 32 * 4, I_OM = 16 * 8;
        constexpr int NITEMS_P0 = I_IN + I_OUT + 3 * I_Q + I_OM;
        LAS unsigned char* scrb = F.lds + F.wave * 16384;
        for (int it = gw; it < NITEMS_P0; it += NGW) {
            int r = it;
            if (r < I_IN) { const int kb = r / 18, nb = r % 18; p0_transpose_item<false>(in[3], DIN, 32 * kb, 128 * nb, (bf16_t*)(ws + WS_WIN) + (size_t)(128 * nb) * 1024 + 32 * kb, 1024, in[2], scrb, F.lane); continue; } r -= I_IN;
            if (r < I_OUT) { const int kb = r / 8, nb = r % 8; const float* gn = (kb < 16) ? in[15] : in[16] - 512; p0_transpose_item<false>(in[17], 1024, 32 * kb, 128 * nb, (bf16_t*)(ws + WS_WOUT) + (size_t)(128 * nb) * 1024 + 32 * kb, 1024, gn, scrb, F.lane); continue; } r -= I_OUT;
            if (r < I_Q) { const int kb = r / 4, nb = r % 4; p0_transpose_item<false>(in[20], 512, 32 * kb, 128 * nb, (bf16_t*)(ws + WS_WQM) + (size_t)(128 * nb) * 1024 + 32 * kb, 1024, in[18], scrb, F.lane); continue; } r -= I_Q;
            if (r < I_Q) { const int kb = r / 4, nb = r % 4; p0_transpose_item<false>(in[21], 512, 32 * kb, 128 * nb, (bf16_t*)(ws + WS_WKV) + (size_t)(128 * nb) * 1024 + 32 * kb, 1024, in[19], scrb, F.lane); continue; } r -= I_Q;
            if (r < I_Q) { const int kb = r / 4, nb = r % 4; p0_transpose_item<false>(in[22], 512, 32 * kb, 128 * nb, (bf16_t*)(ws + WS_WKV) + (size_t)(512 + 128 * nb) * 1024 + 32 * kb, 1024, in[19], scrb, F.lane); continue; } r -= I_Q;
            if (r < I_OM) { const int kb = r / 8, nb = r % 8; p0_transpose_item<false>(in[25], 1024, 32 * kb, 128 * nb, (bf16_t*)(ws + WS_WOM) + (size_t)(128 * nb) * 512 + 32 * kb, 512, nullptr, scrb, F.lane); continue; } r -= I_OM;
        }
    }
    TSI(21);
    {
        float* WR = (float*)(ws + WS_WR);
        for (int i = (F.vcu * NWAVES * 64) + F.tid; i < 20 * 1024; i += F.G * NWAVES * 64) { const int j = i >> 10, k = i & 1023;
            WR[i] = (j < 4 ? in[27][k * 4 + j] : in[29][k * 16 + (j - 4)]) * in[26][k]; }
    }
    {
        float* rope = (float*)(ws + WS_ROPE);
        for (int i = (F.vcu * NWAVES * 64) + F.tid; i < 1024; i += F.G * NWAVES * 64) { const float ang = (float)(i >> 4) * powf(10000.0f, -(float)(i & 15) / 16.0f); rope[i] = cosf(ang); rope[1024 + i] = sinf(ang); }
    }
    for (int m = xn_m; m < T; m += 2 * NGW) rms_rows_to_bf16<2>(in[0], (bf16_t*)(ws + WS_XN), (float*)(ws + WS_RMS0), m, F.lane);
    for (int m = gw; m < NMEMT; m += NGW) rms_rows_to_bf16<1>(in[1], (bf16_t*)(ws + WS_MEMN), nullptr, m, F.lane);
}

struct P1Sched {
    int G, vcu; const char *win, *xn, *memn, *wkv;
    __device__ __forceinline__ bool next(int i, pg8::Unit& u) const {
        int L = i * G + vcu; constexpr size_t TILE = (size_t)256 * 1024 * 2;
        if (L < 768) { u.pm = L % 6; u.pn = L / 6; u.A = win + (size_t)u.pm * TILE; u.B = xn + (size_t)u.pn * TILE; u.aux = 0; }
        else if (L < 1152) { L -= 768; u.pn = L % 3; u.pm = L / 3; u.A = xn + (size_t)u.pm * TILE; u.B = win + (size_t)(6 + u.pn) * TILE; u.aux = 1; }
        else if (L < 1184) { L -= 1152; u.pn = L % 4; u.pm = L / 4; u.A = memn + (size_t)u.pm * TILE; u.B = wkv + (size_t)u.pn * TILE; u.aux = 2; }
        else return false;
        u.flags = 3; u.kt = 16; return true;
    }
};
__device__ __forceinline__ void store_tile_bf16(const f32x4 (&acc)[2][2][4][2], bf16_t* base, int ld, int row0, int col0) {
#pragma unroll
    for (int ai = 0; ai < 2; ++ai)
#pragma unroll
        for (int m = 0; m < 4; ++m) { bf16_t* rowp = base + (size_t)(row0 + ai * 128 + m * 16) * ld + col0;
#pragma unroll
            for (int bj = 0; bj < 2; ++bj) { const f32x4 v0 = acc[ai][bj][m][0], v1 = acc[ai][bj][m][1];
                u32x4 w; w.x = pg8::cvt_pk_bf16(v0[0], v0[1]); w.y = pg8::cvt_pk_bf16(v0[2], v0[3]); w.z = pg8::cvt_pk_bf16(v1[0], v1[1]); w.w = pg8::cvt_pk_bf16(v1[2], v1[3]);
                *(u32x4*)(rowp + bj * 128) = w; } }
}
struct EpiBf16Multi {
    unsigned char* ws;
    __device__ __forceinline__ void operator()(const f32x4 (&acc)[2][2][4][2], const pg8::Unit& u, int wr, int wc, int fr, int fq) const {
        const int row0 = u.pm * 256 + wr * 64 + fr, col0 = u.pn * 256 + wc * 32 + 8 * fq;
        if (u.aux == 0) store_tile_bf16(acc, (bf16_t*)(ws + WS_UHT), T, row0, col0);
        else if (u.aux == 1) store_tile_bf16(acc, (bf16_t*)(ws + WS_QKV), 768, row0, col0);
        else store_tile_bf16(acc, (bf16_t*)(ws + WS_KVM), 1024, row0, col0);
    }
};


__device__ __forceinline__ void kprep_tile(Frame& F, int pm) {
    bf16_t* QKV = (bf16_t*)(F.ws + WS_QKV); const float* rope = (const float*)(F.ws + WS_ROPE); const float* gk = F.in[14];
    const int row = pm * 256 + (F.tid >> 1), kh = F.tid & 1; const int t = row & (SEQ - 1);
    bf16_t* p = QKV + (size_t)row * 768 + 512 + kh * 64;
    u32x4 w[8]; float v[64]; float ss = 0.f;
#pragma unroll
    for (int k = 0; k < 8; ++k) w[k] = *(const u32x4*)(p + 8 * k);
#pragma unroll
    for (int k = 0; k < 8; ++k)
#pragma unroll
        for (int j = 0; j < 4; ++j) { v[8 * k + 2 * j] = bflo(w[k][j]); v[8 * k + 2 * j + 1] = bfhi(w[k][j]); ss += v[8 * k + 2 * j] * v[8 * k + 2 * j] + v[8 * k + 2 * j + 1] * v[8 * k + 2 * j + 1]; }
    const float rstd = 1.0f / sqrtf(ss * (1.0f / 64.0f) + EPSN);
#pragma unroll
    for (int d = 0; d < 64; ++d) v[d] *= rstd * gk[d];
#pragma unroll
    for (int sec = 0; sec < 2; ++sec) { const int pos = sec ? (t & 63) : (t >> 6);
#pragma unroll
        for (int i = 0; i < 16; ++i) { const float c = rope[pos * 16 + i], sn = rope[1024 + pos * 16 + i]; const float x1 = v[32 * sec + i], x2 = v[32 * sec + 16 + i];
            v[32 * sec + i] = x1 * c - x2 * sn; v[32 * sec + 16 + i] = x2 * c + x1 * sn; } }
#pragma unroll
    for (int k = 0; k < 8; ++k) { u32x4 o;
#pragma unroll
        for (int j = 0; j < 4; ++j) o[j] = pk2(v[8 * k + 2 * j], v[8 * k + 2 * j + 1]);
        *(u32x4*)(p + 8 * k) = o; }
}
__device__ __forceinline__ void kmem_norm_tile(Frame& F, int pm, int pn) {
    bf16_t* KVM = (bf16_t*)(F.ws + WS_KVM); const float* g = F.in[24];
    const int row = pm * 256 + (F.tid >> 1), hh = F.tid & 1;
    bf16_t* p = KVM + (size_t)row * 1024 + pn * 256 + hh * 128;
    u32x4 w[16]; float ss = 0.f;
#pragma unroll
    for (int k = 0; k < 16; ++k) w[k] = *(const u32x4*)(p + 8 * k);
#pragma unroll
    for (int k = 0; k < 16; ++k)
#pragma unroll
        for (int j = 0; j < 4; ++j) { const float a = bflo(w[k][j]), b2 = bfhi(w[k][j]); ss += a * a + b2 * b2; }
    const float rstd = 1.0f / sqrtf(ss * (1.0f / 128.0f) + EPSN);
#pragma unroll
    for (int k = 0; k < 16; ++k) { u32x4 o;
#pragma unroll
        for (int j = 0; j < 4; ++j) o[j] = pk2(bflo(w[k][j]) * rstd * g[8 * k + 2 * j], bfhi(w[k][j]) * rstd * g[8 * k + 2 * j + 1]);
        *(u32x4*)(p + 8 * k) = o; }
}

namespace at {
constexpr int D = 64, PQ = 768, PO = 1024;
constexpr int NW = 8, QBLK = 32, QB = QBLK * NW, KVBLK = 64;
__device__ __forceinline__ int crow(int r, int hi) { return (r & 3) + 8 * (r >> 2) + 4 * hi; }
#define SBAR() __builtin_amdgcn_sched_barrier(0)
constexpr int NSLOT = 3, SLOTB = 8192;
constexpr int LDS_K = 0, LDS_V = NSLOT * SLOTB, LDS_WS = 2 * NSLOT * SLOTB, LDS_OST = LDS_WS + NW * 64 * 4, LDS_BYTES_AT = LDS_OST + NW * 4096;
constexpr float C2 = 0.125f * 1.4426950408889634f;
__device__ __forceinline__ void glds16(const void* gsrc, unsigned lds_dst) { unsigned keep;
    asm volatile("s_mov_b32 %0, m0\n\ts_mov_b32 m0, %2\n\ts_nop 0\n\tglobal_load_lds_dwordx4 %1, off\n\ts_mov_b32 m0, %0" : "=&s"(keep) : "v"(gsrc), "s"(lds_dst) : "memory"); }
__device__ __forceinline__ float max3f(float a, float b, float c) { float r; asm("v_max3_f32 %0, %1, %2, %3" : "=v"(r) : "v"(a), "v"(b), "v"(c)); return r; }
__device__ __forceinline__ float max2f(float a, float b) { float r; asm("v_max_f32_e32 %0, %1, %2" : "=v"(r) : "v"(a), "v"(b)); return r; }
__device__ __forceinline__ float fadd_s(float a, float b) { float r; asm("v_add_f32_e32 %0, %1, %2" : "=v"(r) : "v"(a), "v"(b)); return r; }
__device__ __forceinline__ float fsub_s(float a, float b) { float r; asm("v_sub_f32_e32 %0, %1, %2" : "=v"(r) : "v"(a), "v"(b)); return r; }
typedef __bf16 bf16x2_t __attribute__((ext_vector_type(2)));
__device__ __forceinline__ unsigned cvtpk_s(float lo, float hi) { f32x2 v = {lo, hi}; bf16x2_t b = __builtin_convertvector(v, bf16x2_t); return __builtin_bit_cast(unsigned, b); }
#define WAIT_BAR(N) asm volatile("s_waitcnt vmcnt(" #N ") lgkmcnt(0)\n\ts_barrier" ::: "memory")
__device__ __forceinline__ void qkt(f32x16& p0, f32x16& p1, const char* Kslot, const bf16x8* qr, const f32x16& negm, int r32, int hi) {
    const char* kb = Kslot + hi * 1024 + r32 * 16;
#pragma unroll
    for (int d0 = 0; d0 < 4; ++d0) {
        const bf16x8 b0 = *reinterpret_cast<const bf16x8*>(kb + d0 * 2048);
        const bf16x8 b1 = *reinterpret_cast<const bf16x8*>(kb + d0 * 2048 + 512);
        if (d0 == 0) { p0 = __builtin_amdgcn_mfma_f32_32x32x16_bf16(b0, qr[0], negm, 0, 0, 0); p1 = __builtin_amdgcn_mfma_f32_32x32x16_bf16(b1, qr[0], negm, 0, 0, 0); }
        else { p0 = __builtin_amdgcn_mfma_f32_32x32x16_bf16(b0, qr[d0], p0, 0, 0, 0); p1 = __builtin_amdgcn_mfma_f32_32x32x16_bf16(b1, qr[d0], p1, 0, 0, 0); } }
}
typedef LAS const char* lds_cptr;
typedef short v4i16_t __attribute__((ext_vector_type(4)));
__device__ __forceinline__ void kload8(bf16x8* kf, lds_cptr kp) {
    kf[0] = *(const LAS bf16x8*)(kp);        kf[1] = *(const LAS bf16x8*)(kp + 512);
    kf[2] = *(const LAS bf16x8*)(kp + 2048); kf[3] = *(const LAS bf16x8*)(kp + 2560);
    kf[4] = *(const LAS bf16x8*)(kp + 4096); kf[5] = *(const LAS bf16x8*)(kp + 4608);
    kf[6] = *(const LAS bf16x8*)(kp + 6144); kf[7] = *(const LAS bf16x8*)(kp + 6656);
}
__device__ __forceinline__ void kload2(bf16x8* kf, lds_cptr kp, int j) { kf[2 * j] = *(const LAS bf16x8*)(kp + j * 2048); kf[2 * j + 1] = *(const LAS bf16x8*)(kp + j * 2048 + 512); }
__device__ __forceinline__ s16x4 vtr(lds_cptr p) { return __builtin_bit_cast(s16x4, __builtin_amdgcn_ds_read_tr16_b64_v4i16((LAS v4i16_t*)p)); }
__device__ __forceinline__ float rowmax(const f32x16& p0, const f32x16& p1) {
    float a = max3f(p0[0], p0[1], p1[0]), b = max3f(p0[2], p0[3], p1[1]); a = max3f(a, p1[2], p1[3]);
#pragma unroll
    for (int r = 4; r < 16; r += 4) { a = max3f(a, p0[r], p0[r + 1]); b = max3f(b, p0[r + 2], p0[r + 3]); a = max3f(a, p1[r], p1[r + 1]); b = max3f(b, p1[r + 2], p1[r + 3]); }
    const float m = max2f(a, b);
    auto rr = __builtin_amdgcn_permlane32_swap(__float_as_uint(m), __float_as_uint(m), false, false);
    return max2f(__uint_as_float(rr[0]), __uint_as_float(rr[1]));
}
__device__ __forceinline__ void pv(f32x16* o, int vb, bf16x8 pa0, bf16x8 pa1, bf16x8 pa2, bf16x8 pa3) {
#pragma unroll
    for (int d0 = 0; d0 < 2; ++d0) { s16x4 lo[4], hi[4];
#pragma unroll
        for (int ks = 0; ks < 4; ++ks) {
            asm volatile("ds_read_b64_tr_b16 %0,%1 offset:%c2" : "=&v"(lo[ks]) : "v"(vb), "i"(d0 * 4096 + ks * 1024) : "memory");
            asm volatile("ds_read_b64_tr_b16 %0,%1 offset:%c2" : "=&v"(hi[ks]) : "v"(vb), "i"(d0 * 4096 + ks * 1024 + 512) : "memory"); }
        asm volatile("s_waitcnt lgkmcnt(0)" ::: "memory"); SBAR();
#define PK(k) (bf16x8){lo[k][0], lo[k][1], lo[k][2], lo[k][3], hi[k][0], hi[k][1], hi[k][2], hi[k][3]}
        o[d0] = __builtin_amdgcn_mfma_f32_32x32x16_bf16(pa0, PK(0), o[d0], 0, 0, 0);
        o[d0] = __builtin_amdgcn_mfma_f32_32x32x16_bf16(pa1, PK(1), o[d0], 0, 0, 0);
        o[d0] = __builtin_amdgcn_mfma_f32_32x32x16_bf16(pa2, PK(2), o[d0], 0, 0, 0);
        o[d0] = __builtin_amdgcn_mfma_f32_32x32x16_bf16(pa3, PK(3), o[d0], 0, 0, 0);
#undef PK
    }
}
template <int THRL> __device__ __forceinline__ void attn_unit(int b, int h, int qb, const bf16_t* QKV, bf16_t* Y, const float* gq, const float* gk, const float* rope, char* shm) {
    const int tid = threadIdx.x, lane = tid & 63, r32 = lane & 31, hi = lane >> 5; const int wid = __builtin_amdgcn_readfirstlane(tid >> 6);
    const long rowbase = (long)b * SEQ; const int q0 = qb * QB; const int kvh = h >> 2;
    const bf16_t* Qw = QKV + (rowbase + q0 + wid * QBLK) * PQ + h * D;
    const bf16_t* Kh = QKV + rowbase * PQ + 512 + kvh * D; const bf16_t* Vh = QKV + rowbase * PQ + 640 + kvh * D;
    const unsigned lds0 = (unsigned)(uintptr_t)shm;
    float* wsf = (float*)(shm + LDS_WS) + wid * 64;
    const bf16_t* ksrc = Kh + (long)lane * PQ + wid * 8;
    const bf16_t* vsrc = Vh + (long)(16 * (wid & 3) + (lane >> 2)) * PQ + (wid >> 2) * 32 + (lane & 3) * 8;
    const unsigned kdst = lds0 + LDS_K + wid * 1024, vdst = lds0 + LDS_V + wid * 1024;
#define DMA_K(t, slot) glds16(ksrc + (long)(t) * KVBLK * PQ, (unsigned)__builtin_amdgcn_readfirstlane(kdst + (slot)))
#define DMA_V(t, slot) glds16(vsrc + (long)(t) * KVBLK * PQ, (unsigned)__builtin_amdgcn_readfirstlane(vdst + (slot)))
    const int vb0 = (int)(lds0 + LDS_V) + ((lane >> 4) & 1) * 32 + (lane & 3) * 8 + (4 * hi + ((lane & 15) >> 2)) * 64;
    const char* Kbase = shm + LDS_K; bf16x8 kf[8];
    const lds_cptr shm3 = (lds_cptr)shm; const lds_cptr kp0 = shm3 + LDS_K + hi * 1024 + r32 * 16; const lds_cptr vp0 = shm3 + LDS_V + ((lane >> 4) & 1) * 32 + (lane & 3) * 8 + (4 * hi + ((lane & 15) >> 2)) * 64;
    constexpr int NT = SEQ / KVBLK;
    DMA_K(0, 0); DMA_V(0, 0); DMA_K(1, SLOTB);
    bf16x8 qr[4];
    {
        float qf[4][8]; float ss = 0.f;
#pragma unroll
        for (int d0 = 0; d0 < 4; ++d0) { const u32x4 w = *reinterpret_cast<const u32x4*>(&Qw[(long)r32 * PQ + d0 * 16 + hi * 8]);
#pragma unroll
            for (int j = 0; j < 4; ++j) { qf[d0][2 * j] = bflo(w[j]); qf[d0][2 * j + 1] = bfhi(w[j]); }
#pragma unroll
            for (int j = 0; j < 8; ++j) ss += qf[d0][j] * qf[d0][j]; }
        ss += __shfl_xor(ss, 32);
        const float rstd = C2 / sqrtf(ss * (1.0f / 64.0f) + EPSN);
#pragma unroll
        for (int d0 = 0; d0 < 4; ++d0) { const f32x4 g0 = *(const f32x4*)(gq + d0 * 16 + hi * 8), g1 = *(const f32x4*)(gq + d0 * 16 + hi * 8 + 4);
#pragma unroll
            for (int j = 0; j < 4; ++j) { qf[d0][j] *= rstd * g0[j]; qf[d0][4 + j] *= rstd * g1[j]; } }
        const int tq = q0 + wid * QBLK + r32;
#pragma unroll
        for (int sec = 0; sec < 2; ++sec) { const int pos = sec ? (tq & 63) : (tq >> 6);
            const f32x4 c0 = *(const f32x4*)(rope + pos * 16 + hi * 8), c1 = *(const f32x4*)(rope + pos * 16 + hi * 8 + 4);
            const f32x4 s0 = *(const f32x4*)(rope + 1024 + pos * 16 + hi * 8), s1 = *(const f32x4*)(rope + 1024 + pos * 16 + hi * 8 + 4);
#pragma unroll
            for (int j = 0; j < 8; ++j) { const float c = j < 4 ? c0[j & 3] : c1[j & 3], sn = j < 4 ? s0[j & 3] : s1[j & 3];
                const float x1 = qf[2 * sec][j], x2 = qf[2 * sec + 1][j];
                qf[2 * sec][j] = x1 * c - x2 * sn; qf[2 * sec + 1][j] = x2 * c + x1 * sn; } }
#pragma unroll
        for (int d0 = 0; d0 < 4; ++d0) { u32x4 w;
#pragma unroll
            for (int j = 0; j < 4; ++j) w[j] = cvtpk_s(qf[d0][2 * j], qf[d0][2 * j + 1]);
            qr[d0] = __builtin_bit_cast(bf16x8, w); }
    }
    float l_reg = 0.f; f32x16 o[2]; o[0] = f32x16{}; o[1] = f32x16{}; const f32x16 negm = f32x16{};

#define START(P0, P1) do { _Pragma("unroll") for (int r = 0; r < 16; ++r) P0[r] = __builtin_amdgcn_exp2f(P0[r]); } while (0)
#define RESC() do {} while (0)
    f32x16 pA0, pA1, pB0, pB1;
    int sl_prev = 0, sl_cur = 0, sl_next = SLOTB;
#define ROT() do { sl_prev = sl_cur; sl_cur = sl_next; sl_next = (sl_next == (NSLOT - 1) * SLOTB) ? 0 : sl_next + SLOTB; } while (0)
    DMA_K(2, 2 * SLOTB);
    WAIT_BAR(3);
    qkt(pA0, pA1, Kbase, qr, negm, r32, hi); asm volatile("s_nop 15\n\ts_nop 7" : "+v"(pA0), "+v"(pA1));
    START(pA0, pA1);
    _Pragma("unroll") for (int r = 0; r < 16; ++r) pA1[r] = __builtin_amdgcn_exp2f(pA1[r]);
    WAIT_BAR(0);
    DMA_K(3, 0); DMA_V(1, SLOTB);
    ROT();
    kload8(kf, kp0 + sl_cur);
    WAIT_BAR(2);
    s16x4 vlo[8], vhi[8]; u32x4 pw0, pw1, pw2, pw3;
#define PKW(P, B) cvtpk_s(P[B], P[B + 1])
#define PAF(k) __builtin_bit_cast(bf16x8, pw##k)
#define VFR(i) (bf16x8){vlo[i][0], vlo[i][1], vlo[i][2], vlo[i][3], vhi[i][0], vhi[i][1], vhi[i][2], vhi[i][3]}
#define PIN(x) asm volatile("" : "+v"(x))
#define MX3(a, b, c) __builtin_fmaxf(__builtin_fmaxf((a), (b)), (c))
#define GAPA(MF, A0, A1, A2, A3, W0, W1, PW) do { MF; sacc += A0; sacc += A1; sacc += A2; sacc += A3; PIN(sacc); W0; W1; PIN(PW); SBAR(); } while (0)
#define EX(v) __builtin_amdgcn_exp2f(v)
#define GAPB(MF, X, B) do { MF; X[B] = EX(X[B]); X[B + 1] = EX(X[B + 1]); X[B + 2] = EX(X[B + 2]); X[B + 3] = EX(X[B + 3]); PIN(X); SBAR(); } while (0)
#define VRD(i) do { vlo[i] = vtr(vp_ + (((i) >> 2) * 4096 + ((i) & 3) * 1024)); vhi[i] = vtr(vp_ + (((i) >> 2) * 4096 + ((i) & 3) * 1024 + 512)); } while (0)
#define KRD(G, j) do { if (G) { kload2(kf, kp0 + sl_next, j); SBAR(); } } while (0)
#define STEP(C0, C1, P0, P1, t, GK, GV, GL) do { SBAR(); \
    const lds_cptr vp_ = vp0 + sl_prev; \
    VRD(0); SBAR(); float sacc = (P0[0] + P0[1]); \
    GAPA(C0 = __builtin_amdgcn_mfma_f32_32x32x16_bf16(kf[0], qr[0], negm, 0, 0, 0), P0[2], P0[3], P0[4], P0[5],     pw0[0] = PKW(P0, 0), pw0[1] = PKW(P0, 2), pw0); \
    VRD(4); SBAR(); GAPA(C1 = __builtin_amdgcn_mfma_f32_32x32x16_bf16(kf[1], qr[0], negm, 0, 0, 0), P0[6], P0[7], P0[8], P0[9],     pw0[2] = PKW(P0, 4), pw0[3] = PKW(P0, 6), pw0); \
    VRD(1); SBAR(); GAPA(C0 = __builtin_amdgcn_mfma_f32_32x32x16_bf16(kf[2], qr[1], C0, 0, 0, 0),   P0[10], P0[11], P0[12], P0[13], pw1[0] = PKW(P0, 8), pw1[1] = PKW(P0, 10), pw1); \
    VRD(5); SBAR(); GAPA(C1 = __builtin_amdgcn_mfma_f32_32x32x16_bf16(kf[3], qr[1], C1, 0, 0, 0),   P0[14], P0[15], P1[0], P1[1],   pw1[2] = PKW(P0, 12), pw1[3] = PKW(P0, 14), pw1); \
    VRD(2); SBAR(); GAPA(C0 = __builtin_amdgcn_mfma_f32_32x32x16_bf16(kf[4], qr[2], C0, 0, 0, 0),   P1[2], P1[3], P1[4], P1[5],     pw2[0] = PKW(P1, 0), pw2[1] = PKW(P1, 2), pw2); \
    VRD(6); SBAR(); GAPA(C1 = __builtin_amdgcn_mfma_f32_32x32x16_bf16(kf[5], qr[2], C1, 0, 0, 0),   P1[6], P1[7], P1[8], P1[9],     pw2[2] = PKW(P1, 4), pw2[3] = PKW(P1, 6), pw2); \
    VRD(3); SBAR(); GAPA(C0 = __builtin_amdgcn_mfma_f32_32x32x16_bf16(kf[6], qr[3], C0, 0, 0, 0),   P1[10], P1[11], P1[12], P1[13], pw3[0] = PKW(P1, 8), pw3[1] = PKW(P1, 10), pw3); \
    VRD(7); SBAR(); GAPA(C1 = __builtin_amdgcn_mfma_f32_32x32x16_bf16(kf[7], qr[3], C1, 0, 0, 0),   P1[14], P1[15], 0.f, 0.f,       pw3[2] = PKW(P1, 12), pw3[3] = PKW(P1, 14), pw3); \
    l_reg += sacc; \
    if (GK) { DMA_K((t) + 3, sl_cur); } if (GV) { DMA_V((t) + 1, sl_next); } \
    SBAR(); \
    GAPB(o[0] = __builtin_amdgcn_mfma_f32_32x32x16_bf16(PAF(0), VFR(0), o[0], 0, 0, 0), C0, 0); \
    GAPB(o[1] = __builtin_amdgcn_mfma_f32_32x32x16_bf16(PAF(0), VFR(4), o[1], 0, 0, 0), C0, 4); \
    KRD(GL, 0); GAPB(o[0] = __builtin_amdgcn_mfma_f32_32x32x16_bf16(PAF(1), VFR(1), o[0], 0, 0, 0), C0, 8); \
    KRD(GL, 1); GAPB(o[1] = __builtin_amdgcn_mfma_f32_32x32x16_bf16(PAF(1), VFR(5), o[1], 0, 0, 0), C0, 12); \
    KRD(GL, 2); GAPB(o[0] = __builtin_amdgcn_mfma_f32_32x32x16_bf16(PAF(2), VFR(2), o[0], 0, 0, 0), C1, 0); \
    KRD(GL, 3); GAPB(o[1] = __builtin_amdgcn_mfma_f32_32x32x16_bf16(PAF(2), VFR(6), o[1], 0, 0, 0), C1, 4); \
    GAPB(o[0] = __builtin_amdgcn_mfma_f32_32x32x16_bf16(PAF(3), VFR(3), o[0], 0, 0, 0), C1, 8); \
    GAPB(o[1] = __builtin_amdgcn_mfma_f32_32x32x16_bf16(PAF(3), VFR(7), o[1], 0, 0, 0), C1, 12); \
    } while (0)
    int t = 1;
    for (; t + 5 < NT; t += 2) {
        STEP(pB0, pB1, pA0, pA1, t, true, true, true);     WAIT_BAR(2); RESC(); ROT();
        STEP(pA0, pA1, pB0, pB1, t + 1, true, true, true); WAIT_BAR(2); RESC(); ROT();
    }
#define ENDW(tt) do { if ((tt) + 3 < NT) { WAIT_BAR(2); } else if ((tt) + 2 < NT) { WAIT_BAR(1); } else { WAIT_BAR(0); } } while (0)
    for (; t + 1 < NT; t += 2) {
        STEP(pB0, pB1, pA0, pA1, t, (t + 3 < NT), (t + 1 < NT), (t + 1 < NT));         ENDW(t);     RESC(); ROT();
        STEP(pA0, pA1, pB0, pB1, t + 1, (t + 4 < NT), (t + 2 < NT), (t + 2 < NT));     ENDW(t + 1); RESC(); ROT();
    }
    STEP(pB0, pB1, pA0, pA1, NT - 1, false, false, false); RESC();
    { float sacc = pB0[0] + pB0[1]; _Pragma("unroll") for (int r = 2; r < 16; ++r) sacc += pB0[r]; _Pragma("unroll") for (int r = 0; r < 16; ++r) sacc += pB1[r]; l_reg += sacc;
      pw0 = (u32x4){PKW(pB0, 0), PKW(pB0, 2), PKW(pB0, 4), PKW(pB0, 6)}; pw1 = (u32x4){PKW(pB0, 8), PKW(pB0, 10), PKW(pB0, 12), PKW(pB0, 14)}; pw2 = (u32x4){PKW(pB1, 0), PKW(pB1, 2), PKW(pB1, 4), PKW(pB1, 6)}; pw3 = (u32x4){PKW(pB1, 8), PKW(pB1, 10), PKW(pB1, 12), PKW(pB1, 14)};
      SBAR(); pv(o, vb0 + sl_cur, PAF(0), PAF(1), PAF(2), PAF(3)); }
#undef PKW
#undef PAF
#undef VFR
#undef PIN
#undef MX3
#undef GAPA
#undef GAPB
#undef EX
#undef VRD
#undef KRD
#undef STEP
#undef ENDW
    { auto rr = __builtin_amdgcn_permlane32_swap(__float_as_uint(l_reg), __float_as_uint(l_reg), false, false); l_reg = __uint_as_float(rr[0]) + __uint_as_float(rr[1]); }
    if (hi == 0) wsf[32 + r32] = l_reg; asm volatile("s_waitcnt lgkmcnt(0)" ::: "memory");
    float rli[16];
#pragma unroll
    for (int r = 0; r < 16; ++r) rli[r] = __builtin_amdgcn_rcpf(wsf[32 + crow(r, hi)]);
    bf16_t* Ow = Y + (rowbase + q0 + wid * QBLK) * PO + 512 + h * D;
    { bf16_t* stg = (bf16_t*)(shm + LDS_OST) + wid * 2048;
#pragma unroll
      for (int r = 0; r < 16; ++r) { const int orow = crow(r, hi);
#pragma unroll
        for (int d0 = 0; d0 < 2; ++d0) stg[orow * 64 + d0 * 32 + r32] = (bf16_t)f2bf(o[d0][r] * rli[r]); }
      asm volatile("s_waitcnt lgkmcnt(0)" ::: "memory");
#pragma unroll
      for (int i = 0; i < 4; ++i) { const int row = i * 8 + (lane >> 3), ch = lane & 7; const u32x4 v = *(const u32x4*)(stg + row * 64 + ch * 8);
        float f[8]; float ss = 0.f;
#pragma unroll
        for (int j = 0; j < 4; ++j) { f[2 * j] = bflo(v[j]); f[2 * j + 1] = bfhi(v[j]); ss += f[2 * j] * f[2 * j] + f[2 * j + 1] * f[2 * j + 1]; }
        ss += __shfl_xor(ss, 1); ss += __shfl_xor(ss, 2); ss += __shfl_xor(ss, 4);
        const float rs = 1.0f / sqrtf(ss * (1.0f / 64.0f) + EPSN);
        u32x4 w;
#pragma unroll
        for (int j = 0; j < 4; ++j) w[j] = pk2(f[2 * j] * rs, f[2 * j + 1] * rs);
        *(u32x4*)(Ow + (long)row * PO + ch * 8) = w; } }
    asm volatile("s_waitcnt lgkmcnt(0)\n\ts_barrier" ::: "memory");
#undef DMA_K
#undef DMA_V
#undef START
#undef RESC
#undef ROT
}
#undef SBAR
#undef WAIT_BAR
}

namespace bgtr {
constexpr int NIT = 16 * 3 * 1024;
constexpr int SCR = 115200, SCRW = 2560;
struct State { int it, pend; };
struct Desc { const float* W; const float* gain; bf16_t* dst; int N, k0, n0; };
__device__ __forceinline__ Desc desc(int it, const float* const* in, unsigned char* ws) {
    const int e = it / 3072, r = it % 3072, mat = r >> 10, q = r & 1023; Desc d;
    if (mat < 2) { const int kb = q >> 4, nb = q & 15; d.k0 = 16 * kb; d.n0 = 32 * nb; d.N = 512; d.W = in[mat ? 32 : 31] + (size_t)e * 1024 * 512; d.gain = in[26];
        d.dst = (bf16_t*)(ws + WS_WGU) + ((size_t)e * 1024 + 256 * (d.n0 >> 7) + (d.n0 & 127) + 128 * mat) * 1024 + d.k0; }
    else { const int kb = q >> 5, nb = q & 31; d.k0 = 16 * kb; d.n0 = 32 * nb; d.N = 1024; d.W = in[33] + (size_t)e * 512 * 1024; d.gain = nullptr;
        d.dst = (bf16_t*)(ws + WS_WD) + ((size_t)e * 1024 + d.n0) * 1024 + d.k0; }
    return d;
}
__device__ __forceinline__ void glds16(const void* gsrc, unsigned lds_dst) { unsigned keep;
    asm volatile("s_mov_b32 %0, m0\n\ts_mov_b32 m0, %2\n\ts_nop 0\n\tglobal_load_lds_dwordx4 %1, off\n\ts_mov_b32 m0, %0" : "=&s"(keep) : "v"(gsrc), "s"(lds_dst) : "memory"); }
__device__ __forceinline__ void glds4(const void* gsrc, unsigned lds_dst) { unsigned keep;
    asm volatile("s_mov_b32 %0, m0\n\ts_mov_b32 m0, %2\n\ts_nop 0\n\tglobal_load_lds_dword %1, off\n\ts_mov_b32 m0, %0" : "=&s"(keep) : "v"(gsrc), "s"(lds_dst) : "memory"); }
__device__ __forceinline__ void step(State& S, int stride, const float* const* in, unsigned char* ws, LAS unsigned char* lds, unsigned tile, int lane) {
    asm volatile("" : "+v"(lane));
    if (S.pend) { const Desc d = desc(S.it, in, ws); const int n = lane & 31, kh = lane >> 5;
        asm volatile("s_waitcnt vmcnt(0)" ::: "memory");
        u32x4 o;
#pragma unroll
        for (int h = 0; h < 2; ++h) { float x[4];
#pragma unroll
            for (int j = 0; j < 4; ++j) x[j] = *(const LAS float*)(lds + tile + kh * 1152 + (4 * h + j) * 128 + 4 * n);
            if (d.gain) { const f32x4 g0 = *(const LAS f32x4*)(lds + tile + 2304 + 16 * (2 * kh + h));
#pragma unroll
                for (int j = 0; j < 4; ++j) x[j] *= g0[j]; }
            o[2 * h] = pg8::cvt_pk_bf16(x[0], x[1]); o[2 * h + 1] = pg8::cvt_pk_bf16(x[2], x[3]); }
        *(GAS u32x4*)(d.dst + (size_t)n * 1024 + 8 * kh) = o;
        S.it += stride; }
    if (S.it < NIT) { const Desc d = desc(S.it, in, ws);
        const float* g = d.W + (size_t)(d.k0 + (lane >> 3)) * d.N + d.n0 + 4 * (lane & 7);
        asm volatile("s_waitcnt lgkmcnt(0)" ::: "memory");
        glds16(g, tile); glds16(g + (size_t)8 * d.N, tile + 1152u);
        if (d.gain) glds4(d.gain + d.k0 + (lane & 15), tile + 2304u);
        S.pend = 1; }
    else S.pend = 0;
}
}

namespace hy {
constexpr int PADT = 512, ZT = SEQ + 2 * PADT, SB = ZT * 2 + 32;
constexpr int LZ = 0, LF0 = 8 * SB, LF1 = LF0 + 16384 + 68, LRED = LF1 + 16384 + 12, LEND = LRED + 64;
static_assert(LEND <= bgtr::SCR && bgtr::SCR + 8 * bgtr::SCRW <= MISC_OFF, "hyena + background-transposer LDS map");
static_assert(LF0 % 16 == 0 && LEND <= RING_BYTES, "hyena LDS map");
__device__ __forceinline__ int crow(int r, int hi) { return (r & 3) + 8 * (r >> 2) + 4 * hi; }
__device__ __forceinline__ void hyena_unit(int c, const bf16_t* UHT, bf16_t* ZS, bf16_t* YHT, const bf16_t* KF, const float* FN, const float* sw, const float* sbias, const float* skip, LAS unsigned char* lds,
                                           bgtr::State& BG, int bgstride, const float* const* in, unsigned char* ws) {
    int tid_ = threadIdx.x; asm volatile("" : "+v"(tid_));
    const int tid = tid_, lane = tid & 63, wid = __builtin_amdgcn_readfirstlane(tid >> 6);
    const int r32 = lane & 31, hi = lane >> 5;
    __syncthreads();
    if (tid < 17) *(LAS unsigned*)(lds + LF0 + 16384 + 4 * tid) = 0u;
    for (int i = tid; i < 8 * 2 * (PADT / 8); i += 512) { const int b = i / (2 * (PADT / 8)), rem = i % (2 * (PADT / 8)); const int side = rem / (PADT / 8), k = rem % (PADT / 8);
        unsigned z0 = 0u; asm volatile("" : "+v"(z0)); *(LAS u32x4*)(lds + LZ + b * SB + 2 * (side * (PADT + SEQ) + 8 * k)) = (u32x4){z0, z0, z0, z0}; }
#pragma unroll 1
    for (int ord = 0; ord < 2; ++ord) {
        {
            const bf16_t* kfp = KF + ((size_t)ord * 512 + c) * 8192; float as = 0.f;
            const u32x4 wf = *(const u32x4*)(kfp + 8 * tid), wb = *(const u32x4*)(kfp + 4096 + 8 * tid);
            *(LAS u32x4*)(lds + LF0 + 2 * (4096 + 8 * tid)) = wb;
#pragma unroll
            for (int j = 0; j < 4; ++j) { const int m = 4096 - 8 * tid - 2 * j;
                if (tid + j > 0) *(LAS bf16_t*)(lds + LF0 + 2 * m) = (bf16_t)(wf[j] & 0xffffu);
                *(LAS bf16_t*)(lds + LF0 + 2 * (m - 1)) = (bf16_t)(wf[j] >> 16);
                as += fabsf(bflo(wf[j])) + fabsf(bfhi(wf[j])) + fabsf(bflo(wb[j])) + fabsf(bfhi(wb[j])); }
            if (tid == 0) { *(LAS bf16_t*)(lds + LF0) = 0; as -= fabsf(bflo(wb[0])); }
            as = wsum_sw(as); if (lane == 0) *(LAS float*)(lds + LRED + 4 * wid) = as; }
        { const int cc = ord * 512 + c; const float w0 = sw[cc], w1 = sw[1536 + cc], w2 = sw[3072 + cc], bb = sbias[cc];
          const bf16_t* u = UHT + (size_t)cc * T; const bf16_t* zs = ZS + (size_t)c * T;
#pragma unroll 1
          for (int kh = 0; kh < 2; ++kh) {
            u32x4 wv[4], zv[4]; float pv_[4], nx_[4];
#pragma unroll
            for (int kk = 0; kk < 4; ++kk) { const int id = tid + 512 * (4 * kh + kk), b = id >> 9, t8 = (id & 511) * 8; const size_t g = (size_t)b * SEQ + t8;
                wv[kk] = *(const u32x4*)(u + g); pv_[kk] = t8 > 0 ? bf2f(u[g - 1]) : 0.f; nx_[kk] = t8 + 8 < SEQ ? bf2f(u[g + 8]) : 0.f;
                if (ord == 1) zv[kk] = *(const u32x4*)(zs + g); }
#pragma unroll
            for (int kk = 0; kk < 4; ++kk) { const int id = tid + 512 * (4 * kh + kk), b = id >> 9, t8 = (id & 511) * 8;
                const u32x4 w = wv[kk];
                float x[10]; x[0] = pv_[kk]; x[9] = nx_[kk];
#pragma unroll
                for (int j = 0; j < 4; ++j) { x[1 + 2 * j] = bflo(w[j]); x[2 + 2 * j] = bfhi(w[j]); }
                float y[8];
#pragma unroll
                for (int j = 0; j < 8; ++j) y[j] = w0 * x[j] + w1 * x[j + 1] + w2 * x[j + 2] + bb;
                if (ord == 1) { const u32x4 zw = zv[kk];
#pragma unroll
                    for (int j = 0; j < 4; ++j) { y[2 * j] *= bflo(zw[j]); y[2 * j + 1] *= bfhi(zw[j]); } }
                u32x4 ow;
#pragma unroll
                for (int j = 0; j < 4; ++j) ow[j] = pk2(y[2 * j], y[2 * j + 1]);
                *(LAS u32x4*)(lds + LZ + b * SB + 2 * (PADT + t8)) = ow; } } }
        __syncthreads();
#pragma unroll 2
        for (int k = 0; k < 8; ++k) { const int i = tid + 512 * k; const unsigned lo = *(const LAS unsigned*)(lds + LF0 + 4 * i), hi2 = (i < 4095) ? *(const LAS unsigned*)(lds + LF0 + 4 * i + 4) : 0u;
            *(LAS unsigned*)(lds + LF1 + 4 * i) = (lo >> 16) | (hi2 << 16); }
        __syncthreads();
        int ln_ = lane; asm volatile("" : "+v"(ln_));
        const unsigned bgtile = (unsigned)__builtin_amdgcn_readfirstlane(bgtr::SCR + wid * bgtr::SCRW);
        const int r16 = ln_ & 15, g4 = ln_ >> 4;
        const int bcol = ((r16 >> 2) & 1) | (((r16 >> 3) & 1) << 1) | (((r16 >> 1) & 1) << 2), pcol = r16 & 1;
        const int Dlo = 16 * wid - 127;
        f32x4 acc[8][2];
#pragma unroll
        for (int u = 0; u < 8; ++u) { acc[u][0] = (f32x4){0.f, 0.f, 0.f, 0.f}; acc[u][1] = (f32x4){0.f, 0.f, 0.f, 0.f}; }
        const int m0 = 4096 - 32 * Dlo - r16 + 8 * g4;
        const unsigned a0 = (r16 & 1) ? (unsigned)(LF1 + 2 * (m0 - 1)) : (unsigned)(LF0 + 2 * m0);
        const unsigned b0 = (unsigned)(LZ + bcol * SB + 2 * (PADT + 32 * (pcol + 127) + 8 * g4)) - 384u;
#define H16_LDA(A_, d_, a_) do { const unsigned ab_ = a0 - 416u - 64u * (unsigned)(d_); _Pragma("unroll") for (int j = 0; j < 4; ++j) { u32x4 t_; _Pragma("unroll") for (int e = 0; e < 4; ++e) t_[e] = *(const LAS unsigned*)(lds + ab_ + (128 * (3 - j) + 32 * (1 - (a_)) + 4 * e)); A_[j] = __builtin_bit_cast(bf16x8, t_); } } while (0)
#define H16_LDB(B_, d_) do { const unsigned bb_ = b0 - 64u * (unsigned)(d_); _Pragma("unroll") for (int m = 0; m < 11; ++m) B_[m] = *(const LAS bf16x8*)(lds + bb_ + 128 * m); } while (0)
#define H16_MMA(A_, B_, a_, COND) do { _Pragma("unroll") for (int j = 0; j < 4; ++j) _Pragma("unroll") for (int u = 0; u < 8; ++u) if (COND) acc[u][a_] = __builtin_amdgcn_mfma_f32_16x16x32_bf16(A_[j], B_[u - j + 3], acc[u][a_], 0, 0, 0); } while (0)
#define H16_SB() __builtin_amdgcn_sched_barrier(0)
#define H16_PAIR(k_, CE_, CO_, BGS_) do { const int dE = 8 * (k_); \
            H16_LDA(Ay, dE, 1); H16_SB(); H16_MMA(Ax, Bx, 0, CE_); H16_SB(); BGS_; H16_SB(); H16_LDA(Ax, dE + 1, 0); H16_LDB(By, dE + 1); H16_SB(); H16_MMA(Ay, Bx, 1, CE_); H16_SB(); \
            H16_LDA(Ay, dE + 1, 1); H16_SB(); H16_MMA(Ax, By, 0, CO_); H16_SB(); H16_LDA(Ax, dE + 8, 0); H16_LDB(Bx, dE + 8); H16_SB(); H16_MMA(Ay, By, 1, CO_); H16_SB(); } while (0)
        {
            bf16x8 Ax[4], Ay[4], Bx[11], By[11];
            H16_LDA(Ax, 0, 0); H16_LDB(Bx, 0);
            H16_PAIR(0, u <= j, u <= j, (void)0);
            H16_PAIR(1, u <= j + 4, u <= j + 4, (void)0);
            int kEnd = 16; asm volatile("" : "+s"(kEnd));
#pragma unroll 1
            for (int k = 2; k < kEnd; ++k) H16_PAIR(k, true, true, bgtr::step(BG, bgstride, in, ws, lds, bgtile, lane));
            H16_PAIR(16, u >= j, u >= j + 1, (void)0);
            H16_PAIR(17, u >= j + 4, u >= j + 5, (void)0);
        }
#undef H16_LDA
#undef H16_LDB
#undef H16_MMA
#undef H16_SB
#undef H16_PAIR
        float l1 = 0.f;
#pragma unroll
        for (int k = 0; k < 8; ++k) l1 += *(const LAS float*)(lds + LRED + 4 * k);
        const float inv = 1.0f / (l1 + 1e-6f), sk = skip[ord * 512 + c];
        bf16_t* dst = (ord == 0 ? ZS : YHT) + (size_t)c * T + (size_t)bcol * SEQ;
#pragma unroll
        for (int u = 0; u < 8; ++u)
#pragma unroll
            for (int a = 0; a < 2; ++a) { const int t4 = 32 * (2 * (8 * wid + u) + pcol) + 16 * a + 4 * g4;
                const u32x2 zw = *(const LAS u32x2*)(lds + LZ + bcol * SB + 2 * (PADT + t4));
                const float z0 = bflo(zw[0]), z1 = bfhi(zw[0]), z2 = bflo(zw[1]), z3 = bfhi(zw[1]);
                u32x2 ow; ow[0] = pk2(acc[u][a][0] * inv + sk * z0, acc[u][a][1] * inv + sk * z1); ow[1] = pk2(acc[u][a][2] * inv + sk * z2, acc[u][a][3] * inv + sk * z3);
                *(u32x2*)(dst + t4) = ow; }
        VM_WAIT();
        __syncthreads();
    }
}
}

struct P2cItem { u32x4 uw[8], zw[8]; float prev, last; };
__device__ __forceinline__ void p2c_load(P2cItem& I, const bf16_t* UHT, const bf16_t* YHT, int it, int lane) {
    const int g = it & 7, tb = it >> 3; const int t0 = tb * 64, ts0 = t0 & (SEQ - 1); const int c = 64 * g + lane, cc = 1024 + c;
    const bf16_t* u = UHT + (size_t)cc * T + t0; const bf16_t* zp = YHT + (size_t)c * T + t0;
#pragma unroll
    for (int k = 0; k < 8; ++k) { I.uw[k] = *(const u32x4*)(u + 8 * k); I.zw[k] = *(const u32x4*)(zp + 8 * k); }
    I.prev = ts0 > 0 ? bf2f(u[-1]) : 0.f; I.last = ts0 + 64 < SEQ ? bf2f(u[64]) : 0.f;
}
__device__ __forceinline__ void p2c_process(const P2cItem& I, const float* sw, const float* sbias, bf16_t* Y, LAS float* tile, int it, int lane) {
    const int g = it & 7, tb = it >> 3; const int t0 = tb * 64;
    {
        const int cc = 1024 + 64 * g + lane;
        const float w0 = sw[cc], w1 = sw[1536 + cc], w2 = sw[3072 + cc], bb = sbias[cc];
        float prev = I.prev;
#pragma unroll
        for (int k = 0; k < 8; ++k) { float x[10]; x[0] = prev;
#pragma unroll
            for (int j = 0; j < 4; ++j) { x[1 + 2 * j] = bflo(I.uw[k][j]); x[2 + 2 * j] = bfhi(I.uw[k][j]); }
            x[9] = (k < 7) ? bflo(I.uw[k < 7 ? k + 1 : 7][0]) : I.last; prev = x[8];
#pragma unroll
            for (int j = 0; j < 8; ++j) { const float gate = w0 * x[j] + w1 * x[j + 1] + w2 * x[j + 2] + bb; const float zc = (j & 1) ? bfhi(I.zw[k][j >> 1]) : bflo(I.zw[k][j >> 1]);
                tile[lane * 65 + 8 * k + j] = gate * zc; } }
    }
    LDS_WAIT(); asm volatile("" ::: "memory");
    {
        float ss = 0.f;
#pragma unroll 8
        for (int ch = 0; ch < 64; ++ch) { const float v = tile[ch * 65 + lane]; ss += v * v; }
        const float rs = 1.0f / sqrtf(ss * (1.0f / 64.0f) + EPSN);
        bf16_t* o = Y + (size_t)(t0 + lane) * 1024 + 64 * g;
#pragma unroll
        for (int k = 0; k < 8; ++k) { u32x4 w;
#pragma unroll
            for (int j = 0; j < 4; ++j) w[j] = pk2(tile[(8 * k + 2 * j) * 65 + lane] * rs, tile[(8 * k + 2 * j + 1) * 65 + lane] * rs);
            *(u32x4*)(o + 8 * k) = w; }
    }
    LDS_WAIT(); asm volatile("" ::: "memory");
}
__device__ __forceinline__ void p2c_transpose(Frame& F, bf16_t* Y) {
    const int gw = F.vcu * NWAVES + F.wave, NGW = F.G * NWAVES, lane = F.lane;
    const bf16_t* UHT = (const bf16_t*)(F.ws + WS_UHT); const bf16_t* YHT = (const bf16_t*)(F.ws + WS_YHT);
    const float* sw = F.in[4]; const float* sbias = F.in[5];
    LAS float* tile = (LAS float*)(F.lds + F.wave * 16640);
    constexpr int NIT = 8 * (T / 64);
    for (int it = gw; it < NIT; it += 2 * NGW) {
        P2cItem A, B; const bool hasB = it + NGW < NIT;
        p2c_load(A, UHT, YHT, it, lane);
        if (hasB) p2c_load(B, UHT, YHT, it + NGW, lane);
        p2c_process(A, sw, sbias, Y, tile, it, lane);
        if (hasB) p2c_process(B, sw, sbias, Y, tile, it + NGW, lane);
    }
}

struct TileSched {
    int G, vcu, nM, lgN; const char *A, *B; size_t tA, tB; int kt;
    __device__ __forceinline__ bool next(int i, pg8::Unit& u) const {
        const int L = i * G + vcu; if (L >= (nM << lgN)) return false;
        u.pm = L >> lgN; u.pn = L & ((1 << lgN) - 1); u.A = A + (size_t)u.pm * tA; u.B = B + (size_t)u.pn * tB; u.aux = 0; u.flags = 3; u.kt = kt; return true;
    }
};
template <bool BASE_BF16> struct EpiResid {
    const float* base; bf16_t* xb; float* ss; const float* rowscale;
    __device__ __forceinline__ void operator()(const f32x4 (&acc)[2][2][4][2], const pg8::Unit& u, int wr, int wc, int fr, int fq) const {
        const int row0 = u.pm * 256 + wr * 64 + fr, col0 = u.pn * 256 + wc * 32 + 8 * fq;
#pragma unroll
        for (int ai = 0; ai < 2; ++ai)
#pragma unroll
            for (int mh = 0; mh < 2; ++mh) {
                f32x4 b[4][2][2];
#pragma unroll
                for (int mm = 0; mm < 2; ++mm) { const int r = row0 + ai * 128 + (2 * mh + mm) * 16; const float rsc = (BASE_BF16 && rowscale) ? rowscale[r] : 1.0f;
#pragma unroll
                    for (int bj = 0; bj < 2; ++bj) { const size_t off = (size_t)r * 1024 + col0 + bj * 128;
                        if (BASE_BF16) { const u32x4 bw = *(const u32x4*)(xb + off); b[mm][bj][0] = (f32x4){bflo(bw[0]), bfhi(bw[0]), bflo(bw[1]), bfhi(bw[1])} * rsc; b[mm][bj][1] = (f32x4){bflo(bw[2]), bfhi(bw[2]), bflo(bw[3]), bfhi(bw[3])} * rsc; }
                        else { b[mm][bj][0] = *(const f32x4*)(base + off); b[mm][bj][1] = *(const f32x4*)(base + off + 4); } } }
#pragma unroll
                for (int mm = 0; mm < 2; ++mm) { const int m = 2 * mh + mm; const int r = row0 + ai * 128 + m * 16; float part = 0.f;
#pragma unroll
                    for (int bj = 0; bj < 2; ++bj) { const size_t off = (size_t)r * 1024 + col0 + bj * 128;
                        const f32x4 v0 = acc[ai][bj][m][0] + b[mm][bj][0], v1 = acc[ai][bj][m][1] + b[mm][bj][1];
                        u32x4 w; w.x = pg8::cvt_pk_bf16(v0[0], v0[1]); w.y = pg8::cvt_pk_bf16(v0[2], v0[3]); w.z = pg8::cvt_pk_bf16(v1[0], v1[1]); w.w = pg8::cvt_pk_bf16(v1[2], v1[3]);
                        *(u32x4*)(xb + off) = w;
                        part += (v0[0] * v0[0] + v0[1] * v0[1]) + (v0[2] * v0[2] + v0[3] * v0[3]) + (v1[0] * v1[0] + v1[1] * v1[1]) + (v1[2] * v1[2] + v1[3] * v1[3]); }
                    part += __shfl_xor(part, 16); part += __shfl_xor(part, 32);
                    if (fq == 0) ss[(size_t)r * 16 + u.pn * 4 + wc] = part; }
                asm volatile("" ::: "memory"); }
    }
};
__device__ __forceinline__ float row_rstd(const float* ssp, int r) {
    const f32x4* p = (const f32x4*)(ssp + (size_t)r * 16); const f32x4 a = p[0], b = p[1], c = p[2], d = p[3];
    const float t = (((a[0] + a[1]) + (a[2] + a[3])) + ((b[0] + b[1]) + (b[2] + b[3]))) + (((c[0] + c[1]) + (c[2] + c[3])) + ((d[0] + d[1]) + (d[2] + d[3])));
    return 1.0f / sqrtf(t * (1.0f / 1024.0f) + EPSN);
}
struct EpiRowScale {
    bf16_t* O; const float* ss;
    __device__ __forceinline__ void operator()(const f32x4 (&acc)[2][2][4][2], const pg8::Unit& u, int wr, int wc, int fr, int fq) const {
        const int row0 = u.pm * 256 + wr * 64 + fr, col0 = u.pn * 256 + wc * 32 + 8 * fq;
#pragma unroll
        for (int ai = 0; ai < 2; ++ai)
#pragma unroll
            for (int m = 0; m < 4; ++m) { const int r = row0 + ai * 128 + m * 16; const float rs = row_rstd(ss, r);
#pragma unroll
                for (int bj = 0; bj < 2; ++bj) { const f32x4 v0 = acc[ai][bj][m][0] * rs, v1 = acc[ai][bj][m][1] * rs;
                    u32x4 w; w.x = pg8::cvt_pk_bf16(v0[0], v0[1]); w.y = pg8::cvt_pk_bf16(v0[2], v0[3]); w.z = pg8::cvt_pk_bf16(v1[0], v1[1]); w.w = pg8::cvt_pk_bf16(v1[2], v1[3]);
                    *(u32x4*)(O + (size_t)r * 512 + col0 + bj * 128) = w; } }
    }
};

namespace ma {
constexpr int KP = 272, VP = 520;
constexpr int LK = 0, LV = 256 * KP, LEND = LV + 128 * VP;
static_assert(LEND <= MISC_OFF, "mem-attn LDS map");
__device__ __forceinline__ void memattn_unit(int b, int h, int rb, const bf16_t* QM, const bf16_t* KVM, bf16_t* OM, const float* gq, LAS unsigned char* lds) {
    const int tid = threadIdx.x, lane = tid & 63, wid = __builtin_amdgcn_readfirstlane(tid >> 6), r32 = lane & 31, hi = lane >> 5;
    __syncthreads();
#pragma unroll 2
    for (int k = 0; k < 8; ++k) { const int p = tid + 512 * k, key = p >> 4, ch = p & 15;
        const u32x4 w = *(const u32x4*)(KVM + (size_t)(b * 256 + key) * 1024 + h * 128 + ch * 8);
        *(LAS u32x4*)(lds + LK + key * KP + ch * 16) = w; }
#pragma unroll 2
    for (int k = 0; k < 8; ++k) { const int p = tid + 512 * k, key = p & 255, ch = p >> 8;
        const u32x4 w = *(const u32x4*)(KVM + (size_t)(b * 256 + key) * 1024 + 512 + h * 128 + ch * 8);
#pragma unroll
        for (int j = 0; j < 4; ++j) { *(LAS bf16_t*)(lds + LV + (ch * 8 + 2 * j) * VP + key * 2) = (bf16_t)(w[j] & 0xffffu); *(LAS bf16_t*)(lds + LV + (ch * 8 + 2 * j + 1) * VP + key * 2) = (bf16_t)(w[j] >> 16); } }
    const size_t qrow = (size_t)b * SEQ + rb * 256 + wid * 32 + r32;
    bf16x8 qf[8];
    {
        float qv[8][8]; float ssq = 0.f;
#pragma unroll
        for (int ks = 0; ks < 8; ++ks) { const u32x4 w = *(const u32x4*)(QM + qrow * 512 + h * 128 + ks * 16 + hi * 8);
#pragma unroll
            for (int j = 0; j < 4; ++j) { qv[ks][2 * j] = bflo(w[j]); qv[ks][2 * j + 1] = bfhi(w[j]); ssq += qv[ks][2 * j] * qv[ks][2 * j] + qv[ks][2 * j + 1] * qv[ks][2 * j + 1]; } }
        ssq += __shfl_xor(ssq, 32);
        const float rs = (0.08838834764831845f * 1.4426950408889634f) / sqrtf(ssq * (1.0f / 128.0f) + EPSN);
#pragma unroll
        for (int ks = 0; ks < 8; ++ks) { const f32x4 g0 = *(const f32x4*)(gq + ks * 16 + hi * 8), g1 = *(const f32x4*)(gq + ks * 16 + hi * 8 + 4); u32x4 w;
#pragma unroll
            for (int j = 0; j < 2; ++j) { w[j] = pk2(qv[ks][2 * j] * rs * g0[2 * j], qv[ks][2 * j + 1] * rs * g0[2 * j + 1]); w[2 + j] = pk2(qv[ks][4 + 2 * j] * rs * g1[2 * j], qv[ks][5 + 2 * j] * rs * g1[2 * j + 1]); }
            qf[ks] = __builtin_bit_cast(bf16x8, w); }
    }
    __syncthreads();
    f32x16 st[8];
#pragma unroll
    for (int kb = 0; kb < 8; ++kb) { f32x16 a = f32x16{};
#pragma unroll
        for (int ks = 0; ks < 8; ++ks) { const bf16x8 kf = *(const LAS bf16x8*)(lds + LK + (kb * 32 + r32) * KP + ks * 32 + hi * 16);
            a = __builtin_amdgcn_mfma_f32_32x32x16_bf16(kf, qf[ks], a, 0, 0, 0); }
        st[kb] = a; }
    float mx = -1e30f;
#pragma unroll
    for (int kb = 0; kb < 8; ++kb)
#pragma unroll
        for (int r = 0; r < 16; ++r) mx = fmaxf(mx, st[kb][r]);
    mx = fmaxf(mx, __shfl_xor(mx, 32));
    float l = 0.f; u32x4 pb[8][2];
#pragma unroll
    for (int kb = 0; kb < 8; ++kb) {
#pragma unroll
        for (int r = 0; r < 16; ++r) { st[kb][r] = __builtin_amdgcn_exp2f(st[kb][r] - mx); l += st[kb][r]; }
#pragma unroll
        for (int s2 = 0; s2 < 2; ++s2)
#pragma unroll
            for (int j = 0; j < 4; ++j) pb[kb][s2][j] = pk2(st[kb][8 * s2 + 2 * j], st[kb][8 * s2 + 2 * j + 1]); }
    l += __shfl_xor(l, 32);
    const float il = 1.0f / l;
    bf16_t* orow = OM + qrow * 512 + h * 128;
#pragma unroll
    for (int db = 0; db < 4; ++db) { f32x16 o = f32x16{};
#pragma unroll
        for (int kb = 0; kb < 8; ++kb)
#pragma unroll
            for (int s2 = 0; s2 < 2; ++s2) { const LAS unsigned char* vp = lds + LV + (db * 32 + r32) * VP + 2 * (kb * 32 + 16 * s2 + 4 * hi);
                const u32x2 v0 = *(const LAS u32x2*)vp, v1 = *(const LAS u32x2*)(vp + 16);
                const u32x4 vv = (u32x4){v0[0], v0[1], v1[0], v1[1]};
                o = __builtin_amdgcn_mfma_f32_32x32x16_bf16(__builtin_bit_cast(bf16x8, vv), __builtin_bit_cast(bf16x8, pb[kb][s2]), o, 0, 0, 0); }
#pragma unroll
        for (int g4 = 0; g4 < 4; ++g4) { u32x2 w; w[0] = pk2(o[4 * g4] * il, o[4 * g4 + 1] * il); w[1] = pk2(o[4 * g4 + 2] * il, o[4 * g4 + 3] * il);
            *(u32x2*)(orow + db * 32 + 8 * g4 + 4 * hi) = w; } }
}
}

constexpr size_t WS_SSP1 = WS_MOE + 6 * MiBx, WS_SSP2 = WS_MOE + 8 * MiBx;
constexpr size_t WS_TOKW = WS_MOE + 1 * MiBx, WS_RS = WS_MOE + 2 * MiBx, WS_TOKS = WS_MOE + 3 * MiBx;
constexpr size_t WS_HB = WS_UHT;
constexpr int XS_ROWS = T + 24 * 256;
constexpr int WRP = 336;
__device__ __forceinline__ void p6a_route(Frame& F) {
    constexpr int WP = 2064, PS = 20 * WP, LG = 3 * PS, LGW = 16 * 96, CN = LG + 8 * LGW;
    static_assert(CN + 256 <= MISC_OFF, "router LDS map");
    const int lane = F.lane, r16 = lane & 15, g4 = lane >> 4;
    const float* WR = (const float*)(F.ws + WS_WR); const float* brg = F.in[28]; const float* bre = F.in[30];
    int* cnt = (int*)(F.ctl + CW_CNT); int* toks = (int*)(F.ws + WS_TOKS); float* tokw = (float*)(F.ws + WS_TOKW); float* rs2 = (float*)(F.ws + WS_RS);
    const bf16_t* xb = (const bf16_t*)(F.ws + WS_XN);
    volatile LAS int* cntl = (volatile LAS int*)(F.lds + CN); volatile LAS int* basel = cntl + 32;
    __syncthreads();
    for (int i = F.tid; i < 20 * 128; i += NWAVES * 64) { const int e = i >> 7, k8 = (i & 127) * 8;
        const f32x4 wa = *(const f32x4*)(WR + e * 1024 + k8), wb = *(const f32x4*)(WR + e * 1024 + k8 + 4);
        const float w[8] = {wa.x, wa.y, wa.z, wa.w, wb.x, wb.y, wb.z, wb.w};
        u32x4 ph, pm, pl;
#pragma unroll
        for (int j = 0; j < 4; ++j) { unsigned hh[2], mm[2], ll[2];
#pragma unroll
            for (int q = 0; q < 2; ++q) { const float x = w[2 * j + q]; const unsigned h = pk2(x, 0.f) & 0xffffu; const float r1 = x - __uint_as_float(h << 16);
                const unsigned m = pk2(r1, 0.f) & 0xffffu; const float r2 = r1 - __uint_as_float(m << 16); hh[q] = h; mm[q] = m; ll[q] = pk2(r2, 0.f) & 0xffffu; }
            ph[j] = hh[0] | (hh[1] << 16); pm[j] = mm[0] | (mm[1] << 16); pl[j] = ll[0] | (ll[1] << 16); }
        *(LAS u32x4*)(F.lds + e * WP + 2 * k8) = ph; *(LAS u32x4*)(F.lds + PS + e * WP + 2 * k8) = pm; *(LAS u32x4*)(F.lds + 2 * PS + e * WP + 2 * k8) = pl; }
    if (F.tid < 32) cntl[F.tid] = 0;
    __syncthreads();
    LAS float* lgw = (LAS float*)(F.lds + LG + F.wave * LGW);
    const LAS unsigned char* wf0 = F.lds + r16 * WP + 16 * g4;
    const LAS unsigned char* wf1 = F.lds + (16 + (r16 & 3)) * WP + 16 * g4;
    for (int tb = F.vcu; tb < T / 128; tb += F.G) {
        const int tok0 = tb * 128 + F.wave * 16;
        const bf16_t* xr = xb + (size_t)(tok0 + r16) * 1024 + 8 * g4;
        f32x4 acc0 = (f32x4){0.f, 0.f, 0.f, 0.f}, acc1 = acc0; float ssq = 0.f;
#pragma unroll 1
        for (int kb = 0; kb < 2; ++kb) {
            u32x4 xa[16];
#pragma unroll
            for (int j = 0; j < 16; ++j) xa[j] = *(const u32x4*)(xr + 32 * (16 * kb + j));
#pragma unroll
            for (int j = 0; j < 16; ++j) { const int ks = 16 * kb + j; const u32x4 xw = xa[j];
#pragma unroll
                for (int q = 0; q < 4; ++q) { const float v0 = bflo(xw[q]), v1 = bfhi(xw[q]); ssq += v0 * v0 + v1 * v1; }
                bf16x8 xf; __builtin_memcpy(&xf, &xw, 16);
#pragma unroll
                for (int p = 0; p < 3; ++p) { const bf16x8 a0 = *(const LAS bf16x8*)(wf0 + p * PS + 64 * ks), a1 = *(const LAS bf16x8*)(wf1 + p * PS + 64 * ks);
                    acc0 = __builtin_amdgcn_mfma_f32_16x16x32_bf16(a0, xf, acc0, 0, 0, 0); acc1 = __builtin_amdgcn_mfma_f32_16x16x32_bf16(a1, xf, acc1, 0, 0, 0); } } }
        ssq += __shfl_xor(ssq, 16); ssq += __shfl_xor(ssq, 32);
        const float rstd = 1.0f / sqrtf(ssq * (1.0f / 1024.0f) + EPSN);
        *(LAS f32x4*)(lgw + r16 * 24 + 4 * g4) = acc0; if (g4 == 0) *(LAS f32x4*)(lgw + r16 * 24 + 16) = acc1;
        LDS_WAIT(); asm volatile("" ::: "memory");
        const bool act = lane < 16; const int tok = tok0 + r16;
        float lg[20];
#pragma unroll
        for (int q = 0; q < 5; ++q) { const f32x4 v = *(const LAS f32x4*)(lgw + r16 * 24 + 4 * q); lg[4 * q] = v.x * rstd; lg[4 * q + 1] = v.y * rstd; lg[4 * q + 2] = v.z * rstd; lg[4 * q + 3] = v.w * rstd; }
        float gl[4], gm = -1e30f;
#pragma unroll
        for (int j = 0; j < 4; ++j) { gl[j] = lg[j] + brg[j]; gm = fmaxf(gm, gl[j]); }
        float gs = 0.f, gp[4];
#pragma unroll
        for (int j = 0; j < 4; ++j) { gp[j] = expf(gl[j] - gm); gs += gp[j]; }
        int gi = 0; float best = gp[0];
#pragma unroll
        for (int j = 1; j < 4; ++j) if (gp[j] > best) { best = gp[j]; gi = j; }
        const float pg = best / gs;
        float el[4], em = -1e30f;
#pragma unroll
        for (int j = 0; j < 4; ++j) { float vv = 0.f;
#pragma unroll
            for (int q = 0; q < 4; ++q) if (q == gi) vv = lg[4 + q * 4 + j] + bre[q * 4 + j];
            el[j] = vv; em = fmaxf(em, vv); }
        float ep[4];
#pragma unroll
        for (int j = 0; j < 4; ++j) ep[j] = expf(el[j] - em);
        int e1 = 0; float p1 = ep[0];
#pragma unroll
        for (int j = 1; j < 4; ++j) if (ep[j] > p1) { p1 = ep[j]; e1 = j; }
        int e2 = -1; float p2 = -1.f;
#pragma unroll
        for (int j = 0; j < 4; ++j) if (j != e1 && ep[j] > p2) { p2 = ep[j]; e2 = j; }
        const float w1 = pg * p1 / (p1 + p2), w2 = pg * p2 / (p1 + p2);
        const int lo = e1 < e2 ? e1 : e2, hi2 = e1 < e2 ? e2 : e1; const float wlo = e1 < e2 ? w1 : w2, whi = e1 < e2 ? w2 : w1;
        const int pidx = (lo == 0) ? (hi2 - 1) : (lo == 1 ? hi2 + 1 : 5);
        const int bucket = gi * 6 + pidx;
        int rank = 0;
        if (act) rank = __hip_atomic_fetch_add((LAS int*)&cntl[bucket], 1, __ATOMIC_RELAXED, __HIP_MEMORY_SCOPE_WORKGROUP);
        __syncthreads();
        if (F.tid < 24) { const int c = cntl[F.tid]; basel[F.tid] = c ? atomicAdd(&cnt[F.tid * 64], c) : 0; }
        __syncthreads();
        if (act) { const int pos = basel[bucket] + rank; toks[(size_t)bucket * T + pos] = tok; tokw[2 * tok] = wlo; tokw[2 * tok + 1] = whi; rs2[tok] = rstd; }
        __syncthreads();
        if (F.tid < 32) cntl[F.tid] = 0;
        __syncthreads();
    }
}
__device__ __forceinline__ void moe_prefix(Frame& F, volatile LAS int* tp) {
    if (F.tid == 0) { const int* cnt = (const int*)(F.ctl + CW_CNT); int s = 0; for (int b = 0; b < 24; ++b) { tp[b] = s; s += (cnt[b * 64] + 255) >> 8; } tp[24] = s; }
    __syncthreads();
}
__device__ __forceinline__ int moe_bucket_of_tile(volatile LAS int* tp, int tau) { int b = 0;
#pragma unroll
    for (int k = 1; k < 24; ++k) b += (tau >= tp[k]) ? 1 : 0;
    return b; }
__device__ __forceinline__ int moe_expert(int bucket, int slot) { const int g = bucket / 6, p = bucket % 6; const int lo = p < 3 ? 0 : (p < 5 ? 1 : 2), hi2 = p < 3 ? p + 1 : (p < 5 ? p - 1 : 3); return g * 4 + (slot ? hi2 : lo); }
constexpr int CW_TCNT = 11264;
static_assert((CW_TCNT + 160 * 16) * 4 <= (int)CTL_ZERO_BYTES, "ctl region");
struct MoeSched {
    int G, vcu; volatile LAS int* tp; const int* cnt; const char *xb, *wgu, *hb, *wd; const int* toks; unsigned* tcnt;
    __device__ __forceinline__ void tile_rows(int tau, pg8::Unit& u) const { const int b = moe_bucket_of_tile(tp, tau); const int off = (tau - tp[b]) * 256; u.rows = toks + (size_t)b * T + off; const int c = cnt[b * 64] - off; u.nvalid = c < 256 ? c : 256; }
    __device__ __forceinline__ bool next(int i, pg8::Unit& u) const {
        const int ntile = tp[24]; const int NU = ntile * 8, ND = ntile * 4;
        const int nu = (NU > vcu) ? (NU - vcu + G - 1) / G : 0;
        if (i < nu) { const int L = i * G + vcu; const int tau = L >> 3, slot = (L >> 2) & 1, pn = L & 3; const int e = moe_expert(moe_bucket_of_tile(tp, tau), slot);
            u.pm = tau; u.pn = pn; u.aux = slot; u.flags = 3; u.kt = 16; u.A = xb; u.B = wgu + ((size_t)e * 1024 + pn * 256) * 2048; tile_rows(tau, u); return true; }
        const int j = i - nu; const int Ld = (nu + (j >> 1)) * G + vcu - NU, slot = j & 1; if (Ld >= ND) return false;
        const int tau = Ld >> 2, pn = Ld & 3; const int e = moe_expert(moe_bucket_of_tile(tp, tau), slot);
        if (slot == 0) { unsigned spins = 0; while (__hip_atomic_load(tcnt + tau * 16, __ATOMIC_RELAXED, __HIP_MEMORY_SCOPE_AGENT) < 8u) { __builtin_amdgcn_s_sleep(4); if (++spins > (1u << 22)) break; }
            __builtin_amdgcn_fence(__ATOMIC_ACQUIRE, "agent"); }
        u.pm = tau; u.pn = pn; u.aux = 2 | slot; u.flags = slot ? 2 : 1; u.kt = 8; u.A = hb + (size_t)tau * 256 * 2048 + slot * 1024; u.B = wd + ((size_t)e * 1024 + pn * 256) * 2048; tile_rows(tau, u); return true;
    }
    __device__ __forceinline__ unsigned rowoff(const pg8::Unit& u, int R) const {
        if (u.aux & 2) return (unsigned)R * 2048u;
        const int tok = (R < u.nvalid) ? u.rows[R] : 0; return (unsigned)tok * 2048u;
    }
};
struct EpiMoeUp {
    bf16_t* H; const float* rs2; const float* tokw;
    __device__ __forceinline__ void operator()(const f32x4 (&acc)[2][2][4][2], const pg8::Unit& u, int wr, int wc, int fr, int fq) const {
        const int rl0 = wr * 64 + fr, col0 = u.aux * 512 + u.pn * 128 + wc * 32 + 8 * fq;
#pragma unroll
        for (int ai = 0; ai < 2; ++ai)
#pragma unroll
            for (int m = 0; m < 4; ++m) { const int rl = rl0 + ai * 128 + m * 16; const int tok = (rl < u.nvalid) ? u.rows[rl] : -1;
                const float rs = tok >= 0 ? rs2[tok] : 0.f, gwt = tok >= 0 ? tokw[2 * tok + u.aux] : 0.f;
                float hv[8];
#pragma unroll
                for (int n = 0; n < 2; ++n)
#pragma unroll
                    for (int k = 0; k < 4; ++k) { const float g = acc[ai][0][m][n][k] * rs, uu = acc[ai][1][m][n][k] * rs; hv[4 * n + k] = g / (1.0f + __expf(-g)) * uu * gwt; }
                u32x4 w; w.x = pg8::cvt_pk_bf16(hv[0], hv[1]); w.y = pg8::cvt_pk_bf16(hv[2], hv[3]); w.z = pg8::cvt_pk_bf16(hv[4], hv[5]); w.w = pg8::cvt_pk_bf16(hv[6], hv[7]);
                { bf16_t* hp = H + (size_t)(u.pm * 256 + rl) * 1024 + col0; asm volatile("global_store_dwordx4 %0, %1, off sc1\n\ts_nop 1" :: "v"(hp), "v"(w) : "memory"); } }
    }
};
struct EpiMoeDown {
    float* out; const bf16_t* xb;
    __device__ __forceinline__ void operator()(const f32x4 (&acc)[2][2][4][2], const pg8::Unit& u, int wr, int wc, int fr, int fq) const {
        const int rl0 = wr * 64 + fr, col0 = u.pn * 256 + wc * 32 + 8 * fq;
        int tk[2][4];
#pragma unroll
        for (int ai = 0; ai < 2; ++ai)
#pragma unroll
            for (int m = 0; m < 4; ++m) { const int rl = rl0 + ai * 128 + m * 16; tk[ai][m] = (rl < u.nvalid) ? u.rows[rl] : -1; }
#pragma unroll
        for (int ai = 0; ai < 2; ++ai) {
            u32x4 bw[4][2];
#pragma unroll
            for (int m = 0; m < 4; ++m)
#pragma unroll
                for (int bj = 0; bj < 2; ++bj) bw[m][bj] = *(const u32x4*)(xb + (size_t)(tk[ai][m] < 0 ? 0 : tk[ai][m]) * 1024 + col0 + bj * 128);
#pragma unroll
            for (int m = 0; m < 4; ++m) { const int tok = tk[ai][m];
                if (tok >= 0) {
#pragma unroll
                    for (int bj = 0; bj < 2; ++bj) { float* p = out + (size_t)tok * 1024 + col0 + bj * 128; const u32x4 w = bw[m][bj];
                        __builtin_nontemporal_store((f32x4){bflo(w[0]), bfhi(w[0]), bflo(w[1]), bfhi(w[1])} + acc[ai][bj][m][0], (f32x4*)p); __builtin_nontemporal_store((f32x4){bflo(w[2]), bfhi(w[2]), bflo(w[3]), bfhi(w[3])} + acc[ai][bj][m][1], (f32x4*)(p + 4)); } } }
            asm volatile("" ::: "memory"); }
    }
};
struct EpiMoe {
    EpiMoeUp up; EpiMoeDown down; unsigned* tcnt;
    __device__ __forceinline__ void operator()(const f32x4 (&acc)[2][2][4][2], const pg8::Unit& u, int wr, int wc, int fr, int fq) const {
        if (u.aux & 2) { down(acc, u, wr, wc, fr, fq); return; }
        up(acc, u, wr, wc, fr, fq);
        asm volatile("s_waitcnt vmcnt(0)" ::: "memory");
        __builtin_amdgcn_s_barrier();
        if (threadIdx.x == 0) __hip_atomic_fetch_add(tcnt + u.pm * 16, 1u, __ATOMIC_RELAXED, __HIP_MEMORY_SCOPE_AGENT);
    }
};

struct Args { const float* in[34]; float* out; unsigned char* ws; unsigned char* ybuf; int ph_lo, ph_hi; };
__global__ void __launch_bounds__(NWAVES * 64, 2) mk_fwd(Args args) {
    extern __shared__ __attribute__((aligned(16))) unsigned char lds[];
    Frame F;
    F.lds = (LAS unsigned char*)lds;
    F.tid = threadIdx.x; F.lane = F.tid & 63; F.wave = __builtin_amdgcn_readfirstlane(F.tid >> 6);
    F.G = gridDim.x; { const int bx = blockIdx.x; F.vcu = (F.G % 8 == 0) ? (bx % 8) * (F.G / 8) + bx / 8 : bx; }
    F.ws = args.ws; F.ctl = (unsigned*)(args.ws + WS_CTL); F.in = args.in; F.out = args.out;
    volatile LAS unsigned* MISC = (volatile LAS unsigned*)(F.lds + MISC_OFF);
    for (int u = F.tid; u < 128; u += NWAVES * 64) MISC[u] = 0u;
    __syncthreads();
    XcdBarrier bar = xcd_barrier_post(F.ctl + CW_BAR, MISC + 8);
    const int lo = args.ph_lo, hi = args.ph_hi;
#ifdef MK_TS
    if (blockIdx.x == MK_TSB && F.tid == 0) { const unsigned long long t_ = __builtin_amdgcn_s_memrealtime(); MISC[58] = (unsigned)t_; MISC[59] = (unsigned)(t_ >> 32); }
#define TSTAMP(k) TSI(k)
#else
#define TSTAMP(k) do {} while (0)
#endif
#define IN(k) (lo <= (k) && (k) < hi)
#define SEAM(k) do { if (IN(k) && IN((k) + 1)) xcd_barrier(bar); TSTAMP(k); } while (0)
    unsigned char* ws = args.ws;
    if (IN(0)) { p0_prologue(F); }
    SEAM(0);
    if (IN(1)) {
        P1Sched S{F.G, F.vcu, (const char*)(ws + WS_WIN), (const char*)(ws + WS_XN), (const char*)(ws + WS_MEMN), (const char*)(ws + WS_WKV)};
        EpiBf16Multi E{ws};
        pg8::gemm_phase(F.lds, 1024, 1024, 1024, S, E);
        VM_WAIT(); __syncthreads();
        { pg8::Unit u; for (int i = 0; S.next(i, u); ++i) { if (u.aux == 1 && u.pn == 2) kprep_tile(F, u.pm); else if (u.aux == 2 && u.pn < 2) kmem_norm_tile(F, u.pm, u.pn); } }
    }
    SEAM(1);
    TSTAMP(2);
    if (IN(3)) {
        const bf16_t* QKV = (const bf16_t*)(ws + WS_QKV); bf16_t* Yb = (bf16_t*)args.ybuf;
#ifndef NO_HY
        bgtr::State BG; BG.it = __builtin_amdgcn_readfirstlane(F.vcu * NWAVES + F.wave); BG.pend = 0;
        const int bgstride = F.G * NWAVES;
        for (int j = 0; j < 2; ++j) { const int c = j * F.G + F.vcu; if (c < 512)
            hy::hyena_unit(c, (const bf16_t*)(ws + WS_UHT), (bf16_t*)(ws + WS_ZS), (bf16_t*)(ws + WS_YHT), (const bf16_t*)(ws + WS_KF), (const float*)(F.ctl + CW_FN), args.in[4], args.in[5], args.in[12], F.lds, BG, bgstride, args.in, ws); }
        while (BG.it < bgtr::NIT || BG.pend) bgtr::step(BG, bgstride, args.in, ws, F.lds, (unsigned)__builtin_amdgcn_readfirstlane(bgtr::SCR + F.wave * bgtr::SCRW), F.lane);
        __syncthreads();
        TSI(30);
#endif
#ifndef NO_AT
        for (int i = 0; i < 4; ++i) { const int uid = i * F.G + F.vcu; if (uid < 1024) { const int pair = uid >> 6, rem = uid & 63;
            at::attn_unit<8>(pair >> 1, (pair & 1) * 4 + (rem >> 4), rem & 15, QKV, Yb, args.in[13], args.in[14], (const float*)(ws + WS_ROPE), (char*)lds); } }
#endif
    }
    SEAM(3);
#ifndef NO_P2C
    if (IN(4)) { p2c_transpose(F, (bf16_t*)args.ybuf); }
#endif
    SEAM(4);
    if (IN(5)) {
        TileSched S{F.G, F.vcu, T / 256, 2, (const char*)args.ybuf, (const char*)(ws + WS_WOUT), (size_t)256 * 2048, (size_t)256 * 2048, 16};
        EpiResid<true> E{nullptr, (bf16_t*)(ws + WS_XN), (float*)(ws + WS_SSP1), (const float*)(ws + WS_RMS0)};
        pg8::gemm_phase(F.lds, 1024, 1024, 1024, S, E);
    }
    SEAM(5);
    if (IN(6)) {
        TileSched S{F.G, F.vcu, T / 256, 1, (const char*)(ws + WS_XN), (const char*)(ws + WS_WQM), (size_t)256 * 2048, (size_t)256 * 2048, 16};
        EpiRowScale E{(bf16_t*)(ws + WS_QM), (const float*)(ws + WS_SSP1)};
        pg8::gemm_phase(F.lds, 1024, 1024, 1024, S, E);
        VM_WAIT(); __syncthreads();
        { pg8::Unit u; for (int i = 0; S.next(i, u); ++i) for (int hh = 0; hh < 2; ++hh)
            ma::memattn_unit(u.pm >> 4, 2 * u.pn + hh, u.pm & 15, (const bf16_t*)(ws + WS_QM), (const bf16_t*)(ws + WS_KVM), (bf16_t*)(ws + WS_OM), args.in[23], F.lds); }
        __syncthreads();
    }
    SEAM(6);
    TSTAMP(7);
    if (IN(8)) {
        TileSched S{F.G, F.vcu, T / 256, 2, (const char*)(ws + WS_OM), (const char*)(ws + WS_WOM), (size_t)256 * 1024, (size_t)256 * 1024, 8};
        EpiResid<true> E{nullptr, (bf16_t*)(ws + WS_XN), (float*)(ws + WS_SSP2), nullptr};
        pg8::gemm_phase(F.lds, 512, 512, 512, S, E);
    }
    SEAM(8);
    if (IN(9)) { p6a_route(F); }
    SEAM(9);
    volatile LAS int* tp = (volatile LAS int*)(MISC + 32);
    TSTAMP(10);
    if (IN(11)) {
        moe_prefix(F, tp);
        unsigned* tcnt = F.ctl + CW_TCNT;
        MoeSched S{F.G, F.vcu, tp, (const int*)(F.ctl + CW_CNT), (const char*)(ws + WS_XN), (const char*)(ws + WS_WGU), (const char*)(ws + WS_HB), (const char*)(ws + WS_WD), (const int*)(ws + WS_TOKS), tcnt};
        EpiMoe E{EpiMoeUp{(bf16_t*)(ws + WS_HB), (const float*)(ws + WS_RS), (const float*)(ws + WS_TOKW)}, EpiMoeDown{args.out, (const bf16_t*)(ws + WS_XN)}, tcnt};
        pg8::gemm_phase<EpiMoe, MoeSched, true>(F.lds, 1024, 1024, 1024, S, E);
        TSI(13);
    }
#ifdef MK_TS
    xcd_barrier(bar); TSTAMP(12);
    if (blockIdx.x == MK_TSB && F.tid == 0) { const unsigned long long ts1 = ((unsigned long long)MISC[61] << 32) | MISC[60], ts0 = ((unsigned long long)MISC[59] << 32) | MISC[58]; args.out[0] += (float)(ts1 - ts0) * 1e-3f; }
#endif
#undef IN
#undef SEAM
}

extern "C" void kernel_launch(void* const* d_in, const int* in_sizes, int n_in, void* d_out, int out_size, void* d_ws, size_t ws_size, hipStream_t stream) {
    static int grid = 0;
    if (grid == 0) {
        int dev = 0, cus = 0;
        if (hipGetDevice(&dev) != hipSuccess || hipDeviceGetAttribute(&cus, hipDeviceAttributeMultiprocessorCount, dev) != hipSuccess) { grid = -1; return; }
        if (hipFuncSetAttribute((const void*)mk_fwd, hipFuncAttributeMaxDynamicSharedMemorySize, LDS_BYTES) != hipSuccess) { fprintf(stderr, "hipFuncSetAttribute failed\n"); grid = -1; return; }
        (void)hipGetLastError();
        grid = cus;
    }
    if (grid < 0) return;
    (void)hipMemsetAsync((char*)d_ws + WS_CTL, 0, CTL_ZERO_BYTES, stream);
    Args a{};
    for (int i = 0; i < 34; ++i) a.in[i] = (const float*)d_in[i];
    a.out = (float*)d_out; a.ws = (unsigned char*)d_ws;
    a.ybuf = (unsigned char*)d_ws + WS_Y;
    a.ph_lo = 0; a.ph_hi = MK_STAGE;
    hipLaunchKernelGGL(mk_fwd, dim3(grid), dim3(NWAVES * 64), LDS_BYTES, stream, a);

}
```
